# Optimizing an MI355X kernel written in HIP

```python
import jax, jax.numpy as jnp
from jax import lax
import numpy as np

D_MODEL = 1024
BATCH = 8
SEQ = 4096
DEPTH = 1
DEC_BATCH = 8
DEC_SEQ = 64
PAST_LEN = 1024

CHUNK = 64
N_META = 16
Q_BLOCK = 128
FOX_HEADS = 8
FOX_HEAD_DIM = 64
FOX_WIDTH = FOX_HEADS * FOX_HEAD_DIM
ML_HEADS = 4
ML_HEAD_DIM = 128
ML_WIDTH = ML_HEADS * ML_HEAD_DIM
CONV_WIDTH = 4
D_FF = ((-(-8 * D_MODEL // 3)) + 255) // 256 * 256
RMS_EPS = 1e-6
PAD_LOG_GATE = -1e30
SPLITS = (FOX_WIDTH, FOX_WIDTH, FOX_WIDTH, FOX_HEADS, ML_WIDTH, ML_WIDTH, ML_WIDTH, ML_HEADS, ML_HEADS, D_MODEL, D_MODEL)
SPLIT_IDX = tuple(int(i) for i in np.cumsum(SPLITS)[:-1])
D_IN = sum(SPLITS)

kernel_name = 'hybrid_fox_mlstm_stream_step'


def rmsnorm(x, g):
    xf = x.astype(jnp.float32)
    y = xf * lax.rsqrt(jnp.mean(xf * xf, axis=-1, keepdims=True) + RMS_EPS)
    return (y * g.astype(jnp.float32)).astype(x.dtype)


def causal_conv(x, prev, w, b):
    T = x.shape[1]
    xc = jnp.concatenate([prev.astype(x.dtype), x], axis=1)
    y = b + sum(xc[:, i:i + T] * w[i] for i in range(CONV_WIDTH))
    return y, xc[:, T:]


def fox_block(q, Fq, qpos, k, v, Fk):
    s = jnp.einsum('bqhd,bkhd->bhqk', q, k).astype(jnp.float32) * (FOX_HEAD_DIM ** -0.5)
    bias = jnp.transpose(Fq, (0, 2, 1))[:, :, :, None] - jnp.transpose(Fk, (0, 2, 1))[:, :, None, :]
    mask = jnp.arange(k.shape[1])[None, :] <= qpos[:, None]
    s = jnp.where(mask[None, None], s + bias, -jnp.inf)
    p = jax.nn.softmax(s, axis=-1).astype(v.dtype)
    return jnp.einsum('bhqk,bkhd->bqhd', p, v)


def fox_prompt(q, k, v, F):
    B, L, H, Dh = q.shape
    nb = -(-L // Q_BLOCK)
    pad = nb * Q_BLOCK - L
    qb = jnp.pad(q, ((0, 0), (0, pad), (0, 0), (0, 0))).reshape(B, nb, Q_BLOCK, H, Dh).swapaxes(0, 1)
    Fb = jnp.pad(F, ((0, 0), (0, pad), (0, 0))).reshape(B, nb, Q_BLOCK, H).swapaxes(0, 1)
    starts = jnp.arange(nb) * Q_BLOCK

    def one(args):
        qi, Fi, s0 = args
        return fox_block(qi, Fi, s0 + jnp.arange(Q_BLOCK), k, v, F)

    o = lax.map(one, (qb, Fb, starts))
    return o.swapaxes(0, 1).reshape(B, nb * Q_BLOCK, H, Dh)[:, :L]


def mlstm_chunk(state, inp):
    C, n, m = state
    q, k, v, ig, lf = inp
    T = q.shape[1]
    b = jnp.cumsum(lf, axis=1)
    D = b[:, :, None, :] - b[:, None, :, :] + ig[:, None, :, :]
    tril = jnp.tril(jnp.ones((T, T), dtype=bool))
    D = jnp.where(tril[None, :, :, None], D, -jnp.inf)
    m_inter = b + m[:, None, :]
    m_t = jnp.maximum(m_inter, jnp.max(D, axis=2))
    w_intra = jnp.exp(D - m_t[:, :, None, :])
    w_inter = jnp.exp(m_inter - m_t)
    A = w_intra * jnp.einsum('bthd,bshd->btsh', q, k)
    num = jnp.einsum('btsh,bshd->bthd', A, v) + w_inter[..., None] * jnp.einsum('bthk,bhkv->bthv', q, C)
    den = jnp.sum(A, axis=2) + w_inter * jnp.einsum('bthk,bhk->bth', q, n)
    h = num / jnp.maximum(jnp.abs(den), jnp.exp(-m_t))[..., None]
    bL = b[:, -1]
    g = bL[:, None, :] - b + ig
    m_new = jnp.maximum(bL + m, jnp.max(g, axis=1))
    wk = jnp.exp(g - m_new[:, None, :])
    decay = jnp.exp(bL + m - m_new)
    C_new = decay[..., None, None] * C + jnp.einsum('bth,bthk,bthv->bhkv', wk, k, v)
    n_new = decay[..., None] * n + jnp.einsum('bth,bthk->bhk', wk, k)
    return (C_new, n_new, m_new), h


def mlstm_prompt(q, k, v, ig, lf):
    B, L = q.shape[:2]
    pad = (-L) % CHUNK

    def padt(a, val):
        return jnp.pad(a, ((0, 0), (pad, 0)) + ((0, 0),) * (a.ndim - 2), constant_values=val)

    q, k, v, lf = padt(q, 0.0), padt(k, 0.0), padt(v, 0.0), padt(lf, 0.0)
    ig = padt(ig, PAD_LOG_GATE)
    nc = (L + pad) // CHUNK

    def to_chunks(a):
        return a.reshape((B, nc, CHUNK) + a.shape[2:]).swapaxes(0, 1)

    init = (jnp.zeros((B, ML_HEADS, ML_HEAD_DIM, ML_HEAD_DIM), jnp.float32),
            jnp.zeros((B, ML_HEADS, ML_HEAD_DIM), jnp.float32),
            jnp.zeros((B, ML_HEADS), jnp.float32))
    state, h = lax.scan(mlstm_chunk, init, (to_chunks(q), to_chunks(k), to_chunks(v), to_chunks(ig), to_chunks(lf)))
    h = h.swapaxes(0, 1).reshape(B, L + pad, ML_HEADS, ML_HEAD_DIM)[:, pad:]
    return state, h


def token_mixers(h, p, cache):
    B, T, _ = h.shape
    f32 = jnp.float32
    z = h @ p['w_in'] + p['b_in']
    fq, fk, fv, ff, mx, mv, mo, mi, mf, ga, gb = jnp.split(z, SPLIT_IDX, axis=-1)
    fq = rmsnorm(fq.reshape(B, T, FOX_HEADS, FOX_HEAD_DIM), p['g_fq'])
    fk = rmsnorm(fk.reshape(B, T, FOX_HEADS, FOX_HEAD_DIM), p['g_fk'])
    fv = fv.reshape(B, T, FOX_HEADS, FOX_HEAD_DIM)
    logf = jax.nn.log_sigmoid(ff.astype(f32))
    if cache is None:
        F = jnp.cumsum(logf, axis=1)
        a = fox_prompt(fq, fk, fv, F)
        conv_prev = jnp.zeros((B, CONV_WIDTH - 1, ML_WIDTH), h.dtype)
    else:
        P = cache['fox_k'].shape[1]
        k_all = jnp.concatenate([cache['fox_k'].astype(fk.dtype), fk], axis=1)
        v_all = jnp.concatenate([cache['fox_v'].astype(fv.dtype), fv], axis=1)
        F = jnp.cumsum(jnp.concatenate([cache['fox_logf'].astype(f32), logf], axis=1), axis=1)
        a = fox_block(fq, F[:, P:], P + jnp.arange(T), k_all, v_all, F)
        conv_prev = cache['conv']
    xc, conv_new = causal_conv(mx, conv_prev, p['w_conv'], p['b_conv'])
    xc = jax.nn.silu(xc)
    xch = xc.reshape(B, T, ML_HEADS, ML_HEAD_DIM)
    mq = jnp.einsum('bthd,hde->bthe', xch, p['w_mq']).astype(f32)
    mk = (jnp.einsum('bthd,hde->bthe', xch, p['w_mk']) * (ML_HEAD_DIM ** -0.5)).astype(f32)
    mvh = mv.reshape(B, T, ML_HEADS, ML_HEAD_DIM).astype(f32)
    ig = mi.astype(f32)
    lfm = jax.nn.log_sigmoid(mf.astype(f32))
    if cache is None:
        (C, n, m), hcell = mlstm_prompt(mq, mk, mvh, ig, lfm)
    else:
        st = (cache['C'].astype(f32), cache['n'].astype(f32), cache['m'].astype(f32))
        (C, n, m), hcell = mlstm_chunk(st, (mq, mk, mvh, ig, lfm))
    og = jax.nn.sigmoid(mo.astype(f32)).reshape(B, T, ML_HEADS, ML_HEAD_DIM)
    hm = rmsnorm(og * hcell, p['g_mnorm']).reshape(B, T, ML_WIDTH).astype(h.dtype) + p['skip_m'] * xc
    ya = a.reshape(B, T, FOX_WIDTH) @ p['w_fox_proj']
    yb = hm @ p['w_ml_proj']
    merged = jax.nn.sigmoid(ga) * ya + jax.nn.sigmoid(gb) * yb
    out = merged @ p['w_out']
    return out, (fk, fv, logf, C, n, m, conv_new)


def trunk_layer(x, p, cache):
    h = rmsnorm(x, p['g_pre_mix'])
    mix, st = token_mixers(h, p, cache)
    x = x + rmsnorm(mix, p['g_post_mix'])
    h = rmsnorm(x, p['g_pre_ffn'])
    g, u = jnp.split(h @ p['w_gate_up'], 2, axis=-1)
    f = (jax.nn.silu(g) * u) @ p['w_down']
    x = x + rmsnorm(f, p['g_post_ffn'])
    return x, st


def stack_layers(per_layer):
    return [jnp.stack(arrs) for arrs in zip(*per_layer)]


def setup_inputs(seed: int = 0) -> dict:
    key = jax.random.key(seed)
    ks = iter(jax.random.split(key, 48))

    def nrm(shape, s=1.0):
        return s * jax.random.normal(next(ks), shape, jnp.float32)

    b_in = jnp.concatenate([
        nrm((DEPTH, 3 * FOX_WIDTH), 0.02),
        2.0 + nrm((DEPTH, FOX_HEADS), 0.5),
        nrm((DEPTH, 3 * ML_WIDTH), 0.02),
        nrm((DEPTH, ML_HEADS), 0.1),
        jnp.linspace(3.0, 6.0, ML_HEADS)[None, :] + nrm((DEPTH, ML_HEADS), 0.1),
        nrm((DEPTH, 2 * D_MODEL), 0.02)], axis=-1)
    return {
        'x_prompt': nrm((BATCH, SEQ, D_MODEL)),
        'x_sample': nrm((DEC_BATCH, DEC_SEQ, D_MODEL)),
        'cache_fox_k': nrm((DEPTH, DEC_BATCH, PAST_LEN, FOX_HEADS, FOX_HEAD_DIM)),
        'cache_fox_v': nrm((DEPTH, DEC_BATCH, PAST_LEN, FOX_HEADS, FOX_HEAD_DIM)),
        'cache_fox_logf': jax.nn.log_sigmoid(2.0 + nrm((DEPTH, DEC_BATCH, PAST_LEN, FOX_HEADS), 0.5)),
        'state_mlstm_C': nrm((DEPTH, DEC_BATCH, ML_HEADS, ML_HEAD_DIM, ML_HEAD_DIM), 0.1),
        'state_mlstm_n': nrm((DEPTH, DEC_BATCH, ML_HEADS, ML_HEAD_DIM), 0.5),
        'state_mlstm_m': nrm((DEPTH, DEC_BATCH, ML_HEADS)),
        'state_mlstm_conv': nrm((DEPTH, DEC_BATCH, CONV_WIDTH - 1, ML_WIDTH)),
        'meta_tokens': nrm((N_META, D_MODEL)),
        'w_in': nrm((DEPTH, D_MODEL, D_IN), D_MODEL ** -0.5),
        'b_in': b_in,
        'g_fq': 1.0 + nrm((DEPTH, FOX_HEADS, FOX_HEAD_DIM), 0.05),
        'g_fk': 1.0 + nrm((DEPTH, FOX_HEADS, FOX_HEAD_DIM), 0.05),
        'w_conv': nrm((DEPTH, CONV_WIDTH, ML_WIDTH), CONV_WIDTH ** -0.5),
        'b_conv': nrm((DEPTH, ML_WIDTH), 0.02),
        'w_mq': nrm((DEPTH, ML_HEADS, ML_HEAD_DIM, ML_HEAD_DIM), ML_HEAD_DIM ** -0.5),
        'w_mk': nrm((DEPTH, ML_HEADS, ML_HEAD_DIM, ML_HEAD_DIM), ML_HEAD_DIM ** -0.5),
        'g_mnorm': 1.0 + nrm((DEPTH, ML_HEADS, ML_HEAD_DIM), 0.05),
        'skip_m': 1.0 + nrm((DEPTH, ML_WIDTH), 0.05),
        'w_fox_proj': nrm((DEPTH, FOX_WIDTH, D_MODEL), FOX_WIDTH ** -0.5),
        'w_ml_proj': nrm((DEPTH, ML_WIDTH, D_MODEL), ML_WIDTH ** -0.5),
        'w_out': nrm((DEPTH, D_MODEL, D_MODEL), D_MODEL ** -0.5),
        'g_pre_mix': 1.0 + nrm((DEPTH, D_MODEL), 0.05),
        'g_post_mix': 1.0 + nrm((DEPTH, D_MODEL), 0.05),
        'g_pre_ffn': 1.0 + nrm((DEPTH, D_MODEL), 0.05),
        'g_post_ffn': 1.0 + nrm((DEPTH, D_MODEL), 0.05),
        'w_gate_up': nrm((DEPTH, D_MODEL, 2 * D_FF), D_MODEL ** -0.5),
        'w_down': nrm((DEPTH, D_FF, D_MODEL), D_FF ** -0.5),
    }


def reference(x_prompt, x_sample, cache_fox_k, cache_fox_v, cache_fox_logf, state_mlstm_C, state_mlstm_n,
              state_mlstm_m, state_mlstm_conv, meta_tokens, w_in, b_in, g_fq, g_fk, w_conv, b_conv, w_mq, w_mk,
              g_mnorm, skip_m, w_fox_proj, w_ml_proj, w_out, g_pre_mix, g_post_mix, g_pre_ffn, g_post_ffn,
              w_gate_up, w_down):
    B = x_prompt.shape[0]
    meta = jnp.broadcast_to(meta_tokens.astype(x_prompt.dtype)[None], (B, N_META, meta_tokens.shape[-1]))
    xp = jnp.concatenate([meta, x_prompt], axis=1)
    xs = x_sample
    prompt_states, sample_states = [], []
    for l in range(DEPTH):
        p = dict(w_in=w_in[l], b_in=b_in[l], g_fq=g_fq[l], g_fk=g_fk[l], w_conv=w_conv[l], b_conv=b_conv[l],
                 w_mq=w_mq[l], w_mk=w_mk[l], g_mnorm=g_mnorm[l], skip_m=skip_m[l], w_fox_proj=w_fox_proj[l],
                 w_ml_proj=w_ml_proj[l], w_out=w_out[l], g_pre_mix=g_pre_mix[l], g_post_mix=g_post_mix[l],
                 g_pre_ffn=g_pre_ffn[l], g_post_ffn=g_post_ffn[l], w_gate_up=w_gate_up[l], w_down=w_down[l])
        xp, stp = trunk_layer(xp, p, None)
        cache = dict(fox_k=cache_fox_k[l], fox_v=cache_fox_v[l], fox_logf=cache_fox_logf[l],
                     C=state_mlstm_C[l], n=state_mlstm_n[l], m=state_mlstm_m[l], conv=state_mlstm_conv[l])
        xs, sts = trunk_layer(xs, p, cache)
        prompt_states.append(stp)
        sample_states.append(sts)
    fox_k_p, fox_v_p, fox_logf_p, mlstm_C_p, mlstm_n_p, mlstm_m_p, mlstm_conv_p = stack_layers(prompt_states)
    fox_k_s, fox_v_s, fox_logf_s, mlstm_C_s, mlstm_n_s, mlstm_m_s, mlstm_conv_s = stack_layers(sample_states)
    y_prompt = xp[:, N_META:]
    y_sample = xs
    return (y_prompt, y_sample, fox_k_p, fox_v_p, fox_logf_p, mlstm_C_p, mlstm_n_p, mlstm_m_p, mlstm_conv_p,
            fox_k_s, fox_v_s, fox_logf_s, mlstm_C_s, mlstm_n_s, mlstm_m_s, mlstm_conv_s)
```

```cpp
#include <hip/hip_runtime.h>
#include <hip/hip_cooperative_groups.h>
#include <cstdio>
#include <cstdint>
namespace cg = cooperative_groups;

#ifndef MEGA
#define MEGA 0
#endif

constexpr int D = 1024, NB = 8, SEQ = 4096, NMETA = 16, LP = NMETA + SEQ, DEC_T = 64, PAST = 1024;
constexpr int FH = 8, FD = 64, FW = 512, MH = 4, MD = 128, MW = 512;
constexpr int DFF = 2816, DIN = 5136;
constexpr int O_FQ = 0, O_FK = 512, O_FV = 1024, O_FF = 1536, O_MX = 1544, O_MV = 2056, O_MO = 2568, O_MI = 3080, O_MF = 3084, O_GA = 3088, O_GB = 4112;
constexpr float EPS = 1e-6f;
constexpr size_t OUT_YP = 0;
constexpr size_t OUT_YS = OUT_YP + (size_t)NB * SEQ * D;
constexpr size_t OUT_FKP = OUT_YS + (size_t)NB * DEC_T * D;
constexpr size_t OUT_FVP = OUT_FKP + (size_t)NB * LP * FW;
constexpr size_t OUT_LFP = OUT_FVP + (size_t)NB * LP * FW;
constexpr size_t OUT_CP = OUT_LFP + (size_t)NB * LP * FH;
constexpr size_t OUT_NP = OUT_CP + (size_t)NB * MH * MD * MD;
constexpr size_t OUT_MP = OUT_NP + (size_t)NB * MH * MD;
constexpr size_t OUT_CVP = OUT_MP + (size_t)NB * MH;
constexpr size_t OUT_FKS = OUT_CVP + (size_t)NB * 3 * MW;
constexpr size_t OUT_FVS = OUT_FKS + (size_t)NB * DEC_T * FW;
constexpr size_t OUT_LFS = OUT_FVS + (size_t)NB * DEC_T * FW;
constexpr size_t OUT_CS = OUT_LFS + (size_t)NB * DEC_T * FH;
constexpr size_t OUT_NS = OUT_CS + (size_t)NB * MH * MD * MD;
constexpr size_t OUT_MS = OUT_NS + (size_t)NB * MH * MD;
constexpr size_t OUT_CVS = OUT_MS + (size_t)NB * MH;
constexpr size_t OUT_TOTAL = OUT_CVS + (size_t)NB * 3 * MW;

constexpr size_t TM = LP;
constexpr size_t W_H = 0;
constexpr size_t W_Z = W_H + TM * D;
constexpr size_t W_LOGF = W_Z + TM * DIN;
constexpr size_t W_FC = W_LOGF + TM * FH;
constexpr size_t W_AT = W_FC + (TM + PAST) * FH;
constexpr size_t W_XC = W_AT + TM * FW;
constexpr size_t W_MQ = W_XC + TM * MW;
constexpr size_t W_MK = W_MQ + TM * MW;
constexpr size_t W_NUM = W_MK + TM * MW;
constexpr size_t W_DEN = W_NUM + TM * MW;
constexpr size_t W_MT = W_DEN + TM * MH;
constexpr size_t W_HM = W_MT + TM * MH;
constexpr size_t W_YA = W_HM + TM * MW;
constexpr size_t W_YB = W_YA + TM * D;
constexpr size_t W_OB = W_YB + TM * D;
constexpr size_t W_X1 = W_OB + TM * D;
constexpr size_t W_H2 = W_X1 + TM * D;
constexpr size_t W_GU = W_H2 + TM * D;
constexpr size_t W_ACT = W_GU + TM * 2 * DFF;
constexpr size_t W_FFO = W_ACT + TM * DFF;
constexpr size_t W_END = W_FFO + TM * D;

struct Params {
    const float* in[29];
    float* out;
    float* ws;
    int item_lo, item_hi, stage_lo, stage_hi;
};

enum { I_XP = 0, I_XS, I_CK, I_CV, I_CLF, I_SC, I_SN, I_SM, I_SCV, I_META, I_WIN, I_BIN, I_GFQ, I_GFK, I_WCONV, I_BCONV, I_WMQ, I_WMK, I_GMN, I_SKIP,
       I_WFOX, I_WML, I_WOUT, I_GPRE, I_GPOST, I_GPREF, I_GPOSTF, I_WGU, I_WDN };

__device__ __forceinline__ float wave_sum(float v) {
#pragma unroll
    for (int o = 1; o < 64; o <<= 1) v += __shfl_xor(v, o);
    return v;
}
__device__ __forceinline__ float wave_max(float v) {
#pragma unroll
    for (int o = 1; o < 64; o <<= 1) v = fmaxf(v, __shfl_xor(v, o));
    return v;
}
__device__ __forceinline__ float sigmoidf_(float x) { return 1.f / (1.f + expf(-x)); }
__device__ __forceinline__ float logsigmoidf_(float x) { return fminf(x, 0.f) - log1pf(expf(-fabsf(x))); }
__device__ __forceinline__ float siluf_(float x) { return x * sigmoidf_(x); }

struct Item { int T; int b; bool samp; };
__device__ __forceinline__ Item get_item(int it) { Item I; I.samp = it >= NB; I.b = I.samp ? it - NB : it; I.T = I.samp ? DEC_T : LP; return I; }

__device__ __forceinline__ const float* xrow(const Params& P, const Item& I, int t) {
    if (I.samp) return P.in[I_XS] + ((size_t)I.b * DEC_T + t) * D;
    if (t < NMETA) return P.in[I_META] + (size_t)t * D;
    return P.in[I_XP] + ((size_t)I.b * SEQ + (t - NMETA)) * D;
}

__device__ __forceinline__ void sgemm(const float* A, int lda, const float* B, int ldb, float* C, int ldc, int M, int N, int K, const float* bias, float alpha, float* sm) {
    float (*As)[68] = (float (*)[68])sm;
    float (*Bs)[68] = (float (*)[68])(sm + 16 * 68);
    const int tid = threadIdx.x, tx = tid & 15, ty = tid >> 4;
    const int nbn = (N + 63) / 64, nbm = (M + 63) / 64;
    for (int vb = blockIdx.x; vb < nbm * nbn; vb += gridDim.x) {
        const int bm = vb / nbn, bn = vb % nbn;
        float acc[4][4];
#pragma unroll
        for (int i = 0; i < 4; ++i)
#pragma unroll
            for (int j = 0; j < 4; ++j) acc[i][j] = 0.f;
        for (int k0 = 0; k0 < K; k0 += 16) {
            {
                const int r = tid >> 2, kq = (tid & 3) * 4, gr = bm * 64 + r;
                float4 v = make_float4(0.f, 0.f, 0.f, 0.f);
                if (gr < M) v = *(const float4*)(A + (size_t)gr * lda + k0 + kq);
                As[kq + 0][r] = v.x; As[kq + 1][r] = v.y; As[kq + 2][r] = v.z; As[kq + 3][r] = v.w;
            }
            {
                const int kk = tid >> 4, nq = (tid & 15) * 4, gn = bn * 64 + nq;
                float4 v = make_float4(0.f, 0.f, 0.f, 0.f);
                if (gn < N) v = *(const float4*)(B + (size_t)(k0 + kk) * ldb + gn);
                *(float4*)&Bs[kk][nq] = v;
            }
            __syncthreads();
#pragma unroll
            for (int kk = 0; kk < 16; ++kk) {
                const float4 a = *(const float4*)&As[kk][ty * 4];
                const float4 b = *(const float4*)&Bs[kk][tx * 4];
                const float av[4] = {a.x, a.y, a.z, a.w}, bv[4] = {b.x, b.y, b.z, b.w};
#pragma unroll
                for (int i = 0; i < 4; ++i)
#pragma unroll
                    for (int j = 0; j < 4; ++j) acc[i][j] += av[i] * bv[j];
            }
            __syncthreads();
        }
#pragma unroll
        for (int i = 0; i < 4; ++i) {
            const int gr = bm * 64 + ty * 4 + i;
            if (gr < M) {
                const int gn = bn * 64 + tx * 4;
                if (gn < N) {
                    float4 o;
                    o.x = alpha * acc[i][0] + (bias ? bias[gn + 0] : 0.f);
                    o.y = alpha * acc[i][1] + (bias ? bias[gn + 1] : 0.f);
                    o.z = alpha * acc[i][2] + (bias ? bias[gn + 2] : 0.f);
                    o.w = alpha * acc[i][3] + (bias ? bias[gn + 3] : 0.f);
                    *(float4*)(C + (size_t)gr * ldc + gn) = o;
                }
            }
        }
    }
}

__device__ __forceinline__ void st_norm_in(const Params& P, const Item& I) {
    const int lane = threadIdx.x & 63, wv = threadIdx.x >> 6;
    float* H = P.ws + W_H;
    const float* g = P.in[I_GPRE];
    for (int t = blockIdx.x * 4 + wv; t < I.T; t += gridDim.x * 4) {
        const float* x = xrow(P, I, t);
        float v[16]; float ss = 0.f;
#pragma unroll
        for (int j = 0; j < 16; ++j) { v[j] = x[lane + 64 * j]; ss += v[j] * v[j]; }
        ss = wave_sum(ss);
        const float r = rsqrtf(ss * (1.f / D) + EPS);
#pragma unroll
        for (int j = 0; j < 16; ++j) H[(size_t)t * D + lane + 64 * j] = v[j] * r * g[lane + 64 * j];
    }
}
__device__ __forceinline__ void st_fox_prep(const Params& P, const Item& I) {
    const int lane = threadIdx.x & 63, wv = threadIdx.x >> 6;
    float* Z = P.ws + W_Z; float* LOGF = P.ws + W_LOGF;
    float* ok = P.out + (I.samp ? OUT_FKS + (size_t)I.b * DEC_T * FW : OUT_FKP + (size_t)I.b * LP * FW);
    float* ov = P.out + (I.samp ? OUT_FVS + (size_t)I.b * DEC_T * FW : OUT_FVP + (size_t)I.b * LP * FW);
    float* olf = P.out + (I.samp ? OUT_LFS + (size_t)I.b * DEC_T * FH : OUT_LFP + (size_t)I.b * LP * FH);
    for (int t = blockIdx.x * 4 + wv; t < I.T; t += gridDim.x * 4) {
        float* z = Z + (size_t)t * DIN;
        const int c0 = lane * 8;
        float q[8], k[8]; float sq = 0.f, sk = 0.f;
#pragma unroll
        for (int j = 0; j < 8; ++j) { q[j] = z[O_FQ + c0 + j]; k[j] = z[O_FK + c0 + j]; sq += q[j] * q[j]; sk += k[j] * k[j]; }
#pragma unroll
        for (int o = 1; o < 8; o <<= 1) { sq += __shfl_xor(sq, o); sk += __shfl_xor(sk, o); }
        const float rq = rsqrtf(sq * (1.f / FD) + EPS), rk = rsqrtf(sk * (1.f / FD) + EPS);
#pragma unroll
        for (int j = 0; j < 8; ++j) {
            const float qn = q[j] * rq * P.in[I_GFQ][c0 + j], kn = k[j] * rk * P.in[I_GFK][c0 + j];
            z[O_FQ + c0 + j] = qn; z[O_FK + c0 + j] = kn;
            ok[(size_t)t * FW + c0 + j] = kn;
            ov[(size_t)t * FW + c0 + j] = z[O_FV + c0 + j];
        }
        if (lane < FH) { const float lf = logsigmoidf_(z[O_FF + lane]); LOGF[(size_t)t * FH + lane] = lf; olf[(size_t)t * FH + lane] = lf; }
    }
}
__device__ __forceinline__ void st_fcum(const Params& P, const Item& I) {
    if (blockIdx.x != 0 || threadIdx.x >= FH) return;
    const int h = threadIdx.x;
    float* FC = P.ws + W_FC; const float* LOGF = P.ws + W_LOGF;
    float acc = 0.f; int base = 0;
    if (I.samp) {
        const float* cl = P.in[I_CLF] + (size_t)I.b * PAST * FH;
        for (int i = 0; i < PAST; ++i) { acc += cl[(size_t)i * FH + h]; FC[(size_t)i * FH + h] = acc; }
        base = PAST;
    }
    for (int t = 0; t < I.T; ++t) { acc += LOGF[(size_t)t * FH + h]; FC[(size_t)(base + t) * FH + h] = acc; }
}
__device__ __forceinline__ void st_attn(const Params& P, const Item& I, float* sm) {
    const int lane = threadIdx.x & 63, wv = threadIdx.x >> 6;
    const float* Z = P.ws + W_Z; const float* FC = P.ws + W_FC; float* AT = P.ws + W_AT;
    float* qs = sm + wv * 64;
    const int base = I.samp ? PAST : 0;
    const float* ck = P.in[I_CK] + (size_t)I.b * PAST * FW;
    const float* cv = P.in[I_CV] + (size_t)I.b * PAST * FW;
    const int nunits = I.T * FH;
    for (int u = blockIdx.x * 4 + wv; u < nunits; u += gridDim.x * 4) {
        const int t = u / FH, h = u % FH;
        qs[lane] = Z[(size_t)t * DIN + O_FQ + h * FD + lane];
        __builtin_amdgcn_wave_barrier();
        const int qpos = base + t;
        const float Fq = FC[(size_t)qpos * FH + h];
        float m = -INFINITY, l = 0.f; float o[64];
#pragma unroll
        for (int d = 0; d < 64; ++d) o[d] = 0.f;
        for (int i = lane; i <= qpos; i += 64) {
            const float* kr; const float* vr;
            if (i < base) { kr = ck + (size_t)i * FW + h * FD; vr = cv + (size_t)i * FW + h * FD; }
            else { kr = Z + (size_t)(i - base) * DIN + O_FK + h * FD; vr = Z + (size_t)(i - base) * DIN + O_FV + h * FD; }
            float dot = 0.f;
#pragma unroll
            for (int d = 0; d < 64; d += 4) { const float4 kk = *(const float4*)(kr + d); dot += kk.x * qs[d] + kk.y * qs[d + 1] + kk.z * qs[d + 2] + kk.w * qs[d + 3]; }
            const float sc = dot * 0.125f + (Fq - FC[(size_t)i * FH + h]);
            const float mn = fmaxf(m, sc), corr = expf(m - mn), p = expf(sc - mn);
            l = l * corr + p;
#pragma unroll
            for (int d = 0; d < 64; d += 4) { const float4 vv = *(const float4*)(vr + d);
                o[d] = o[d] * corr + p * vv.x; o[d + 1] = o[d + 1] * corr + p * vv.y; o[d + 2] = o[d + 2] * corr + p * vv.z; o[d + 3] = o[d + 3] * corr + p * vv.w; }
            m = mn;
        }
        const float Mx = wave_max(m);
        const float sc_l = (m == -INFINITY) ? 0.f : expf(m - Mx);
        const float L = wave_sum(l * sc_l);
        float mine = 0.f;
#pragma unroll
        for (int d = 0; d < 64; ++d) { const float s = wave_sum(o[d] * sc_l); if (lane == d) mine = s; }
        AT[(size_t)t * FW + h * FD + lane] = mine / L;
    }
}
__device__ __forceinline__ void st_conv(const Params& P, const Item& I) {
    const float* Z = P.ws + W_Z; float* XC = P.ws + W_XC;
    const float* wc = P.in[I_WCONV]; const float* bc = P.in[I_BCONV];
    const float* prev = P.in[I_SCV] + (size_t)I.b * 3 * MW;
    const int n = I.T * MW;
    for (int e = blockIdx.x * blockDim.x + threadIdx.x; e < n; e += gridDim.x * blockDim.x) {
        const int t = e / MW, c = e % MW;
        float y = bc[c];
#pragma unroll
        for (int i = 0; i < 4; ++i) {
            const int u = t + i - 3;
            float s;
            if (u >= 0) s = Z[(size_t)u * DIN + O_MX + c]; else s = I.samp ? prev[(size_t)(u + 3) * MW + c] : 0.f;
            y += wc[i * MW + c] * s;
        }
        XC[e] = siluf_(y);
    }
    float* oc = P.out + (I.samp ? OUT_CVS : OUT_CVP) + (size_t)I.b * 3 * MW;
    for (int e = blockIdx.x * blockDim.x + threadIdx.x; e < 3 * MW; e += gridDim.x * blockDim.x) {
        const int j = e / MW, c = e % MW;
        oc[e] = Z[(size_t)(I.T - 3 + j) * DIN + O_MX + c];
    }
}
__device__ __forceinline__ void st_mlstm(const Params& P, const Item& I, float* sm) {
    if (blockIdx.x >= MH) return;
    const int h = blockIdx.x, j = threadIdx.x;
    const float* Z = P.ws + W_Z; const float* MQ = P.ws + W_MQ; const float* MK = P.ws + W_MK;
    float* NUM = P.ws + W_NUM; float* DEN = P.ws + W_DEN; float* MT = P.ws + W_MT;
    float* qs = sm;
    float* ks = sm + 8 * 128;
    float c[128];
    float m = 0.f;
    if (I.samp) {
        m = P.in[I_SM][I.b * MH + h];
        const float* C0 = P.in[I_SC] + ((size_t)I.b * MH + h) * MD * MD;
        const float* n0 = P.in[I_SN] + ((size_t)I.b * MH + h) * MD;
#pragma unroll
        for (int dk = 0; dk < 128; ++dk) c[dk] = (j < 128) ? C0[(size_t)dk * MD + j] : (j == 128 ? n0[dk] : 0.f);
    } else {
#pragma unroll
        for (int dk = 0; dk < 128; ++dk) c[dk] = 0.f;
    }
    for (int t0 = 0; t0 < I.T; t0 += 8) {
        __syncthreads();
        for (int e = threadIdx.x; e < 8 * 128; e += blockDim.x) {
            const int tt = e >> 7, d = e & 127;
            const bool ok = (t0 + tt) < I.T;
            qs[e] = ok ? MQ[(size_t)(t0 + tt) * MW + h * MD + d] : 0.f;
            ks[e] = ok ? MK[(size_t)(t0 + tt) * MW + h * MD + d] : 0.f;
        }
        __syncthreads();
        const int nt = (I.T - t0) < 8 ? (I.T - t0) : 8;
        for (int tt = 0; tt < nt; ++tt) {
            const int t = t0 + tt;
            const float* z = Z + (size_t)t * DIN;
            const float lf = logsigmoidf_(z[O_MF + h]), ig = z[O_MI + h];
            const float mn = fmaxf(lf + m, ig);
            const float a = expf(lf + m - mn), bb = expf(ig - mn);
            const float vj = (j < 128) ? z[O_MV + h * MD + j] : 1.f;
            const float bv = bb * vj;
            float acc0 = 0.f, acc1 = 0.f, acc2 = 0.f, acc3 = 0.f;
#pragma unroll
            for (int dk = 0; dk < 128; dk += 4) {
                const float4 kk = *(const float4*)(ks + tt * 128 + dk);
                const float4 qq = *(const float4*)(qs + tt * 128 + dk);
                c[dk] = a * c[dk] + bv * kk.x; acc0 += qq.x * c[dk];
                c[dk + 1] = a * c[dk + 1] + bv * kk.y; acc1 += qq.y * c[dk + 1];
                c[dk + 2] = a * c[dk + 2] + bv * kk.z; acc2 += qq.z * c[dk + 2];
                c[dk + 3] = a * c[dk + 3] + bv * kk.w; acc3 += qq.w * c[dk + 3];
            }
            const float acc = (acc0 + acc1) + (acc2 + acc3);
            if (j < 128) NUM[(size_t)t * MW + h * MD + j] = acc;
            else if (j == 128) { DEN[(size_t)t * MH + h] = acc; MT[(size_t)t * MH + h] = mn; }
            m = mn;
        }
    }
    float* oC = P.out + (I.samp ? OUT_CS : OUT_CP) + ((size_t)I.b * MH + h) * MD * MD;
    float* on = P.out + (I.samp ? OUT_NS : OUT_NP) + ((size_t)I.b * MH + h) * MD;
    float* om = P.out + (I.samp ? OUT_MS : OUT_MP) + (size_t)I.b * MH + h;
#pragma unroll
    for (int dk = 0; dk < 128; ++dk) { if (j < 128) oC[(size_t)dk * MD + j] = c[dk]; else if (j == 128) on[dk] = c[dk]; }
    if (j == 0) *om = m;
}
__device__ __forceinline__ void st_hm(const Params& P, const Item& I) {
    const int lane = threadIdx.x & 63, wv = threadIdx.x >> 6;
    const float* Z = P.ws + W_Z; const float* NUM = P.ws + W_NUM; const float* DEN = P.ws + W_DEN; const float* MT = P.ws + W_MT; const float* XC = P.ws + W_XC;
    float* HM = P.ws + W_HM;
    for (int t = blockIdx.x * 4 + wv; t < I.T; t += gridDim.x * 4) {
        const int c0 = lane * 8, h = lane >> 4;
        const float den = DEN[(size_t)t * MH + h], mt = MT[(size_t)t * MH + h];
        const float dd = fmaxf(fabsf(den), expf(-mt));
        float v[8]; float ss = 0.f;
#pragma unroll
        for (int jj = 0; jj < 8; ++jj) { const float hc = NUM[(size_t)t * MW + c0 + jj] / dd; v[jj] = sigmoidf_(Z[(size_t)t * DIN + O_MO + c0 + jj]) * hc; ss += v[jj] * v[jj]; }
#pragma unroll
        for (int o = 1; o < 16; o <<= 1) ss += __shfl_xor(ss, o);
        const float r = rsqrtf(ss * (1.f / MD) + EPS);
#pragma unroll
        for (int jj = 0; jj < 8; ++jj) HM[(size_t)t * MW + c0 + jj] = v[jj] * r * P.in[I_GMN][c0 + jj] + P.in[I_SKIP][c0 + jj] * XC[(size_t)t * MW + c0 + jj];
    }
}
__device__ __forceinline__ void st_merge(const Params& P, const Item& I) {
    const float* Z = P.ws + W_Z; float* YA = P.ws + W_YA; const float* YB = P.ws + W_YB;
    const int n = I.T * D;
    for (int e = blockIdx.x * blockDim.x + threadIdx.x; e < n; e += gridDim.x * blockDim.x) {
        const int t = e / D, c = e % D;
        YA[e] = sigmoidf_(Z[(size_t)t * DIN + O_GA + c]) * YA[e] + sigmoidf_(Z[(size_t)t * DIN + O_GB + c]) * YB[e];
    }
}
__device__ __forceinline__ void st_mid(const Params& P, const Item& I) {
    const int lane = threadIdx.x & 63, wv = threadIdx.x >> 6;
    const float* OB = P.ws + W_OB; float* X1 = P.ws + W_X1; float* H2 = P.ws + W_H2;
    for (int t = blockIdx.x * 4 + wv; t < I.T; t += gridDim.x * 4) {
        const float* x = xrow(P, I, t);
        float v[16]; float ss = 0.f;
#pragma unroll
        for (int jj = 0; jj < 16; ++jj) { v[jj] = OB[(size_t)t * D + lane + 64 * jj]; ss += v[jj] * v[jj]; }
        ss = wave_sum(ss);
        const float r = rsqrtf(ss * (1.f / D) + EPS);
        float s2 = 0.f;
#pragma unroll
        for (int jj = 0; jj < 16; ++jj) { v[jj] = x[lane + 64 * jj] + v[jj] * r * P.in[I_GPOST][lane + 64 * jj]; s2 += v[jj] * v[jj]; }
        s2 = wave_sum(s2);
        const float r2 = rsqrtf(s2 * (1.f / D) + EPS);
#pragma unroll
        for (int jj = 0; jj < 16; ++jj) { X1[(size_t)t * D + lane + 64 * jj] = v[jj]; H2[(size_t)t * D + lane + 64 * jj] = v[jj] * r2 * P.in[I_GPREF][lane + 64 * jj]; }
    }
}
__device__ __forceinline__ void st_act(const Params& P, const Item& I) {
    const float* GU = P.ws + W_GU; float* ACT = P.ws + W_ACT;
    const int n = I.T * DFF;
    for (int e = blockIdx.x * blockDim.x + threadIdx.x; e < n; e += gridDim.x * blockDim.x) {
        const int t = e / DFF, c = e % DFF;
        ACT[e] = siluf_(GU[(size_t)t * 2 * DFF + c]) * GU[(size_t)t * 2 * DFF + DFF + c];
    }
}
__device__ __forceinline__ void st_final(const Params& P, const Item& I) {
    const int lane = threadIdx.x & 63, wv = threadIdx.x >> 6;
    const float* FFO = P.ws + W_FFO; const float* X1 = P.ws + W_X1;
    for (int t = blockIdx.x * 4 + wv; t < I.T; t += gridDim.x * 4) {
        float* y;
        if (I.samp) y = P.out + OUT_YS + ((size_t)I.b * DEC_T + t) * D;
        else { if (t < NMETA) continue; y = P.out + OUT_YP + ((size_t)I.b * SEQ + (t - NMETA)) * D; }
        float v[16]; float ss = 0.f;
#pragma unroll
        for (int jj = 0; jj < 16; ++jj) { v[jj] = FFO[(size_t)t * D + lane + 64 * jj]; ss += v[jj] * v[jj]; }
        ss = wave_sum(ss);
        const float r = rsqrtf(ss * (1.f / D) + EPS);
#pragma unroll
        for (int jj = 0; jj < 16; ++jj) y[lane + 64 * jj] = X1[(size_t)t * D + lane + 64 * jj] + v[jj] * r * P.in[I_GPOSTF][lane + 64 * jj];
    }
}

constexpr int NSTAGE = 17;
template <int s> __device__ __forceinline__ void run_stage(const Params& P, const Item& I, float* sm) {
    float* ws = P.ws;
    switch (s) {
    case 0: st_norm_in(P, I); break;
    case 1: sgemm(ws + W_H, D, P.in[I_WIN], DIN, ws + W_Z, DIN, I.T, DIN, D, P.in[I_BIN], 1.f, sm); break;
    case 2: st_fox_prep(P, I); break;
    case 3: st_fcum(P, I); break;
    case 4: st_attn(P, I, sm); break;
    case 5: st_conv(P, I); break;
    case 6:
        for (int h = 0; h < MH; ++h) {
            sgemm(ws + W_XC + h * MD, MW, P.in[I_WMQ] + (size_t)h * MD * MD, MD, ws + W_MQ + h * MD, MW, I.T, MD, MD, nullptr, 1.f, sm);
            sgemm(ws + W_XC + h * MD, MW, P.in[I_WMK] + (size_t)h * MD * MD, MD, ws + W_MK + h * MD, MW, I.T, MD, MD, nullptr, 0.08838834764831845f, sm);
        }
        break;
    case 7: st_mlstm(P, I, sm); break;
    case 8: st_hm(P, I); break;
    case 9:
        sgemm(ws + W_AT, FW, P.in[I_WFOX], D, ws + W_YA, D, I.T, D, FW, nullptr, 1.f, sm);
        sgemm(ws + W_HM, MW, P.in[I_WML], D, ws + W_YB, D, I.T, D, MW, nullptr, 1.f, sm);
        break;
    case 10: st_merge(P, I); break;
    case 11: sgemm(ws + W_YA, D, P.in[I_WOUT], D, ws + W_OB, D, I.T, D, D, nullptr, 1.f, sm); break;
    case 12: st_mid(P, I); break;
    case 13: sgemm(ws + W_H2, D, P.in[I_WGU], 2 * DFF, ws + W_GU, 2 * DFF, I.T, 2 * DFF, D, nullptr, 1.f, sm); break;
    case 14: st_act(P, I); break;
    case 15: sgemm(ws + W_ACT, DFF, P.in[I_WDN], D, ws + W_FFO, D, I.T, D, DFF, nullptr, 1.f, sm); break;
    case 16: st_final(P, I); break;
    }
}

template <int s> __global__ void __launch_bounds__(256) stage_kernel(Params P) {
    __shared__ __attribute__((aligned(16))) float sm[2304];
    for (int it = P.item_lo; it < P.item_hi; ++it) { const Item I = get_item(it); run_stage<s>(P, I, sm); }
}
template <int s> struct StageLoop {
    static __device__ __forceinline__ void run(const Params& P, const Item& I, float* sm, cg::grid_group& grid) { StageLoop<s - 1>::run(P, I, sm, grid); run_stage<s>(P, I, sm); grid.sync(); }
    static void launch(const Params& P, int grid, hipStream_t stream) { StageLoop<s - 1>::launch(P, grid, stream); hipLaunchKernelGGL(stage_kernel<s>, dim3(grid), dim3(256), 0, stream, P); }
};
template <> struct StageLoop<-1> {
    static __device__ __forceinline__ void run(const Params&, const Item&, float*, cg::grid_group&) {}
    static void launch(const Params&, int, hipStream_t) {}
};
__global__ void __launch_bounds__(256) naive_kernel(Params P) {
    __shared__ __attribute__((aligned(16))) float sm[2304];
    cg::grid_group grid = cg::this_grid();
    for (int it = P.item_lo; it < P.item_hi; ++it) { const Item I = get_item(it); StageLoop<NSTAGE - 1>::run(P, I, sm, grid); }
}

extern "C" void kernel_launch(void* const* d_in, const int* in_sizes, int n_in, void* d_out, int out_size, void* d_ws, size_t ws_size, hipStream_t stream) {
    static int grid_blocks = 0;
    if (!grid_blocks) {
        int dev = 0, cus = 0, per_cu = 0;
        hipGetDevice(&dev);
        hipDeviceGetAttribute(&cus, hipDeviceAttributeMultiprocessorCount, dev);
        hipOccupancyMaxActiveBlocksPerMultiprocessor(&per_cu, naive_kernel, 256, 0);
        if (per_cu < 1) per_cu = 1;
        if (per_cu > 4) per_cu = 4;
        grid_blocks = cus * per_cu;
        if ((size_t)out_size != OUT_TOTAL || n_in != 29 || ws_size < W_END * sizeof(float))
            fprintf(stderr, "kernel_launch: unexpected sizes out=%d (want %zu) n_in=%d ws=%zu (need %zu)\n", out_size, OUT_TOTAL, n_in, ws_size, W_END * sizeof(float));
    }
    Params P{};
    for (int i = 0; i < 29; ++i) P.in[i] = (const float*)d_in[i];
    P.out = (float*)d_out; P.ws = (float*)d_ws;
#if MEGA
    P.item_lo = 0; P.item_hi = 2 * NB; P.stage_lo = 0; P.stage_hi = NSTAGE;
    void* args[] = {&P};
    hipError_t e = hipLaunchCooperativeKernel((void*)naive_kernel, dim3(grid_blocks), dim3(256), args, 0, stream);
    if (e != hipSuccess) fprintf(stderr, "cooperative launch failed: %s (grid %d)\n", hipGetErrorString(e), grid_blocks);
#else
    for (int it = 0; it < 2 * NB; ++it) { P.item_lo = it; P.item_hi = it + 1; P.stage_lo = 0; P.stage_hi = NSTAGE; StageLoop<NSTAGE - 1>::launch(P, 2048, stream); }
#endif
}
```

```cpp
#include <hip/hip_runtime.h>
#include <hip/hip_cooperative_groups.h>
#include <cstdio>
#include <cstdint>
namespace cg = cooperative_groups;

#ifndef MEGA
#define MEGA 1
#endif

constexpr int D = 1024, NB = 8, SEQ = 4096, NMETA = 16, LP = NMETA + SEQ, DEC_T = 64, PAST = 1024;
constexpr int FH = 8, FD = 64, FW = 512, MH = 4, MD = 128, MW = 512;
constexpr int DFF = 2816, DIN = 5136;
constexpr int O_FQ = 0, O_FK = 512, O_FV = 1024, O_FF = 1536, O_MX = 1544, O_MV = 2056, O_MO = 2568, O_MI = 3080, O_MF = 3084, O_GA = 3088, O_GB = 4112;
constexpr float EPS = 1e-6f;
constexpr size_t OUT_YP = 0;
constexpr size_t OUT_YS = OUT_YP + (size_t)NB * SEQ * D;
constexpr size_t OUT_FKP = OUT_YS + (size_t)NB * DEC_T * D;
constexpr size_t OUT_FVP = OUT_FKP + (size_t)NB * LP * FW;
constexpr size_t OUT_LFP = OUT_FVP + (size_t)NB * LP * FW;
constexpr size_t OUT_CP = OUT_LFP + (size_t)NB * LP * FH;
constexpr size_t OUT_NP = OUT_CP + (size_t)NB * MH * MD * MD;
constexpr size_t OUT_MP = OUT_NP + (size_t)NB * MH * MD;
constexpr size_t OUT_CVP = OUT_MP + (size_t)NB * MH;
constexpr size_t OUT_FKS = OUT_CVP + (size_t)NB * 3 * MW;
constexpr size_t OUT_FVS = OUT_FKS + (size_t)NB * DEC_T * FW;
constexpr size_t OUT_LFS = OUT_FVS + (size_t)NB * DEC_T * FW;
constexpr size_t OUT_CS = OUT_LFS + (size_t)NB * DEC_T * FH;
constexpr size_t OUT_NS = OUT_CS + (size_t)NB * MH * MD * MD;
constexpr size_t OUT_MS = OUT_NS + (size_t)NB * MH * MD;
constexpr size_t OUT_CVS = OUT_MS + (size_t)NB * MH;
constexpr size_t OUT_TOTAL = OUT_CVS + (size_t)NB * 3 * MW;

constexpr size_t TM = LP;
constexpr size_t W_H = 0;
constexpr size_t W_Z = W_H + TM * D;
constexpr size_t W_LOGF = W_Z + TM * DIN;
constexpr size_t W_FC = W_LOGF + TM * FH;
constexpr size_t W_AT = W_FC + (TM + PAST) * FH;
constexpr size_t W_XC = W_AT + TM * FW;
constexpr size_t W_MQ = W_XC + TM * MW;
constexpr size_t W_MK = W_MQ + TM * MW;
constexpr size_t W_NUM = W_MK + TM * MW;
constexpr size_t W_DEN = W_NUM + TM * MW;
constexpr size_t W_MT = W_DEN + TM * MH;
constexpr size_t W_HM = W_MT + TM * MH;
constexpr size_t W_YA = W_HM + TM * MW;
constexpr size_t W_YB = W_YA + TM * D;
constexpr size_t W_OB = W_YB + TM * D;
constexpr size_t W_X1 = W_OB + TM * D;
constexpr size_t W_H2 = W_X1 + TM * D;
constexpr size_t W_GU = W_H2 + TM * D;
constexpr size_t W_ACT = W_GU + TM * 2 * DFF;
constexpr size_t W_FFO = W_ACT + TM * DFF;
constexpr size_t W_END = W_FFO + TM * D;

struct Params {
    const float* in[29];
    float* out;
    float* ws;
    int item_lo, item_hi, stage_lo, stage_hi;
};

enum { I_XP = 0, I_XS, I_CK, I_CV, I_CLF, I_SC, I_SN, I_SM, I_SCV, I_META, I_WIN, I_BIN, I_GFQ, I_GFK, I_WCONV, I_BCONV, I_WMQ, I_WMK, I_GMN, I_SKIP,
       I_WFOX, I_WML, I_WOUT, I_GPRE, I_GPOST, I_GPREF, I_GPOSTF, I_WGU, I_WDN };

__device__ __forceinline__ float wave_sum(float v) {
#pragma unroll
    for (int o = 1; o < 64; o <<= 1) v += __shfl_xor(v, o);
    return v;
}
__device__ __forceinline__ float wave_max(float v) {
#pragma unroll
    for (int o = 1; o < 64; o <<= 1) v = fmaxf(v, __shfl_xor(v, o));
    return v;
}
__device__ __forceinline__ float sigmoidf_(float x) { return 1.f / (1.f + expf(-x)); }
__device__ __forceinline__ float logsigmoidf_(float x) { return fminf(x, 0.f) - log1pf(expf(-fabsf(x))); }
__device__ __forceinline__ float siluf_(float x) { return x * sigmoidf_(x); }

struct Item { int T; int b; bool samp; };
__device__ __forceinline__ Item get_item(int it) { Item I; I.samp = it >= NB; I.b = I.samp ? it - NB : it; I.T = I.samp ? DEC_T : LP; return I; }

__device__ __forceinline__ const float* xrow(const Params& P, const Item& I, int t) {
    if (I.samp) return P.in[I_XS] + ((size_t)I.b * DEC_T + t) * D;
    if (t < NMETA) return P.in[I_META] + (size_t)t * D;
    return P.in[I_XP] + ((size_t)I.b * SEQ + (t - NMETA)) * D;
}

__device__ __forceinline__ void sgemm(const float* A, int lda, const float* B, int ldb, float* C, int ldc, int M, int N, int K, const float* bias, float alpha, float* sm) {
    float (*As)[68] = (float (*)[68])sm;
    float (*Bs)[68] = (float (*)[68])(sm + 16 * 68);
    const int tid = threadIdx.x, tx = tid & 15, ty = tid >> 4;
    const int nbn = (N + 63) / 64, nbm = (M + 63) / 64;
    for (int vb = blockIdx.x; vb < nbm * nbn; vb += gridDim.x) {
        const int bm = vb / nbn, bn = vb % nbn;
        float acc[4][4];
#pragma unroll
        for (int i = 0; i < 4; ++i)
#pragma unroll
            for (int j = 0; j < 4; ++j) acc[i][j] = 0.f;
        for (int k0 = 0; k0 < K; k0 += 16) {
            {
                const int r = tid >> 2, kq = (tid & 3) * 4, gr = bm * 64 + r;
                float4 v = make_float4(0.f, 0.f, 0.f, 0.f);
                if (gr < M) v = *(const float4*)(A + (size_t)gr * lda + k0 + kq);
                As[kq + 0][r] = v.x; As[kq + 1][r] = v.y; As[kq + 2][r] = v.z; As[kq + 3][r] = v.w;
            }
            {
                const int kk = tid >> 4, nq = (tid & 15) * 4, gn = bn * 64 + nq;
                float4 v = make_float4(0.f, 0.f, 0.f, 0.f);
                if (gn < N) v = *(const float4*)(B + (size_t)(k0 + kk) * ldb + gn);
                *(float4*)&Bs[kk][nq] = v;
            }
            __syncthreads();
#pragma unroll
            for (int kk = 0; kk < 16; ++kk) {
                const float4 a = *(const float4*)&As[kk][ty * 4];
                const float4 b = *(const float4*)&Bs[kk][tx * 4];
                const float av[4] = {a.x, a.y, a.z, a.w}, bv[4] = {b.x, b.y, b.z, b.w};
#pragma unroll
                for (int i = 0; i < 4; ++i)
#pragma unroll
                    for (int j = 0; j < 4; ++j) acc[i][j] += av[i] * bv[j];
            }
            __syncthreads();
        }
#pragma unroll
        for (int i = 0; i < 4; ++i) {
            const int gr = bm * 64 + ty * 4 + i;
            if (gr < M) {
                const int gn = bn * 64 + tx * 4;
                if (gn < N) {
                    float4 o;
                    o.x = alpha * acc[i][0] + (bias ? bias[gn + 0] : 0.f);
                    o.y = alpha * acc[i][1] + (bias ? bias[gn + 1] : 0.f);
                    o.z = alpha * acc[i][2] + (bias ? bias[gn + 2] : 0.f);
                    o.w = alpha * acc[i][3] + (bias ? bias[gn + 3] : 0.f);
                    *(float4*)(C + (size_t)gr * ldc + gn) = o;
                }
            }
        }
    }
}

__device__ __forceinline__ void st_norm_in(const Params& P, const Item& I) {
    const int lane = threadIdx.x & 63, wv = threadIdx.x >> 6;
    float* H = P.ws + W_H;
    const float* g = P.in[I_GPRE];
    for (int t = blockIdx.x * 4 + wv; t < I.T; t += gridDim.x * 4) {
        const float* x = xrow(P, I, t);
        float v[16]; float ss = 0.f;
#pragma unroll
        for (int j = 0; j < 16; ++j) { v[j] = x[lane + 64 * j]; ss += v[j] * v[j]; }
        ss = wave_sum(ss);
        const float r = rsqrtf(ss * (1.f / D) + EPS);
#pragma unroll
        for (int j = 0; j < 16; ++j) H[(size_t)t * D + lane + 64 * j] = v[j] * r * g[lane + 64 * j];
    }
}
__device__ __forceinline__ void st_fox_prep(const Params& P, const Item& I) {
    const int lane = threadIdx.x & 63, wv = threadIdx.x >> 6;
    float* Z = P.ws + W_Z; float* LOGF = P.ws + W_LOGF;
    float* ok = P.out + (I.samp ? OUT_FKS + (size_t)I.b * DEC_T * FW : OUT_FKP + (size_t)I.b * LP * FW);
    float* ov = P.out + (I.samp ? OUT_FVS + (size_t)I.b * DEC_T * FW : OUT_FVP + (size_t)I.b * LP * FW);
    float* olf = P.out + (I.samp ? OUT_LFS + (size_t)I.b * DEC_T * FH : OUT_LFP + (size_t)I.b * LP * FH);
    for (int t = blockIdx.x * 4 + wv; t < I.T; t += gridDim.x * 4) {
        float* z = Z + (size_t)t * DIN;
        const int c0 = lane * 8;
        float q[8], k[8]; float sq = 0.f, sk = 0.f;
#pragma unroll
        for (int j = 0; j < 8; ++j) { q[j] = z[O_FQ + c0 + j]; k[j] = z[O_FK + c0 + j]; sq += q[j] * q[j]; sk += k[j] * k[j]; }
#pragma unroll
        for (int o = 1; o < 8; o <<= 1) { sq += __shfl_xor(sq, o); sk += __shfl_xor(sk, o); }
        const float rq = rsqrtf(sq * (1.f / FD) + EPS), rk = rsqrtf(sk * (1.f / FD) + EPS);
#pragma unroll
        for (int j = 0; j < 8; ++j) {
            const float qn = q[j] * rq * P.in[I_GFQ][c0 + j], kn = k[j] * rk * P.in[I_GFK][c0 + j];
            z[O_FQ + c0 + j] = qn; z[O_FK + c0 + j] = kn;
            ok[(size_t)t * FW + c0 + j] = kn;
            ov[(size_t)t * FW + c0 + j] = z[O_FV + c0 + j];
        }
        if (lane < FH) { const float lf = logsigmoidf_(z[O_FF + lane]); LOGF[(size_t)t * FH + lane] = lf; olf[(size_t)t * FH + lane] = lf; }
    }
}
__device__ __forceinline__ void st_fcum(const Params& P, const Item& I) {
    if (blockIdx.x != 0 || threadIdx.x >= FH) return;
    const int h = threadIdx.x;
    float* FC = P.ws + W_FC; const float* LOGF = P.ws + W_LOGF;
    float acc = 0.f; int base = 0;
    if (I.samp) {
        const float* cl = P.in[I_CLF] + (size_t)I.b * PAST * FH;
        for (int i = 0; i < PAST; ++i) { acc += cl[(size_t)i * FH + h]; FC[(size_t)i * FH + h] = acc; }
        base = PAST;
    }
    for (int t = 0; t < I.T; ++t) { acc += LOGF[(size_t)t * FH + h]; FC[(size_t)(base + t) * FH + h] = acc; }
}
__device__ __forceinline__ void st_attn(const Params& P, const Item& I, float* sm) {
    const int lane = threadIdx.x & 63, wv = threadIdx.x >> 6;
    const float* Z = P.ws + W_Z; const float* FC = P.ws + W_FC; float* AT = P.ws + W_AT;
    float* qs = sm + wv * 64;
    const int base = I.samp ? PAST : 0;
    const float* ck = P.in[I_CK] + (size_t)I.b * PAST * FW;
    const float* cv = P.in[I_CV] + (size_t)I.b * PAST * FW;
    const int nunits = I.T * FH;
    for (int u = blockIdx.x * 4 + wv; u < nunits; u += gridDim.x * 4) {
        const int t = u / FH, h = u % FH;
        qs[lane] = Z[(size_t)t * DIN + O_FQ + h * FD + lane];
        __builtin_amdgcn_wave_barrier();
        const int qpos = base + t;
        const float Fq = FC[(size_t)qpos * FH + h];
        float m = -INFINITY, l = 0.f; float o[64];
#pragma unroll
        for (int d = 0; d < 64; ++d) o[d] = 0.f;
        for (int i = lane; i <= qpos; i += 64) {
            const float* kr; const float* vr;
            if (i < base) { kr = ck + (size_t)i * FW + h * FD; vr = cv + (size_t)i * FW + h * FD; }
            else { kr = Z + (size_t)(i - base) * DIN + O_FK + h * FD; vr = Z + (size_t)(i - base) * DIN + O_FV + h * FD; }
            float dot = 0.f;
#pragma unroll
            for (int d = 0; d < 64; d += 4) { const float4 kk = *(const float4*)(kr + d); dot += kk.x * qs[d] + kk.y * qs[d + 1] + kk.z * qs[d + 2] + kk.w * qs[d + 3]; }
            const float sc = dot * 0.125f + (Fq - FC[(size_t)i * FH + h]);
            const float mn = fmaxf(m, sc), corr = expf(m - mn), p = expf(sc - mn);
            l = l * corr + p;
#pragma unroll
            for (int d = 0; d < 64; d += 4) { const float4 vv = *(const float4*)(vr + d);
                o[d] = o[d] * corr + p * vv.x; o[d + 1] = o[d + 1] * corr + p * vv.y; o[d + 2] = o[d + 2] * corr + p * vv.z; o[d + 3] = o[d + 3] * corr + p * vv.w; }
            m = mn;
        }
        const float Mx = wave_max(m);
        const float sc_l = (m == -INFINITY) ? 0.f : expf(m - Mx);
        const float L = wave_sum(l * sc_l);
        float mine = 0.f;
#pragma unroll
        for (int d = 0; d < 64; ++d) { const float s = wave_sum(o[d] * sc_l); if (lane == d) mine = s; }
        AT[(size_t)t * FW + h * FD + lane] = mine / L;
    }
}
__device__ __forceinline__ void st_conv(const Params& P, const Item& I) {
    const float* Z = P.ws + W_Z; float* XC = P.ws + W_XC;
    const float* wc = P.in[I_WCONV]; const float* bc = P.in[I_BCONV];
    const float* prev = P.in[I_SCV] + (size_t)I.b * 3 * MW;
    const int n = I.T * MW;
    for (int e = blockIdx.x * blockDim.x + threadIdx.x; e < n; e += gridDim.x * blockDim.x) {
        const int t = e / MW, c = e % MW;
        float y = bc[c];
#pragma unroll
        for (int i = 0; i < 4; ++i) {
            const int u = t + i - 3;
            float s;
            if (u >= 0) s = Z[(size_t)u * DIN + O_MX + c]; else s = I.samp ? prev[(size_t)(u + 3) * MW + c] : 0.f;
            y += wc[i * MW + c] * s;
        }
        XC[e] = siluf_(y);
    }
    float* oc = P.out + (I.samp ? OUT_CVS : OUT_CVP) + (size_t)I.b * 3 * MW;
    for (int e = blockIdx.x * blockDim.x + threadIdx.x; e < 3 * MW; e += gridDim.x * blockDim.x) {
        const int j = e / MW, c = e % MW;
        oc[e] = Z[(size_t)(I.T - 3 + j) * DIN + O_MX + c];
    }
}
__device__ __forceinline__ void st_mlstm(const Params& P, const Item& I, float* sm) {
    if (blockIdx.x >= MH) return;
    const int h = blockIdx.x, j = threadIdx.x;
    const float* Z = P.ws + W_Z; const float* MQ = P.ws + W_MQ; const float* MK = P.ws + W_MK;
    float* NUM = P.ws + W_NUM; float* DEN = P.ws + W_DEN; float* MT = P.ws + W_MT;
    float* qs = sm;
    float* ks = sm + 8 * 128;
    float c[128];
    float m = 0.f;
    if (I.samp) {
        m = P.in[I_SM][I.b * MH + h];
        const float* C0 = P.in[I_SC] + ((size_t)I.b * MH + h) * MD * MD;
        const float* n0 = P.in[I_SN] + ((size_t)I.b * MH + h) * MD;
#pragma unroll
        for (int dk = 0; dk < 128; ++dk) c[dk] = (j < 128) ? C0[(size_t)dk * MD + j] : (j == 128 ? n0[dk] : 0.f);
    } else {
#pragma unroll
        for (int dk = 0; dk < 128; ++dk) c[dk] = 0.f;
    }
    for (int t0 = 0; t0 < I.T; t0 += 8) {
        __syncthreads();
        for (int e = threadIdx.x; e < 8 * 128; e += blockDim.x) {
            const int tt = e >> 7, d = e & 127;
            const bool ok = (t0 + tt) < I.T;
            qs[e] = ok ? MQ[(size_t)(t0 + tt) * MW + h * MD + d] : 0.f;
            ks[e] = ok ? MK[(size_t)(t0 + tt) * MW + h * MD + d] : 0.f;
        }
        __syncthreads();
        const int nt = (I.T - t0) < 8 ? (I.T - t0) : 8;
        for (int tt = 0; tt < nt; ++tt) {
            const int t = t0 + tt;
            const float* z = Z + (size_t)t * DIN;
            const float lf = logsigmoidf_(z[O_MF + h]), ig = z[O_MI + h];
            const float mn = fmaxf(lf + m, ig);
            const float a = expf(lf + m - mn), bb = expf(ig - mn);
            const float vj = (j < 128) ? z[O_MV + h * MD + j] : 1.f;
            const float bv = bb * vj;
            float acc0 = 0.f, acc1 = 0.f, acc2 = 0.f, acc3 = 0.f;
#pragma unroll
            for (int dk = 0; dk < 128; dk += 4) {
                const float4 kk = *(const float4*)(ks + tt * 128 + dk);
                const float4 qq = *(const float4*)(qs + tt * 128 + dk);
                c[dk] = a * c[dk] + bv * kk.x; acc0 += qq.x * c[dk];
                c[dk + 1] = a * c[dk + 1] + bv * kk.y; acc1 += qq.y * c[dk + 1];
                c[dk + 2] = a * c[dk + 2] + bv * kk.z; acc2 += qq.z * c[dk + 2];
                c[dk + 3] = a * c[dk + 3] + bv * kk.w; acc3 += qq.w * c[dk + 3];
            }
            const float acc = (acc0 + acc1) + (acc2 + acc3);
            if (j < 128) NUM[(size_t)t * MW + h * MD + j] = acc;
            else if (j == 128) { DEN[(size_t)t * MH + h] = acc; MT[(size_t)t * MH + h] = mn; }
            m = mn;
        }
    }
    float* oC = P.out + (I.samp ? OUT_CS : OUT_CP) + ((size_t)I.b * MH + h) * MD * MD;
    float* on = P.out + (I.samp ? OUT_NS : OUT_NP) + ((size_t)I.b * MH + h) * MD;
    float* om = P.out + (I.samp ? OUT_MS : OUT_MP) + (size_t)I.b * MH + h;
#pragma unroll
    for (int dk = 0; dk < 128; ++dk) { if (j < 128) oC[(size_t)dk * MD + j] = c[dk]; else if (j == 128) on[dk] = c[dk]; }
    if (j == 0) *om = m;
}
__device__ __forceinline__ void st_hm(const Params& P, const Item& I) {
    const int lane = threadIdx.x & 63, wv = threadIdx.x >> 6;
    const float* Z = P.ws + W_Z; const float* NUM = P.ws + W_NUM; const float* DEN = P.ws + W_DEN; const float* MT = P.ws + W_MT; const float* XC = P.ws + W_XC;
    float* HM = P.ws + W_HM;
    for (int t = blockIdx.x * 4 + wv; t < I.T; t += gridDim.x * 4) {
        const int c0 = lane * 8, h = lane >> 4;
        const float den = DEN[(size_t)t * MH + h], mt = MT[(size_t)t * MH + h];
        const float dd = fmaxf(fabsf(den), expf(-mt));
        float v[8]; float ss = 0.f;
#pragma unroll
        for (int jj = 0; jj < 8; ++jj) { const float hc = NUM[(size_t)t * MW + c0 + jj] / dd; v[jj] = sigmoidf_(Z[(size_t)t * DIN + O_MO + c0 + jj]) * hc; ss += v[jj] * v[jj]; }
#pragma unroll
        for (int o = 1; o < 16; o <<= 1) ss += __shfl_xor(ss, o);
        const float r = rsqrtf(ss * (1.f / MD) + EPS);
#pragma unroll
        for (int jj = 0; jj < 8; ++jj) HM[(size_t)t * MW + c0 + jj] = v[jj] * r * P.in[I_GMN][c0 + jj] + P.in[I_SKIP][c0 + jj] * XC[(size_t)t * MW + c0 + jj];
    }
}
__device__ __forceinline__ void st_merge(const Params& P, const Item& I) {
    const float* Z = P.ws + W_Z; float* YA = P.ws + W_YA; const float* YB = P.ws + W_YB;
    const int n = I.T * D;
    for (int e = blockIdx.x * blockDim.x + threadIdx.x; e < n; e += gridDim.x * blockDim.x) {
        const int t = e / D, c = e % D;
        YA[e] = sigmoidf_(Z[(size_t)t * DIN + O_GA + c]) * YA[e] + sigmoidf_(Z[(size_t)t * DIN + O_GB + c]) * YB[e];
    }
}
__device__ __forceinline__ void st_mid(const Params& P, const Item& I) {
    const int lane = threadIdx.x & 63, wv = threadIdx.x >> 6;
    const float* OB = P.ws + W_OB; float* X1 = P.ws + W_X1; float* H2 = P.ws + W_H2;
    for (int t = blockIdx.x * 4 + wv; t < I.T; t += gridDim.x * 4) {
        const float* x = xrow(P, I, t);
        float v[16]; float ss = 0.f;
#pragma unroll
        for (int jj = 0; jj < 16; ++jj) { v[jj] = OB[(size_t)t * D + lane + 64 * jj]; ss += v[jj] * v[jj]; }
        ss = wave_sum(ss);
        const float r = rsqrtf(ss * (1.f / D) + EPS);
        float s2 = 0.f;
#pragma unroll
        for (int jj = 0; jj < 16; ++jj) { v[jj] = x[lane + 64 * jj] + v[jj] * r * P.in[I_GPOST][lane + 64 * jj]; s2 += v[jj] * v[jj]; }
        s2 = wave_sum(s2);
        const float r2 = rsqrtf(s2 * (1.f / D) + EPS);
#pragma unroll
        for (int jj = 0; jj < 16; ++jj) { X1[(size_t)t * D + lane + 64 * jj] = v[jj]; H2[(size_t)t * D + lane + 64 * jj] = v[jj] * r2 * P.in[I_GPREF][lane + 64 * jj]; }
    }
}
__device__ __forceinline__ void st_act(const Params& P, const Item& I) {
    const float* GU = P.ws + W_GU; float* ACT = P.ws + W_ACT;
    const int n = I.T * DFF;
    for (int e = blockIdx.x * blockDim.x + threadIdx.x; e < n; e += gridDim.x * blockDim.x) {
        const int t = e / DFF, c = e % DFF;
        ACT[e] = siluf_(GU[(size_t)t * 2 * DFF + c]) * GU[(size_t)t * 2 * DFF + DFF + c];
    }
}
__device__ __forceinline__ void st_final(const Params& P, const Item& I) {
    const int lane = threadIdx.x & 63, wv = threadIdx.x >> 6;
    const float* FFO = P.ws + W_FFO; const float* X1 = P.ws + W_X1;
    for (int t = blockIdx.x * 4 + wv; t < I.T; t += gridDim.x * 4) {
        float* y;
        if (I.samp) y = P.out + OUT_YS + ((size_t)I.b * DEC_T + t) * D;
        else { if (t < NMETA) continue; y = P.out + OUT_YP + ((size_t)I.b * SEQ + (t - NMETA)) * D; }
        float v[16]; float ss = 0.f;
#pragma unroll
        for (int jj = 0; jj < 16; ++jj) { v[jj] = FFO[(size_t)t * D + lane + 64 * jj]; ss += v[jj] * v[jj]; }
        ss = wave_sum(ss);
        const float r = rsqrtf(ss * (1.f / D) + EPS);
#pragma unroll
        for (int jj = 0; jj < 16; ++jj) y[lane + 64 * jj] = X1[(size_t)t * D + lane + 64 * jj] + v[jj] * r * P.in[I_GPOSTF][lane + 64 * jj];
    }
}

constexpr int NSTAGE = 17;
template <int s> __device__ __forceinline__ void run_stage(const Params& P, const Item& I, float* sm) {
    float* ws = P.ws;
    switch (s) {
    case 0: st_norm_in(P, I); break;
    case 1: sgemm(ws + W_H, D, P.in[I_WIN], DIN, ws + W_Z, DIN, I.T, DIN, D, P.in[I_BIN], 1.f, sm); break;
    case 2: st_fox_prep(P, I); break;
    case 3: st_fcum(P, I); break;
    case 4: st_attn(P, I, sm); break;
    case 5: st_conv(P, I); break;
    case 6:
        for (int h = 0; h < MH; ++h) {
            sgemm(ws + W_XC + h * MD, MW, P.in[I_WMQ] + (size_t)h * MD * MD, MD, ws + W_MQ + h * MD, MW, I.T, MD, MD, nullptr, 1.f, sm);
            sgemm(ws + W_XC + h * MD, MW, P.in[I_WMK] + (size_t)h * MD * MD, MD, ws + W_MK + h * MD, MW, I.T, MD, MD, nullptr, 0.08838834764831845f, sm);
        }
        break;
    case 7: st_mlstm(P, I, sm); break;
    case 8: st_hm(P, I); break;
    case 9:
        sgemm(ws + W_AT, FW, P.in[I_WFOX], D, ws + W_YA, D, I.T, D, FW, nullptr, 1.f, sm);
        sgemm(ws + W_HM, MW, P.in[I_WML], D, ws + W_YB, D, I.T, D, MW, nullptr, 1.f, sm);
        break;
    case 10: st_merge(P, I); break;
    case 11: sgemm(ws + W_YA, D, P.in[I_WOUT], D, ws + W_OB, D, I.T, D, D, nullptr, 1.f, sm); break;
    case 12: st_mid(P, I); break;
    case 13: sgemm(ws + W_H2, D, P.in[I_WGU], 2 * DFF, ws + W_GU, 2 * DFF, I.T, 2 * DFF, D, nullptr, 1.f, sm); break;
    case 14: st_act(P, I); break;
    case 15: sgemm(ws + W_ACT, DFF, P.in[I_WDN], D, ws + W_FFO, D, I.T, D, DFF, nullptr, 1.f, sm); break;
    case 16: st_final(P, I); break;
    }
}

template <int s> __global__ void __launch_bounds__(256) stage_kernel(Params P) {
    __shared__ __attribute__((aligned(16))) float sm[2304];
    for (int it = P.item_lo; it < P.item_hi; ++it) { const Item I = get_item(it); run_stage<s>(P, I, sm); }
}
template <int s> struct StageLoop {
    static __device__ __forceinline__ void run(const Params& P, const Item& I, float* sm, cg::grid_group& grid) { StageLoop<s - 1>::run(P, I, sm, grid); run_stage<s>(P, I, sm); grid.sync(); }
    static void launch(const Params& P, int grid, hipStream_t stream) { StageLoop<s - 1>::launch(P, grid, stream); hipLaunchKernelGGL(stage_kernel<s>, dim3(grid), dim3(256), 0, stream, P); }
};
template <> struct StageLoop<-1> {
    static __device__ __forceinline__ void run(const Params&, const Item&, float*, cg::grid_group&) {}
    static void launch(const Params&, int, hipStream_t) {}
};
__global__ void __launch_bounds__(256) naive_kernel(Params P) {
    __shared__ __attribute__((aligned(16))) float sm[2304];
    cg::grid_group grid = cg::this_grid();
    for (int it = P.item_lo; it < P.item_hi; ++it) { const Item I = get_item(it); StageLoop<NSTAGE - 1>::run(P, I, sm, grid); }
}

extern "C" void kernel_launch(void* const* d_in, const int* in_sizes, int n_in, void* d_out, int out_size, void* d_ws, size_t ws_size, hipStream_t stream) {
    static int grid_blocks = 0;
    if (!grid_blocks) {
        int dev = 0, cus = 0, per_cu = 0;
        hipGetDevice(&dev);
        hipDeviceGetAttribute(&cus, hipDeviceAttributeMultiprocessorCount, dev);
        hipOccupancyMaxActiveBlocksPerMultiprocessor(&per_cu, naive_kernel, 256, 0);
        if (per_cu < 1) per_cu = 1;
        if (per_cu > 4) per_cu = 4;
        grid_blocks = cus * per_cu;
        if ((size_t)out_size != OUT_TOTAL || n_in != 29 || ws_size < W_END * sizeof(float))
            fprintf(stderr, "kernel_launch: unexpected sizes out=%d (want %zu) n_in=%d ws=%zu (need %zu)\n", out_size, OUT_TOTAL, n_in, ws_size, W_END * sizeof(float));
    }
    Params P{};
    for (int i = 0; i < 29; ++i) P.in[i] = (const float*)d_in[i];
    P.out = (float*)d_out; P.ws = (float*)d_ws;
#if MEGA
    P.item_lo = 0; P.item_hi = 2 * NB; P.stage_lo = 0; P.stage_hi = NSTAGE;
    void* args[] = {&P};
    hipError_t e = hipLaunchCooperativeKernel((void*)naive_kernel, dim3(grid_blocks), dim3(256), args, 0, stream);
    if (e != hipSuccess) fprintf(stderr, "cooperative launch failed: %s (grid %d)\n", hipGetErrorString(e), grid_blocks);
#else
    for (int it = 0; it < 2 * NB; ++it) { P.item_lo = it; P.item_hi = it + 1; P.stage_lo = 0; P.stage_hi = NSTAGE; StageLoop<NSTAGE - 1>::launch(P, 2048, stream); }
#endif
}
```

```cpp
#define FAST_NPB 8
#define DBG 0
#include <hip/hip_runtime.h>
#include <hip/hip_cooperative_groups.h>
#include <cstdio>
#include <cstdint>
namespace cg = cooperative_groups;


constexpr int D = 1024, NB = 8, SEQ = 4096, NMETA = 16, LP = NMETA + SEQ, DEC_T = 64, PAST = 1024;
constexpr int FH = 8, FD = 64, FW = 512, MH = 4, MD = 128, MW = 512;
constexpr int DFF = 2816, DIN = 5136;
constexpr int O_FQ = 0, O_FK = 512, O_FV = 1024, O_FF = 1536, O_MX = 1544, O_MV = 2056, O_MO = 2568, O_MI = 3080, O_MF = 3084, O_GA = 3088, O_GB = 4112;
constexpr float EPS = 1e-6f;
constexpr size_t OUT_YP = 0;
constexpr size_t OUT_YS = OUT_YP + (size_t)NB * SEQ * D;
constexpr size_t OUT_FKP = OUT_YS + (size_t)NB * DEC_T * D;
constexpr size_t OUT_FVP = OUT_FKP + (size_t)NB * LP * FW;
constexpr size_t OUT_LFP = OUT_FVP + (size_t)NB * LP * FW;
constexpr size_t OUT_CP = OUT_LFP + (size_t)NB * LP * FH;
constexpr size_t OUT_NP = OUT_CP + (size_t)NB * MH * MD * MD;
constexpr size_t OUT_MP = OUT_NP + (size_t)NB * MH * MD;
constexpr size_t OUT_CVP = OUT_MP + (size_t)NB * MH;
constexpr size_t OUT_FKS = OUT_CVP + (size_t)NB * 3 * MW;
constexpr size_t OUT_FVS = OUT_FKS + (size_t)NB * DEC_T * FW;
constexpr size_t OUT_LFS = OUT_FVS + (size_t)NB * DEC_T * FW;
constexpr size_t OUT_CS = OUT_LFS + (size_t)NB * DEC_T * FH;
constexpr size_t OUT_NS = OUT_CS + (size_t)NB * MH * MD * MD;
constexpr size_t OUT_MS = OUT_NS + (size_t)NB * MH * MD;
constexpr size_t OUT_CVS = OUT_MS + (size_t)NB * MH;
constexpr size_t OUT_TOTAL = OUT_CVS + (size_t)NB * 3 * MW;

constexpr size_t TM = LP;
constexpr size_t W_H = 0;
constexpr size_t W_Z = W_H + TM * D;
constexpr size_t W_LOGF = W_Z + TM * DIN;
constexpr size_t W_FC = W_LOGF + TM * FH;
constexpr size_t W_AT = W_FC + (TM + PAST) * FH;
constexpr size_t W_XC = W_AT + TM * FW;
constexpr size_t W_MQ = W_XC + TM * MW;
constexpr size_t W_MK = W_MQ + TM * MW;
constexpr size_t W_NUM = W_MK + TM * MW;
constexpr size_t W_DEN = W_NUM + TM * MW;
constexpr size_t W_MT = W_DEN + TM * MH;
constexpr size_t W_HM = W_MT + TM * MH;
constexpr size_t W_YA = W_HM + TM * MW;
constexpr size_t W_YB = W_YA + TM * D;
constexpr size_t W_OB = W_YB + TM * D;
constexpr size_t W_X1 = W_OB + TM * D;
constexpr size_t W_H2 = W_X1 + TM * D;
constexpr size_t W_GU = W_Z;
constexpr size_t W_ACT = W_MQ;
constexpr size_t W_FFO = W_YB;
constexpr size_t W_END = W_H2 + TM * D;
static_assert(W_Z + TM * 2 * DFF <= W_MQ && W_MQ + TM * DFF <= W_YB, "naive aliases");

struct Params {
    const float* in[29];
    float* out;
    float* ws;
    int item_lo, item_hi, stage_lo, stage_hi;
};

enum { I_XP = 0, I_XS, I_CK, I_CV, I_CLF, I_SC, I_SN, I_SM, I_SCV, I_META, I_WIN, I_BIN, I_GFQ, I_GFK, I_WCONV, I_BCONV, I_WMQ, I_WMK, I_GMN, I_SKIP,
       I_WFOX, I_WML, I_WOUT, I_GPRE, I_GPOST, I_GPREF, I_GPOSTF, I_WGU, I_WDN };

__device__ __forceinline__ float wave_sum(float v) {
#pragma unroll
    for (int o = 1; o < 64; o <<= 1) v += __shfl_xor(v, o);
    return v;
}
__device__ __forceinline__ float wave_max(float v) {
#pragma unroll
    for (int o = 1; o < 64; o <<= 1) v = fmaxf(v, __shfl_xor(v, o));
    return v;
}
__device__ __forceinline__ float sigmoidf_(float x) { return 1.f / (1.f + expf(-x)); }
__device__ __forceinline__ float logsigmoidf_(float x) { return fminf(x, 0.f) - log1pf(expf(-fabsf(x))); }
__device__ __forceinline__ float siluf_(float x) { return x * sigmoidf_(x); }

#ifndef DBG
#define DBG 0
#endif
#ifndef DBG_G0
#define DBG_G0 {-1}
#define DBG_G1 {-1}
#define DBG_G2 {-1}
#define DBG_G3 {-1}
#define DBG_G4 {-1}
#endif
#if DBG
struct Item { int T; int b; bool samp; };
__device__ __forceinline__ Item get_item(int it) { Item I; I.samp = it >= NB; I.b = I.samp ? it - NB : it; I.T = I.samp ? DEC_T : LP; return I; }

__device__ __forceinline__ const float* xrow(const Params& P, const Item& I, int t) {
    if (I.samp) return P.in[I_XS] + ((size_t)I.b * DEC_T + t) * D;
    if (t < NMETA) return P.in[I_META] + (size_t)t * D;
    return P.in[I_XP] + ((size_t)I.b * SEQ + (t - NMETA)) * D;
}

__device__ __forceinline__ void sgemm(const float* A, int lda, const float* B, int ldb, float* C, int ldc, int M, int N, int K, const float* bias, float alpha, float* sm) {
    float (*As)[68] = (float (*)[68])sm;
    float (*Bs)[68] = (float (*)[68])(sm + 16 * 68);
    const int tid = threadIdx.x, tx = tid & 15, ty = tid >> 4;
    const int nbn = (N + 63) / 64, nbm = (M + 63) / 64;
    for (int vb = blockIdx.x; vb < nbm * nbn; vb += gridDim.x) {
        const int bm = vb / nbn, bn = vb % nbn;
        float acc[4][4];
#pragma unroll
        for (int i = 0; i < 4; ++i)
#pragma unroll
            for (int j = 0; j < 4; ++j) acc[i][j] = 0.f;
        for (int k0 = 0; k0 < K; k0 += 16) {
            {
                const int r = tid >> 2, kq = (tid & 3) * 4, gr = bm * 64 + r;
                float4 v = make_float4(0.f, 0.f, 0.f, 0.f);
                if (gr < M) v = *(const float4*)(A + (size_t)gr * lda + k0 + kq);
                As[kq + 0][r] = v.x; As[kq + 1][r] = v.y; As[kq + 2][r] = v.z; As[kq + 3][r] = v.w;
            }
            {
                const int kk = tid >> 4, nq = (tid & 15) * 4, gn = bn * 64 + nq;
                float4 v = make_float4(0.f, 0.f, 0.f, 0.f);
                if (gn < N) v = *(const float4*)(B + (size_t)(k0 + kk) * ldb + gn);
                *(float4*)&Bs[kk][nq] = v;
            }
            __syncthreads();
#pragma unroll
            for (int kk = 0; kk < 16; ++kk) {
                const float4 a = *(const float4*)&As[kk][ty * 4];
                const float4 b = *(const float4*)&Bs[kk][tx * 4];
                const float av[4] = {a.x, a.y, a.z, a.w}, bv[4] = {b.x, b.y, b.z, b.w};
#pragma unroll
                for (int i = 0; i < 4; ++i)
#pragma unroll
                    for (int j = 0; j < 4; ++j) acc[i][j] += av[i] * bv[j];
            }
            __syncthreads();
        }
#pragma unroll
        for (int i = 0; i < 4; ++i) {
            const int gr = bm * 64 + ty * 4 + i;
            if (gr < M) {
                const int gn = bn * 64 + tx * 4;
                if (gn < N) {
                    float4 o;
                    o.x = alpha * acc[i][0] + (bias ? bias[gn + 0] : 0.f);
                    o.y = alpha * acc[i][1] + (bias ? bias[gn + 1] : 0.f);
                    o.z = alpha * acc[i][2] + (bias ? bias[gn + 2] : 0.f);
                    o.w = alpha * acc[i][3] + (bias ? bias[gn + 3] : 0.f);
                    *(float4*)(C + (size_t)gr * ldc + gn) = o;
                }
            }
        }
    }
}

__device__ __forceinline__ void st_norm_in(const Params& P, const Item& I) {
    const int lane = threadIdx.x & 63, wv = threadIdx.x >> 6;
    float* H = P.ws + W_H;
    const float* g = P.in[I_GPRE];
    for (int t = blockIdx.x * 4 + wv; t < I.T; t += gridDim.x * 4) {
        const float* x = xrow(P, I, t);
        float v[16]; float ss = 0.f;
#pragma unroll
        for (int j = 0; j < 16; ++j) { v[j] = x[lane + 64 * j]; ss += v[j] * v[j]; }
        ss = wave_sum(ss);
        const float r = rsqrtf(ss * (1.f / D) + EPS);
#pragma unroll
        for (int j = 0; j < 16; ++j) H[(size_t)t * D + lane + 64 * j] = v[j] * r * g[lane + 64 * j];
    }
}
__device__ __forceinline__ void st_fox_prep(const Params& P, const Item& I) {
    const int lane = threadIdx.x & 63, wv = threadIdx.x >> 6;
    float* Z = P.ws + W_Z; float* LOGF = P.ws + W_LOGF;
    float* ok = P.out + (I.samp ? OUT_FKS + (size_t)I.b * DEC_T * FW : OUT_FKP + (size_t)I.b * LP * FW);
    float* ov = P.out + (I.samp ? OUT_FVS + (size_t)I.b * DEC_T * FW : OUT_FVP + (size_t)I.b * LP * FW);
    float* olf = P.out + (I.samp ? OUT_LFS + (size_t)I.b * DEC_T * FH : OUT_LFP + (size_t)I.b * LP * FH);
    for (int t = blockIdx.x * 4 + wv; t < I.T; t += gridDim.x * 4) {
        float* z = Z + (size_t)t * DIN;
        const int c0 = lane * 8;
        float q[8], k[8]; float sq = 0.f, sk = 0.f;
#pragma unroll
        for (int j = 0; j < 8; ++j) { q[j] = z[O_FQ + c0 + j]; k[j] = z[O_FK + c0 + j]; sq += q[j] * q[j]; sk += k[j] * k[j]; }
#pragma unroll
        for (int o = 1; o < 8; o <<= 1) { sq += __shfl_xor(sq, o); sk += __shfl_xor(sk, o); }
        const float rq = rsqrtf(sq * (1.f / FD) + EPS), rk = rsqrtf(sk * (1.f / FD) + EPS);
#pragma unroll
        for (int j = 0; j < 8; ++j) {
            const float qn = q[j] * rq * P.in[I_GFQ][c0 + j], kn = k[j] * rk * P.in[I_GFK][c0 + j];
            z[O_FQ + c0 + j] = qn; z[O_FK + c0 + j] = kn;
            ok[(size_t)t * FW + c0 + j] = kn;
            ov[(size_t)t * FW + c0 + j] = z[O_FV + c0 + j];
        }
        if (lane < FH) { const float lf = logsigmoidf_(z[O_FF + lane]); LOGF[(size_t)t * FH + lane] = lf; olf[(size_t)t * FH + lane] = lf; }
    }
}
__device__ __forceinline__ void st_fcum(const Params& P, const Item& I) {
    if (blockIdx.x != 0 || threadIdx.x >= FH) return;
    const int h = threadIdx.x;
    float* FC = P.ws + W_FC; const float* LOGF = P.ws + W_LOGF;
    float acc = 0.f; int base = 0;
    if (I.samp) {
        const float* cl = P.in[I_CLF] + (size_t)I.b * PAST * FH;
        for (int i = 0; i < PAST; ++i) { acc += cl[(size_t)i * FH + h]; FC[(size_t)i * FH + h] = acc; }
        base = PAST;
    }
    for (int t = 0; t < I.T; ++t) { acc += LOGF[(size_t)t * FH + h]; FC[(size_t)(base + t) * FH + h] = acc; }
}
__device__ __forceinline__ void st_attn(const Params& P, const Item& I, float* sm) {
    const int lane = threadIdx.x & 63, wv = threadIdx.x >> 6;
    const float* Z = P.ws + W_Z; const float* FC = P.ws + W_FC; float* AT = P.ws + W_AT;
    float* qs = sm + wv * 64;
    const int base = I.samp ? PAST : 0;
    const float* ck = P.in[I_CK] + (size_t)I.b * PAST * FW;
    const float* cv = P.in[I_CV] + (size_t)I.b * PAST * FW;
    const int nunits = I.T * FH;
    for (int u = blockIdx.x * 4 + wv; u < nunits; u += gridDim.x * 4) {
        const int t = u / FH, h = u % FH;
        qs[lane] = Z[(size_t)t * DIN + O_FQ + h * FD + lane];
        __builtin_amdgcn_wave_barrier();
        const int qpos = base + t;
        const float Fq = FC[(size_t)qpos * FH + h];
        float m = -INFINITY, l = 0.f; float o[64];
#pragma unroll
        for (int d = 0; d < 64; ++d) o[d] = 0.f;
        for (int i = lane; i <= qpos; i += 64) {
            const float* kr; const float* vr;
            if (i < base) { kr = ck + (size_t)i * FW + h * FD; vr = cv + (size_t)i * FW + h * FD; }
            else { kr = Z + (size_t)(i - base) * DIN + O_FK + h * FD; vr = Z + (size_t)(i - base) * DIN + O_FV + h * FD; }
            float dot = 0.f;
#pragma unroll
            for (int d = 0; d < 64; d += 4) { const float4 kk = *(const float4*)(kr + d); dot += kk.x * qs[d] + kk.y * qs[d + 1] + kk.z * qs[d + 2] + kk.w * qs[d + 3]; }
            const float sc = dot * 0.125f + (Fq - FC[(size_t)i * FH + h]);
            const float mn = fmaxf(m, sc), corr = expf(m - mn), p = expf(sc - mn);
            l = l * corr + p;
#pragma unroll
            for (int d = 0; d < 64; d += 4) { const float4 vv = *(const float4*)(vr + d);
                o[d] = o[d] * corr + p * vv.x; o[d + 1] = o[d + 1] * corr + p * vv.y; o[d + 2] = o[d + 2] * corr + p * vv.z; o[d + 3] = o[d + 3] * corr + p * vv.w; }
            m = mn;
        }
        const float Mx = wave_max(m);
        const float sc_l = (m == -INFINITY) ? 0.f : expf(m - Mx);
        const float L = wave_sum(l * sc_l);
        float mine = 0.f;
#pragma unroll
        for (int d = 0; d < 64; ++d) { const float s = wave_sum(o[d] * sc_l); if (lane == d) mine = s; }
        AT[(size_t)t * FW + h * FD + lane] = mine / L;
    }
}
__device__ __forceinline__ void st_conv(const Params& P, const Item& I) {
    const float* Z = P.ws + W_Z; float* XC = P.ws + W_XC;
    const float* wc = P.in[I_WCONV]; const float* bc = P.in[I_BCONV];
    const float* prev = P.in[I_SCV] + (size_t)I.b * 3 * MW;
    const int n = I.T * MW;
    for (int e = blockIdx.x * blockDim.x + threadIdx.x; e < n; e += gridDim.x * blockDim.x) {
        const int t = e / MW, c = e % MW;
        float y = bc[c];
#pragma unroll
        for (int i = 0; i < 4; ++i) {
            const int u = t + i - 3;
            float s;
            if (u >= 0) s = Z[(size_t)u * DIN + O_MX + c]; else s = I.samp ? prev[(size_t)(u + 3) * MW + c] : 0.f;
            y += wc[i * MW + c] * s;
        }
        XC[e] = siluf_(y);
    }
    float* oc = P.out + (I.samp ? OUT_CVS : OUT_CVP) + (size_t)I.b * 3 * MW;
    for (int e = blockIdx.x * blockDim.x + threadIdx.x; e < 3 * MW; e += gridDim.x * blockDim.x) {
        const int j = e / MW, c = e % MW;
        oc[e] = Z[(size_t)(I.T - 3 + j) * DIN + O_MX + c];
    }
}
__device__ __forceinline__ void st_mlstm(const Params& P, const Item& I, float* sm) {
    if (blockIdx.x >= MH) return;
    const int h = blockIdx.x, j = threadIdx.x;
    const float* Z = P.ws + W_Z; const float* MQ = P.ws + W_MQ; const float* MK = P.ws + W_MK;
    float* NUM = P.ws + W_NUM; float* DEN = P.ws + W_DEN; float* MT = P.ws + W_MT;
    float* qs = sm;
    float* ks = sm + 8 * 128;
    float c[128];
    float m = 0.f;
    if (I.samp) {
        m = P.in[I_SM][I.b * MH + h];
        const float* C0 = P.in[I_SC] + ((size_t)I.b * MH + h) * MD * MD;
        const float* n0 = P.in[I_SN] + ((size_t)I.b * MH + h) * MD;
#pragma unroll
        for (int dk = 0; dk < 128; ++dk) c[dk] = (j < 128) ? C0[(size_t)dk * MD + j] : (j == 128 ? n0[dk] : 0.f);
    } else {
#pragma unroll
        for (int dk = 0; dk < 128; ++dk) c[dk] = 0.f;
    }
    for (int t0 = 0; t0 < I.T; t0 += 8) {
        __syncthreads();
        for (int e = threadIdx.x; e < 8 * 128; e += blockDim.x) {
            const int tt = e >> 7, d = e & 127;
            const bool ok = (t0 + tt) < I.T;
            qs[e] = ok ? MQ[(size_t)(t0 + tt) * MW + h * MD + d] : 0.f;
            ks[e] = ok ? MK[(size_t)(t0 + tt) * MW + h * MD + d] : 0.f;
        }
        __syncthreads();
        const int nt = (I.T - t0) < 8 ? (I.T - t0) : 8;
        for (int tt = 0; tt < nt; ++tt) {
            const int t = t0 + tt;
            const float* z = Z + (size_t)t * DIN;
            const float lf = logsigmoidf_(z[O_MF + h]), ig = z[O_MI + h];
            const float mn = fmaxf(lf + m, ig);
            const float a = expf(lf + m - mn), bb = expf(ig - mn);
            const float vj = (j < 128) ? z[O_MV + h * MD + j] : 1.f;
            const float bv = bb * vj;
            float acc0 = 0.f, acc1 = 0.f, acc2 = 0.f, acc3 = 0.f;
#pragma unroll
            for (int dk = 0; dk < 128; dk += 4) {
                const float4 kk = *(const float4*)(ks + tt * 128 + dk);
                const float4 qq = *(const float4*)(qs + tt * 128 + dk);
                c[dk] = a * c[dk] + bv * kk.x; acc0 += qq.x * c[dk];
                c[dk + 1] = a * c[dk + 1] + bv * kk.y; acc1 += qq.y * c[dk + 1];
                c[dk + 2] = a * c[dk + 2] + bv * kk.z; acc2 += qq.z * c[dk + 2];
                c[dk + 3] = a * c[dk + 3] + bv * kk.w; acc3 += qq.w * c[dk + 3];
            }
            const float acc = (acc0 + acc1) + (acc2 + acc3);
            if (j < 128) NUM[(size_t)t * MW + h * MD + j] = acc;
            else if (j == 128) { DEN[(size_t)t * MH + h] = acc; MT[(size_t)t * MH + h] = mn; }
            m = mn;
        }
    }
    float* oC = P.out + (I.samp ? OUT_CS : OUT_CP) + ((size_t)I.b * MH + h) * MD * MD;
    float* on = P.out + (I.samp ? OUT_NS : OUT_NP) + ((size_t)I.b * MH + h) * MD;
    float* om = P.out + (I.samp ? OUT_MS : OUT_MP) + (size_t)I.b * MH + h;
#pragma unroll
    for (int dk = 0; dk < 128; ++dk) { if (j < 128) oC[(size_t)dk * MD + j] = c[dk]; else if (j == 128) on[dk] = c[dk]; }
    if (j == 0) *om = m;
}
__device__ __forceinline__ void st_hm(const Params& P, const Item& I) {
    const int lane = threadIdx.x & 63, wv = threadIdx.x >> 6;
    const float* Z = P.ws + W_Z; const float* NUM = P.ws + W_NUM; const float* DEN = P.ws + W_DEN; const float* MT = P.ws + W_MT; const float* XC = P.ws + W_XC;
    float* HM = P.ws + W_HM;
    for (int t = blockIdx.x * 4 + wv; t < I.T; t += gridDim.x * 4) {
        const int c0 = lane * 8, h = lane >> 4;
        const float den = DEN[(size_t)t * MH + h], mt = MT[(size_t)t * MH + h];
        const float dd = fmaxf(fabsf(den), expf(-mt));
        float v[8]; float ss = 0.f;
#pragma unroll
        for (int jj = 0; jj < 8; ++jj) { const float hc = NUM[(size_t)t * MW + c0 + jj] / dd; v[jj] = sigmoidf_(Z[(size_t)t * DIN + O_MO + c0 + jj]) * hc; ss += v[jj] * v[jj]; }
#pragma unroll
        for (int o = 1; o < 16; o <<= 1) ss += __shfl_xor(ss, o);
        const float r = rsqrtf(ss * (1.f / MD) + EPS);
#pragma unroll
        for (int jj = 0; jj < 8; ++jj) HM[(size_t)t * MW + c0 + jj] = v[jj] * r * P.in[I_GMN][c0 + jj] + P.in[I_SKIP][c0 + jj] * XC[(size_t)t * MW + c0 + jj];
    }
}
__device__ __forceinline__ void st_merge(const Params& P, const Item& I) {
    const float* Z = P.ws + W_Z; float* YA = P.ws + W_YA; const float* YB = P.ws + W_YB;
    const int n = I.T * D;
    for (int e = blockIdx.x * blockDim.x + threadIdx.x; e < n; e += gridDim.x * blockDim.x) {
        const int t = e / D, c = e % D;
        YA[e] = sigmoidf_(Z[(size_t)t * DIN + O_GA + c]) * YA[e] + sigmoidf_(Z[(size_t)t * DIN + O_GB + c]) * YB[e];
    }
}
__device__ __forceinline__ void st_mid(const Params& P, const Item& I) {
    const int lane = threadIdx.x & 63, wv = threadIdx.x >> 6;
    const float* OB = P.ws + W_OB; float* X1 = P.ws + W_X1; float* H2 = P.ws + W_H2;
    for (int t = blockIdx.x * 4 + wv; t < I.T; t += gridDim.x * 4) {
        const float* x = xrow(P, I, t);
        float v[16]; float ss = 0.f;
#pragma unroll
        for (int jj = 0; jj < 16; ++jj) { v[jj] = OB[(size_t)t * D + lane + 64 * jj]; ss += v[jj] * v[jj]; }
        ss = wave_sum(ss);
        const float r = rsqrtf(ss * (1.f / D) + EPS);
        float s2 = 0.f;
#pragma unroll
        for (int jj = 0; jj < 16; ++jj) { v[jj] = x[lane + 64 * jj] + v[jj] * r * P.in[I_GPOST][lane + 64 * jj]; s2 += v[jj] * v[jj]; }
        s2 = wave_sum(s2);
        const float r2 = rsqrtf(s2 * (1.f / D) + EPS);
#pragma unroll
        for (int jj = 0; jj < 16; ++jj) { X1[(size_t)t * D + lane + 64 * jj] = v[jj]; H2[(size_t)t * D + lane + 64 * jj] = v[jj] * r2 * P.in[I_GPREF][lane + 64 * jj]; }
    }
}
__device__ __forceinline__ void st_act(const Params& P, const Item& I) {
    const float* GU = P.ws + W_GU; float* ACT = P.ws + W_ACT;
    const int n = I.T * DFF;
    for (int e = blockIdx.x * blockDim.x + threadIdx.x; e < n; e += gridDim.x * blockDim.x) {
        const int t = e / DFF, c = e % DFF;
        ACT[e] = siluf_(GU[(size_t)t * 2 * DFF + c]) * GU[(size_t)t * 2 * DFF + DFF + c];
    }
}
__device__ __forceinline__ void st_final(const Params& P, const Item& I) {
    const int lane = threadIdx.x & 63, wv = threadIdx.x >> 6;
    const float* FFO = P.ws + W_FFO; const float* X1 = P.ws + W_X1;
    for (int t = blockIdx.x * 4 + wv; t < I.T; t += gridDim.x * 4) {
        float* y;
        if (I.samp) y = P.out + OUT_YS + ((size_t)I.b * DEC_T + t) * D;
        else { if (t < NMETA) continue; y = P.out + OUT_YP + ((size_t)I.b * SEQ + (t - NMETA)) * D; }
        float v[16]; float ss = 0.f;
#pragma unroll
        for (int jj = 0; jj < 16; ++jj) { v[jj] = FFO[(size_t)t * D + lane + 64 * jj]; ss += v[jj] * v[jj]; }
        ss = wave_sum(ss);
        const float r = rsqrtf(ss * (1.f / D) + EPS);
#pragma unroll
        for (int jj = 0; jj < 16; ++jj) y[lane + 64 * jj] = X1[(size_t)t * D + lane + 64 * jj] + v[jj] * r * P.in[I_GPOSTF][lane + 64 * jj];
    }
}

constexpr int NSTAGE = 17;
template <int s> __device__ __forceinline__ void run_stage(const Params& P, const Item& I, float* sm) {
    float* ws = P.ws;
    switch (s) {
    case 0: st_norm_in(P, I); break;
    case 1: sgemm(ws + W_H, D, P.in[I_WIN], DIN, ws + W_Z, DIN, I.T, DIN, D, P.in[I_BIN], 1.f, sm); break;
    case 2: st_fox_prep(P, I); break;
    case 3: st_fcum(P, I); break;
    case 4: st_attn(P, I, sm); break;
    case 5: st_conv(P, I); break;
    case 6:
        for (int h = 0; h < MH; ++h) {
            sgemm(ws + W_XC + h * MD, MW, P.in[I_WMQ] + (size_t)h * MD * MD, MD, ws + W_MQ + h * MD, MW, I.T, MD, MD, nullptr, 1.f, sm);
            sgemm(ws + W_XC + h * MD, MW, P.in[I_WMK] + (size_t)h * MD * MD, MD, ws + W_MK + h * MD, MW, I.T, MD, MD, nullptr, 0.08838834764831845f, sm);
        }
        break;
    case 7: st_mlstm(P, I, sm); break;
    case 8: st_hm(P, I); break;
    case 9:
        sgemm(ws + W_AT, FW, P.in[I_WFOX], D, ws + W_YA, D, I.T, D, FW, nullptr, 1.f, sm);
        sgemm(ws + W_HM, MW, P.in[I_WML], D, ws + W_YB, D, I.T, D, MW, nullptr, 1.f, sm);
        break;
    case 10: st_merge(P, I); break;
    case 11: sgemm(ws + W_YA, D, P.in[I_WOUT], D, ws + W_OB, D, I.T, D, D, nullptr, 1.f, sm); break;
    case 12: st_mid(P, I); break;
    case 13: sgemm(ws + W_H2, D, P.in[I_WGU], 2 * DFF, ws + W_GU, 2 * DFF, I.T, 2 * DFF, D, nullptr, 1.f, sm); break;
    case 14: st_act(P, I); break;
    case 15: sgemm(ws + W_ACT, DFF, P.in[I_WDN], D, ws + W_FFO, D, I.T, D, DFF, nullptr, 1.f, sm); break;
    case 16: st_final(P, I); break;
    }
}

template <int s> __global__ void __launch_bounds__(256) stage_kernel(Params P) {
    __shared__ __attribute__((aligned(16))) float sm[2304];
    for (int it = P.item_lo; it < P.item_hi; ++it) { const Item I = get_item(it); run_stage<s>(P, I, sm); }
}
template <int s> struct StageLoop {
    static void launch(const Params& P, int grid, hipStream_t stream) { StageLoop<s - 1>::launch(P, grid, stream); hipLaunchKernelGGL(stage_kernel<s>, dim3(grid), dim3(256), 0, stream, P); }
    template <class H> static void launch_hook(const Params& P, int grid, hipStream_t stream, int it, H& hook) { StageLoop<s - 1>::launch_hook(P, grid, stream, it, hook); hipLaunchKernelGGL(stage_kernel<s>, dim3(grid), dim3(256), 0, stream, P); hook(it, s); }
};
template <> struct StageLoop<-1> {
    static void launch(const Params&, int, hipStream_t) {}
    template <class H> static void launch_hook(const Params&, int, hipStream_t, int, H&) {}
};
#endif

namespace pg8 {
#define PG8_LAS __attribute__((address_space(3)))
typedef unsigned short bf16_t;
typedef short bf16x8 __attribute__((ext_vector_type(8)));
typedef float f32x4 __attribute__((ext_vector_type(4)));
typedef unsigned u32x4 __attribute__((ext_vector_type(4)));
constexpr int BM = 256, BK = 64, HALF = 128, HTB = HALF * BK * 2  , STAGE_BYTES = 8 * HTB, NXCD = 8, WGM = 8;

__host__ __device__ __forceinline__ int lds_byte(int r, int c) { const int st = (r >> 4) * 2 + (c >> 5), rr = r & 15, cc = c & 31, ob = rr * 64 + cc * 2; return st * 1024 + (ob ^ (((ob >> 9) & 1) << 5)); }
__host__ __device__ __forceinline__ void stage_rc(int b, int& R, int& C) { const int st = b / 1024, sb = b % 1024, swz = sb ^ (((sb >> 9) & 1) << 5); R = (st >> 1) * 16 + swz / 64; C = (st & 1) * 32 + (swz % 64) / 2; }
__host__ __device__ __forceinline__ int perm32(int rho) { const int n = rho >> 4, i = rho & 15; return 8 * (i >> 2) + 4 * n + (i & 3); }

struct Unit { int pm, pn; };
struct Gemm { const bf16_t* A; const bf16_t* Bt; int M, N, K; };

struct StaticOrder {
    int nM, nN, nwg, G, c;
    __host__ __device__ void init(int M, int N, int G_, int c_) { nM = M / BM; nN = N / BM; nwg = nM * nN; G = G_; c = c_; }
    __host__ __device__ bool next(int i, Unit& u) const {
        const long L = (long)i * G + c; if (L >= nwg) return false;
        int wgid = (int)L; { const int q = nwg / NXCD, r = nwg % NXCD, xcd = wgid % NXCD, off = wgid / NXCD; wgid = (xcd < r ? xcd * (q + 1) : r * (q + 1) + (xcd - r) * q) + off; }
        const int nig = WGM * nN, gid = wgid / nig, fm = gid * WGM, gsz = (nM - fm) < WGM ? (nM - fm) : WGM;
        u.pm = fm + ((wgid % nig) % gsz); u.pn = (wgid % nig) / gsz; return true;
    }
    __device__ __forceinline__ void a_ready(const Unit&) const {}
    __device__ __forceinline__ void done(const Unit&) const {}
};

__device__ __forceinline__ unsigned cvt_pk_bf16(float lo, float hi) { unsigned r; asm volatile("v_cvt_pk_bf16_f32 %0, %1, %2" : "=v"(r) : "v"(lo), "v"(hi)); return r; }
typedef float f32x2 __attribute__((ext_vector_type(2)));
__device__ __forceinline__ f32x2 gelu_pk(f32x2 v) {
    const f32x2 av = __builtin_elementwise_abs(v), d = av * 0.2316418882f + 1.0f;
    f32x2 t; t.x = __builtin_amdgcn_rcpf(d.x); t.y = __builtin_amdgcn_rcpf(d.y);
    f32x2 q = t * 0.5307027145f + (-0.7265760135f); q = q * t + 0.7107068705f; q = q * t + (-0.142248368f); q = q * t + 0.127414796f; q = q * t;
    const f32x2 s = (v * v) * (-0.72134752044f);
    f32x2 e; e.x = __builtin_amdgcn_exp2f(s.x); e.y = __builtin_amdgcn_exp2f(s.y);
    const f32x2 m = v * (q * e), r = v - m;
    f32x2 o; o.x = v.x < 0.f ? m.x : r.x; o.y = v.y < 0.f ? m.y : r.y; return o;
}

template <int ACT  > struct EpiBf16 {
    static constexpr bool PERM = true, AFTER_DRAIN = false; static_assert(ACT == 0 || ACT == 1, "EpiBf16: ACT is 0 (none) or 1 (gelu_pk)");
    bf16_t* O; int ldc; const float* bias; int split_cols; size_t split_stride; float scale0;
    __device__ __forceinline__ void operator()(const f32x4 (&acc)[2][2][4][2], const Unit& u, int wr, int wc, int fr, int fq) const {
        const int row0 = u.pm * BM + wr * 64 + fr; int colt = u.pn * BM; bf16_t* base = O;
        float sc = 1.f; if (split_cols) { const int t = colt / split_cols; base += (size_t)t * split_stride; colt -= t * split_cols; if (t == 0) sc = scale0; }
        const int col0 = colt + wc * 32 + 8 * fq, bcol0 = u.pn * BM + wc * 32 + 8 * fq;
        f32x4 bv[2][2];
#pragma unroll
        for (int bj = 0; bj < 2; ++bj)
#pragma unroll
            for (int n = 0; n < 2; ++n) bv[bj][n] = bias ? *(const f32x4*)(bias + bcol0 + bj * HALF + 4 * n) : (f32x4){0.f, 0.f, 0.f, 0.f};
#pragma unroll
        for (int ai = 0; ai < 2; ++ai)
#pragma unroll
            for (int m = 0; m < 4; ++m) { bf16_t* rowp = base + (size_t)(row0 + ai * HALF + m * 16) * ldc + col0;
#pragma unroll
                for (int bj = 0; bj < 2; ++bj) { f32x4 v0 = acc[ai][bj][m][0] + bv[bj][0], v1 = acc[ai][bj][m][1] + bv[bj][1];
                    if (ACT == 1) { f32x2 a = gelu_pk((f32x2){v0[0], v0[1]}), b = gelu_pk((f32x2){v0[2], v0[3]}), c = gelu_pk((f32x2){v1[0], v1[1]}), d = gelu_pk((f32x2){v1[2], v1[3]});
                        v0 = (f32x4){a.x, a.y, b.x, b.y}; v1 = (f32x4){c.x, c.y, d.x, d.y}; }
                    v0 = v0 * sc; v1 = v1 * sc; u32x4 w; w.x = cvt_pk_bf16(v0[0], v0[1]); w.y = cvt_pk_bf16(v0[2], v0[3]); w.z = cvt_pk_bf16(v1[0], v1[1]); w.w = cvt_pk_bf16(v1[2], v1[3]);
                    *(u32x4*)(rowp + bj * HALF) = w; } }
    }
};
template <class Epi, class Sched, bool ALIGN_EPI = false, bool SP2 = false>
__device__ __forceinline__ void gemm_phase(PG8_LAS unsigned char* lds, const Gemm g, const Sched& S, const Epi& E) {
    const int tid = threadIdx.x, wid = __builtin_amdgcn_readfirstlane(tid >> 6), lane = tid & 63, wr = wid >> 2, wc = wid & 3, fr = lane & 15, fq = lane >> 4;
    const int K = g.K, nt = K / BK;
    unsigned voffA[2], voffB[2];
#pragma unroll
    for (int i = 0; i < 2; ++i) { int R, C; stage_rc(tid * 16 + i * 8192, R, C); const int Rb = Epi::PERM ? ((R & ~31) + perm32(R & 31)) : R;
        voffA[i] = (unsigned)(R * K + C) * 2u; voffB[i] = (unsigned)(Rb * K + C) * 2u; }
    const size_t kstep = (size_t)(BK * 2);
    const size_t hstep = (size_t)HALF * K * 2;
    const size_t tstep = 2 * hstep;
    const unsigned ldsw = (unsigned)wid * 1024u;
    const int aoff = lds_byte(wr * 64 + fr, fq * 8), boff = lds_byte(wc * 32 + fr, fq * 8);
#define PG8_SA(b, h) (((b) * 2 + (h)) * HTB)
#define PG8_SB(b, h) ((4 + (b) * 2 + (h)) * HTB)
#define PG8_STAGE(bufoff, gbase, voff) do { _Pragma("unroll") for (int _i = 0; _i < 2; ++_i) \
        __builtin_amdgcn_global_load_lds((const unsigned*)((const char*)(gbase) + (voff)[_i]), (PG8_LAS unsigned*)(lds + (bufoff) + ldsw + _i * 8192), 16, 0, 0); } while (0)
#define PG8_LDA(dst, b, h) do { _Pragma("unroll") for (int m = 0; m < 4; ++m) _Pragma("unroll") for (int k = 0; k < 2; ++k) dst[m][k] = *(const PG8_LAS bf16x8*)(lds + PG8_SA(b, h) + aoff + m * 2048 + k * 1024); } while (0)
#define PG8_LDB(dst, b, h) do { _Pragma("unroll") for (int n = 0; n < 2; ++n) _Pragma("unroll") for (int k = 0; k < 2; ++k) dst[n][k] = *(const PG8_LAS bf16x8*)(lds + PG8_SB(b, h) + boff + n * 2048 + k * 1024); } while (0)
#define PG8_MMA(ai, bj, At, Bt) do { __builtin_amdgcn_s_setprio(1); _Pragma("unroll") for (int m = 0; m < 4; ++m) _Pragma("unroll") for (int n = 0; n < 2; ++n) _Pragma("unroll") for (int k = 0; k < 2; ++k) \
        acc[ai][bj][m][n] = __builtin_amdgcn_mfma_f32_16x16x32_bf16(Bt[n][k], At[m][k], acc[ai][bj][m][n], 0, 0, 0); __builtin_amdgcn_s_setprio(0); } while (0)
#define PG8_WAIT_V(n) asm volatile("s_waitcnt vmcnt(" #n ")" ::: "memory")
#define PG8_WAIT_L(n) asm volatile("s_waitcnt lgkmcnt(" #n ")" ::: "memory")
#define PG8_BAR __builtin_amdgcn_s_barrier()
#define PG8_SCHED __builtin_amdgcn_sched_barrier(0)
    Unit cur, nxt; int ui = 0;
    if (!S.next(0, cur)) return;
    f32x4 acc[2][2][4][2];
#pragma unroll
    for (int a = 0; a < 2; ++a)
#pragma unroll
        for (int b = 0; b < 2; ++b)
#pragma unroll
            for (int m = 0; m < 4; ++m)
#pragma unroll
                for (int n = 0; n < 2; ++n) acc[a][b][m][n] = (f32x4){0.f, 0.f, 0.f, 0.f};
    bf16x8 At[4][2], B0[2][2], B1[2][2];
    const char* cA = (const char*)g.A + (size_t)cur.pm * tstep; const char* cB = (const char*)g.Bt + (size_t)cur.pn * tstep;
    S.a_ready(cur);
    if constexpr (SP2) {
        PG8_STAGE(PG8_SB(0, 0), cB, voffB); PG8_STAGE(PG8_SB(0, 1), cB + hstep, voffB); PG8_STAGE(PG8_SA(0, 0), cA, voffA); PG8_STAGE(PG8_SA(0, 1), cA + hstep, voffA);
        if (wr == 1) PG8_BAR;
        PG8_WAIT_V(2); PG8_BAR;
        PG8_STAGE(PG8_SB(1, 0), cB + kstep, voffB); PG8_STAGE(PG8_SA(1, 0), cA + kstep, voffA); PG8_STAGE(PG8_SB(1, 1), cB + hstep + kstep, voffB);
        PG8_WAIT_V(6); PG8_BAR;
    } else {
        PG8_STAGE(PG8_SB(0, 0), cB, voffB); PG8_STAGE(PG8_SA(0, 0), cA, voffA); PG8_STAGE(PG8_SB(0, 1), cB + hstep, voffB); PG8_STAGE(PG8_SA(0, 1), cA + hstep, voffA);
        if (wr == 1) PG8_BAR;
        PG8_WAIT_V(4); PG8_BAR;
        PG8_STAGE(PG8_SB(1, 0), cB + kstep, voffB); PG8_STAGE(PG8_SA(1, 0), cA + kstep, voffA); PG8_STAGE(PG8_SB(1, 1), cB + hstep + kstep, voffB);
        PG8_WAIT_V(6); PG8_BAR;
    }
    for (;;) {
        const bool has_next = S.next(ui + 1, nxt);
        const char* nA = has_next ? (const char*)g.A + (size_t)nxt.pm * tstep : cA; const char* nB = has_next ? (const char*)g.Bt + (size_t)nxt.pn * tstep : cB;
        for (int t = 0; t < nt; t += 2) {
            const bool last = (t == nt - 2);
            const char* a1 = cA + (size_t)(t + 1) * kstep;
            const char* a2 = last ? nA : cA + (size_t)(t + 2) * kstep; const char* b2 = last ? nB : cB + (size_t)(t + 2) * kstep;
            const char* a3 = a2 + kstep; const char* b3 = b2 + kstep;
            if (last && has_next) S.a_ready(nxt);
            if constexpr (SP2) {
            PG8_LDB(B0, 0, 0); PG8_LDB(B1, 0, 1); PG8_SCHED; PG8_LDA(At, 0, 0); PG8_STAGE(PG8_SA(1, 1), a1 + hstep, voffA);
            PG8_WAIT_V(8); PG8_WAIT_L(0); PG8_BAR; PG8_MMA(0, 0, At, B0); PG8_MMA(0, 1, At, B1); PG8_BAR; PG8_SCHED;
            PG8_LDA(At, 0, 1); PG8_STAGE(PG8_SB(0, 0), b2, voffB); PG8_STAGE(PG8_SB(0, 1), b2 + hstep, voffB); PG8_STAGE(PG8_SA(0, 0), a2, voffA);
            PG8_WAIT_V(8); PG8_WAIT_L(0); PG8_BAR; PG8_MMA(1, 0, At, B0); PG8_MMA(1, 1, At, B1); PG8_BAR; PG8_SCHED;
            PG8_LDB(B0, 1, 0); PG8_LDB(B1, 1, 1); PG8_SCHED; PG8_LDA(At, 1, 0); PG8_STAGE(PG8_SA(0, 1), a2 + hstep, voffA);
            PG8_WAIT_V(8); PG8_WAIT_L(0); PG8_BAR; PG8_MMA(0, 0, At, B0); PG8_MMA(0, 1, At, B1); PG8_BAR; PG8_SCHED;
            PG8_LDA(At, 1, 1); PG8_STAGE(PG8_SB(1, 0), b3, voffB); PG8_STAGE(PG8_SB(1, 1), b3 + hstep, voffB); PG8_STAGE(PG8_SA(1, 0), a3, voffA);
            PG8_WAIT_V(8); PG8_WAIT_L(0); PG8_BAR; PG8_MMA(1, 0, At, B0); PG8_MMA(1, 1, At, B1); PG8_BAR; PG8_SCHED;
            } else {
            PG8_LDB(B0, 0, 0); PG8_SCHED; PG8_LDA(At, 0, 0); PG8_STAGE(PG8_SA(1, 1), a1 + hstep, voffA);
            PG8_WAIT_L(8); PG8_BAR; PG8_WAIT_L(0); PG8_MMA(0, 0, At, B0); PG8_BAR; PG8_SCHED;
            PG8_LDB(B1, 0, 1); PG8_STAGE(PG8_SB(0, 0), b2, voffB);
            PG8_BAR; PG8_WAIT_L(0); PG8_MMA(0, 1, At, B1); PG8_BAR;
            PG8_LDA(At, 0, 1); PG8_STAGE(PG8_SA(0, 0), a2, voffA);
            PG8_BAR; PG8_WAIT_L(0); PG8_MMA(1, 0, At, B0); PG8_BAR; PG8_SCHED;
            PG8_STAGE(PG8_SB(0, 1), b2 + hstep, voffB);
            PG8_WAIT_V(6); PG8_BAR; PG8_MMA(1, 1, At, B1); PG8_BAR;
            PG8_LDB(B0, 1, 0); PG8_SCHED; PG8_LDA(At, 1, 0); PG8_STAGE(PG8_SA(0, 1), a2 + hstep, voffA);
            PG8_WAIT_L(8); PG8_BAR; PG8_WAIT_L(0); PG8_MMA(0, 0, At, B0); PG8_BAR; PG8_SCHED;
            PG8_LDB(B1, 1, 1); PG8_STAGE(PG8_SB(1, 0), b3, voffB);
            PG8_BAR; PG8_WAIT_L(0); PG8_MMA(0, 1, At, B1); PG8_BAR;
            PG8_LDA(At, 1, 1); PG8_STAGE(PG8_SA(1, 0), a3, voffA);
            PG8_BAR; PG8_WAIT_L(0); PG8_MMA(1, 0, At, B0); PG8_BAR; PG8_SCHED;
            PG8_STAGE(PG8_SB(1, 1), b3 + hstep, voffB);
            PG8_WAIT_V(6); PG8_BAR; PG8_MMA(1, 1, At, B1); PG8_BAR;
            }
        }
        if constexpr (ALIGN_EPI) { if (wr == 0) PG8_BAR; }
        if constexpr (!Epi::AFTER_DRAIN) { E(acc, cur, wr, wc, fr, fq); S.done(cur); }
        if (!has_next) break;
#pragma unroll
        for (int a = 0; a < 2; ++a)
#pragma unroll
            for (int b = 0; b < 2; ++b)
#pragma unroll
                for (int m = 0; m < 4; ++m)
#pragma unroll
                    for (int n = 0; n < 2; ++n) acc[a][b][m][n] = (f32x4){0.f, 0.f, 0.f, 0.f};
        cur = nxt; cA = nA; cB = nB; ++ui;
        if constexpr (ALIGN_EPI) { if (wr == 1) PG8_BAR; }
    }
    PG8_WAIT_V(0);
    if constexpr (!ALIGN_EPI) { if (wr == 0) PG8_BAR; }
    PG8_BAR;
    if constexpr (Epi::AFTER_DRAIN) { E.fused(acc, cur, wr, wc, fr, fq, lds, wid, lane); S.done(cur); }
#undef PG8_SA
#undef PG8_SB
#undef PG8_STAGE
#undef PG8_LDA
#undef PG8_LDB
#undef PG8_MMA
#undef PG8_WAIT_V
#undef PG8_WAIT_L
#undef PG8_BAR
#undef PG8_SCHED
}
}

#ifndef FAST_NPB
#define FAST_NPB 8
#endif
#define LAS __attribute__((address_space(3)))
#define GAS __attribute__((address_space(1)))
namespace fk {
using pg8::bf16_t;
typedef unsigned v4u __attribute__((ext_vector_type(4)));
typedef unsigned v2u __attribute__((ext_vector_type(2)));
typedef float f32x4 __attribute__((ext_vector_type(4)));
typedef float f32x16 __attribute__((ext_vector_type(16)));
typedef short bf16x8 __attribute__((ext_vector_type(8)));
typedef short s16x4 __attribute__((ext_vector_type(4)));
constexpr int NPB = FAST_NPB;
constexpr int RP = 4160, PADF = 48, NCH = RP / 64;
constexpr int SROW0 = NPB * RP;
constexpr int MREAL = SROW0 + NB * DEC_T;
constexpr int M = (MREAL + 255) / 256 * 256;
constexpr size_t SE = (size_t)M * 512;
constexpr size_t SB = SE * 2;
constexpr int NZ = 5376;
constexpr size_t MiB = 1u << 20;
constexpr size_t alignM(size_t x) { return (x + MiB - 1) / MiB * MiB; }
constexpr size_t WS_CTL = 0, CTL_ZERO_BYTES = 1 * MiB;
constexpr size_t WS_WIN = 1 * MiB, WS_WGU = 12 * MiB, WS_WDN = 23 * MiB, WS_WOUT = 29 * MiB, WS_WFOX = 31 * MiB, WS_WML = 32 * MiB, WS_WMQ = 33 * MiB, WS_WMK = 33 * MiB + 131072, WS_BIAS = 34 * MiB;
constexpr size_t WS_A = 35 * MiB;
constexpr size_t WS_Z = WS_A + alignM(2 * SB);
constexpr int ZQ = 0, ZK = 1, ZV = 2, ZMX = 3, ZMV = 4, ZMO = 5, ZGA = 6, ZGB = 8, ZGT = 10;
constexpr size_t WS_MISC = alignM(WS_Z + 11 * SB);
constexpr int NBPL = 4416;
constexpr int NBSL = 1280;
constexpr int NITEM_L = (NPB * NCH + NB) * MH;
constexpr size_t MS_NBP = 0;
constexpr size_t MS_NBS = MS_NBP + (size_t)NPB * FH * NBPL * 4;
constexpr size_t MS_BT = MS_NBS + (size_t)NB * FH * NBSL * 4;
constexpr size_t MS_IGT = MS_BT + (size_t)M * MH * 4;
constexpr size_t MS_CHS = MS_IGT + (size_t)M * MH * 4;
constexpr size_t MS_NL = MS_CHS + (size_t)NITEM_L * 2 * 4;
constexpr size_t MS_JST = MS_NL + (size_t)NITEM_L * MD * 4;
constexpr size_t MS_MC = MS_JST + (size_t)(NPB * FH * 17 + 64) * 4;
constexpr size_t MS_END = MS_MC + (size_t)NITEM_L * 4;
constexpr size_t WS_KS = alignM(WS_MISC + MS_END);
constexpr size_t WS_VS = WS_KS + (size_t)NB * NBSL * FW * 2;
constexpr size_t WS_SCR = alignM(WS_VS + (size_t)NB * NBSL * FW * 2);
constexpr size_t SCR_BYTES = 3 * SB + 4096;
#if FAST_NPB == 8
constexpr size_t WS_FASTEND = WS_SCR;
static_assert(SCR_BYTES <= (size_t)NB * SEQ * D * 4, "scratch fits y_prompt");
#else
constexpr size_t WS_FASTEND = alignM(WS_SCR + SCR_BYTES + 2 * (size_t)M * D * 4);
#endif
constexpr int CW_TMO = 0, CW_BAR = 4096, CW_QUE = 16384;

struct FP { const float* in[29]; float* out; unsigned char* ws; unsigned char* scr; int ph_lo, ph_hi; };

#define LDS_WAIT() asm volatile("s_waitcnt lgkmcnt(0)" ::: "memory")
#define VM_WAIT() asm volatile("s_waitcnt vmcnt(0)" ::: "memory")
__device__ __forceinline__ unsigned f2bf(float f) { unsigned u = __builtin_bit_cast(unsigned, f); return (u + 0x7fffu + ((u >> 16) & 1u)) >> 16; }
__device__ __forceinline__ unsigned pk2(float lo, float hi) { return f2bf(lo) | (f2bf(hi) << 16); }
__device__ __forceinline__ float bf2f(unsigned short b) { return __builtin_bit_cast(float, (unsigned)b << 16); }
__device__ __forceinline__ float bflo(unsigned w) { return __builtin_bit_cast(float, w << 16); }
__device__ __forceinline__ float bfhi(unsigned w) { return __builtin_bit_cast(float, w & 0xffff0000u); }

__device__ __forceinline__ void tr_item(const float* W, int K, int N, int col0, int ncols, bf16_t* WT, int row_off, LAS float* scr, int item, int lane) {
    const int nblk = ncols / 32, kb = item / nblk, nb = item % nblk, k0 = 64 * kb, n0 = 32 * nb;
#pragma unroll 8
    for (int i = 0; i < 32; ++i) { const int kk = 2 * i + (lane >> 5); scr[kk * 33 + (lane & 31)] = W[(size_t)(k0 + kk) * N + col0 + n0 + (lane & 31)]; }
    LDS_WAIT(); asm volatile("" ::: "memory");
    const int c = lane & 7;
#pragma unroll
    for (int j = 0; j < 4; ++j) { const int n = (lane >> 3) + 8 * j; const LAS float* s = scr + (8 * c) * 33 + n;
        v4u o; o.x = pk2(s[0 * 33], s[1 * 33]); o.y = pk2(s[2 * 33], s[3 * 33]); o.z = pk2(s[4 * 33], s[5 * 33]); o.w = pk2(s[6 * 33], s[7 * 33]);
        *(v4u*)(WT + (size_t)(row_off + n0 + n) * K + k0 + 8 * c) = o; }
    LDS_WAIT(); asm volatile("" ::: "memory");
}
__device__ __forceinline__ const float* fast_xrow(const FP& P, int r) {
    if (r < SROW0) { const int b = r / RP, p = r % RP; if (p < PADF) return nullptr; const int t = p - PADF;
        return t < NMETA ? P.in[I_META] + (size_t)t * D : P.in[I_XP] + ((size_t)b * SEQ + (t - NMETA)) * D; }
    if (r < MREAL) return P.in[I_XS] + (size_t)(r - SROW0) * D;
    return nullptr;
}
__device__ __forceinline__ void p0_prologue(const FP& P, LAS unsigned char* lds) {
    const int tid = threadIdx.x, lane = tid & 63, wave = tid >> 6;
    const int gw = blockIdx.x * 8 + wave, NGW = gridDim.x * 8;
    unsigned char* ws = P.ws;
    bf16_t* Win_t = (bf16_t*)(ws + WS_WIN); bf16_t* Wgu_t = (bf16_t*)(ws + WS_WGU); bf16_t* Wdn_t = (bf16_t*)(ws + WS_WDN); bf16_t* Wout_t = (bf16_t*)(ws + WS_WOUT);
    bf16_t* Wfox_t = (bf16_t*)(ws + WS_WFOX); bf16_t* Wml_t = (bf16_t*)(ws + WS_WML); bf16_t* Wmq_t = (bf16_t*)(ws + WS_WMQ); bf16_t* Wmk_t = (bf16_t*)(ws + WS_WMK);
    LAS float* scr = (LAS float*)(lds + wave * 16384);
    constexpr int I_IN = 16 * (5120 / 32), I_GU = 44 * 64, I_DN = 44 * 32, I_OUT = 16 * 32, I_FOX = 8 * 32, I_MQ = 4 * 8;
    constexpr int NITEMS = I_IN + I_GU + I_DN + I_OUT + 2 * I_FOX + 2 * I_MQ;
    for (int it = gw; it < NITEMS; it += NGW) {
        int r = it;
        if (r < I_IN) {
            if (r < 768) { tr_item(P.in[I_WIN], D, DIN, 0, 1536, Win_t, 0, scr, r, lane); continue; } r -= 768;
            if (r < 256) { tr_item(P.in[I_WIN], D, DIN, O_MX, 512, Win_t, 1536, scr, r, lane); continue; } r -= 256;
            if (r < 256) { tr_item(P.in[I_WIN], D, DIN, O_MV, 512, Win_t, 2048, scr, r, lane); continue; } r -= 256;
            if (r < 256) { tr_item(P.in[I_WIN], D, DIN, O_MO, 512, Win_t, 2560, scr, r, lane); continue; } r -= 256;
            if (r < 512) { tr_item(P.in[I_WIN], D, DIN, O_GA, 1024, Win_t, 3072, scr, r, lane); continue; } r -= 512;
            tr_item(P.in[I_WIN], D, DIN, O_GB, 1024, Win_t, 4096, scr, r, lane); continue;
        }
        r -= I_IN;
        if (r < I_GU) { const int sg = r / 64, j = sg >> 1, u = sg & 1; tr_item(P.in[I_WGU], D, 2 * DFF, u * DFF + 128 * j, 128, Wgu_t, 256 * j + 128 * u, scr, r % 64, lane); continue; }
        r -= I_GU;
        if (r < I_DN) { tr_item(P.in[I_WDN], DFF, D, 0, D, Wdn_t, 0, scr, r, lane); continue; } r -= I_DN;
        if (r < I_OUT) { tr_item(P.in[I_WOUT], D, D, 0, D, Wout_t, 0, scr, r, lane); continue; } r -= I_OUT;
        if (r < I_FOX) { tr_item(P.in[I_WFOX], FW, D, 0, D, Wfox_t, 0, scr, r, lane); continue; } r -= I_FOX;
        if (r < I_FOX) { tr_item(P.in[I_WML], MW, D, 0, D, Wml_t, 0, scr, r, lane); continue; } r -= I_FOX;
        if (r < I_MQ) { const int h = r / 8; tr_item(P.in[I_WMQ] + (size_t)h * MD * MD, MD, MD, 0, MD, Wmq_t + (size_t)h * MD * MD, 0, scr, r % 8, lane); continue; } r -= I_MQ;
        { const int h = r / 8; tr_item(P.in[I_WMK] + (size_t)h * MD * MD, MD, MD, 0, MD, Wmk_t + (size_t)h * MD * MD, 0, scr, r % 8, lane); }
    }
    {
        const int gt = blockIdx.x * 512 + tid, NT = gridDim.x * 512;
        for (int e = gt; e < 256 * D; e += NT) {
            const int g = e / D, k = e % D;
            float v = 0.f;
            if (g < 16) { const int oc = g < 8 ? O_FF + g : (g < 12 ? O_MI + (g - 8) : O_MF + (g - 12)); v = P.in[I_WIN][(size_t)k * DIN + oc]; }
            Win_t[(size_t)(5120 + g) * D + k] = (bf16_t)f2bf(v);
        }
        float* bias_p = (float*)(ws + WS_BIAS);
        for (int n = gt; n < NZ; n += NT) {
            int oc = -1;
            if (n < 1536) oc = n; else if (n < 2048) oc = O_MX + (n - 1536); else if (n < 2560) oc = O_MV + (n - 2048); else if (n < 3072) oc = O_MO + (n - 2560);
            else if (n < 4096) oc = O_GA + (n - 3072); else if (n < 5120) oc = O_GB + (n - 4096); else if (n < 5128) oc = O_FF + (n - 5120); else if (n < 5132) oc = O_MI + (n - 5128); else if (n < 5136) oc = O_MF + (n - 5132);
            bias_p[n] = oc >= 0 ? P.in[I_BIN][oc] : 0.f;
        }
        bf16_t* KS = (bf16_t*)(ws + WS_KS); bf16_t* VS = (bf16_t*)(ws + WS_VS);
        for (int e = gt; e < NB * NBSL * (FW / 4); e += NT) {
            const int c4 = e % (FW / 4), i = (e / (FW / 4)) % NBSL, b = e / ((FW / 4) * NBSL);
            if (i >= PAST && i < PAST + DEC_T) continue;
            float4 kv = make_float4(0.f, 0.f, 0.f, 0.f), vv = kv;
            if (i < PAST) { kv = *(const float4*)(P.in[I_CK] + ((size_t)b * PAST + i) * FW + c4 * 4); vv = *(const float4*)(P.in[I_CV] + ((size_t)b * PAST + i) * FW + c4 * 4); }
            v2u ko, vo; ko.x = pk2(kv.x, kv.y); ko.y = pk2(kv.z, kv.w); vo.x = pk2(vv.x, vv.y); vo.y = pk2(vv.z, vv.w);
            *(v2u*)(KS + ((size_t)b * NBSL + i) * FW + c4 * 4) = ko; *(v2u*)(VS + ((size_t)b * NBSL + i) * FW + c4 * 4) = vo;
        }
    }
    bf16_t* A = (bf16_t*)(ws + WS_A);
    for (int r = gw; r < M; r += NGW) {
        const float* x = fast_xrow(P, r);
        unsigned long long* o8 = (unsigned long long*)(A + (size_t)r * D) + lane;
        if (!x) {
#pragma unroll
            for (int j = 0; j < 4; ++j) o8[64 * j] = 0ull;
            continue;
        }
        const f32x4* xr = (const f32x4*)x + lane; const f32x4* gr = (const f32x4*)P.in[I_GPRE] + lane;
        f32x4 v[4]; float s = 0.f;
#pragma unroll
        for (int j = 0; j < 4; ++j) { v[j] = xr[64 * j]; s += (v[j].x * v[j].x + v[j].y * v[j].y) + (v[j].z * v[j].z + v[j].w * v[j].w); }
        const float rs = rsqrtf(wave_sum(s) * (1.f / D) + EPS);
#pragma unroll
        for (int j = 0; j < 4; ++j) { const f32x4 g = gr[64 * j]; const f32x4 w = v[j] * rs * g;
            o8[64 * j] = (unsigned long long)pk2(w.x, w.y) | ((unsigned long long)pk2(w.z, w.w) << 32); }
    }
}
}
namespace fk {
constexpr float LOG2E = 1.4426950408889634f;
constexpr float C2Q = 0.125f * LOG2E;
constexpr float NEGBIG = -1e30f;
constexpr float SKIP_THR = 32.f;

__device__ __forceinline__ float wave_scan_add(float v, int lane) {
#pragma unroll
    for (int o = 1; o < 64; o <<= 1) { const float u = __shfl_up(v, o); if (lane >= o) v += u; }
    return v;
}
__device__ __forceinline__ float wave_scan_max(float v, int lane) {
#pragma unroll
    for (int o = 1; o < 64; o <<= 1) { const float u = __shfl_up(v, o); if (lane >= o) v = fmaxf(v, u); }
    return v;
}
__device__ __forceinline__ f32x4 mfma16(bf16x8 a, bf16x8 b, f32x4 c) { return __builtin_amdgcn_mfma_f32_16x16x32_bf16(a, b, c, 0, 0, 0); }

struct ZB {
    bf16_t* z;
    __device__ __forceinline__ bf16_t* buf(int i) const { return z + (size_t)i * SE; }
};

__device__ __forceinline__ void p2_fscan(const FP& P, int sq, LAS float* wl  , int lane) {
    unsigned char* ws = P.ws;
    const bf16_t* GT = (const bf16_t*)(ws + WS_Z) + (size_t)ZGT * SE;
    int* JST = (int*)(ws + WS_MISC + MS_JST);
    float gq = 0.f, gk = 0.f;
#pragma unroll
    for (int j = 0; j < 8; ++j) { gq = fmaxf(gq, fabsf(P.in[I_GFQ][lane + 64 * j])); gk = fmaxf(gk, fabsf(P.in[I_GFK][lane + 64 * j])); }
    gq = wave_max(gq); gk = wave_max(gk);
    const float TH2 = SKIP_THR + 2.f * C2Q * 64.f * gq * gk + 6.f;
    if (sq < NPB * FH) {
        const int b = sq / FH, fh = sq % FH;
        float* NBP = (float*)(ws + WS_MISC + MS_NBP) + (size_t)sq * NBPL;
        float* olf = P.out + OUT_LFP + (size_t)b * LP * FH;
        float carry = 0.f;
        for (int c = 0; c < NCH; ++c) {
            const int p = 64 * c + lane; const size_t row = (size_t)b * RP + p;
            const bool pad = p < PADF;
            const float lf = pad ? 0.f : logsigmoidf_(bf2f(GT[row * 512 + fh]));
            const float Fv = carry + wave_scan_add(lf, lane);
            carry = __shfl(Fv, 63);
            const float nb = pad ? NEGBIG : -Fv * LOG2E;
            NBP[p] = nb;
            if (!pad) olf[(size_t)(p - PADF) * FH + fh] = lf;
            if (lane == 63) wl[c] = nb;
            if ((c & 3) == 0 && lane == (c == 0 ? PADF : 0)) wl[80 + (c >> 2)] = nb;
        }
        for (int p = RP + lane; p < NBPL; p += 64) NBP[p] = NEGBIG;
        LDS_WAIT(); asm volatile("" ::: "memory");
        if (lane < 17) {
            const float t0 = wl[80 + lane]; int J = 0; const int Jmax = 4 * lane;
            while (J < Jmax && wl[J] - t0 < -TH2) ++J;
            JST[sq * 17 + lane] = J;
        }
        LDS_WAIT(); asm volatile("" ::: "memory");
    } else {
        const int s2 = sq - NPB * FH, b = s2 / FH, fh = s2 % FH;
        float* NBS = (float*)(ws + WS_MISC + MS_NBS) + (size_t)s2 * NBSL;
        float* olf = P.out + OUT_LFS + (size_t)b * DEC_T * FH;
        const float* cl = P.in[I_CLF] + (size_t)b * PAST * FH;
        float carry = 0.f;
        for (int c = 0; c < 17; ++c) {
            const int i = 64 * c + lane;
            float lf;
            if (c < 16) lf = cl[(size_t)i * FH + fh];
            else { lf = logsigmoidf_(bf2f(GT[((size_t)SROW0 + b * DEC_T + lane) * 512 + fh])); olf[(size_t)lane * FH + fh] = lf; }
            const float Fv = carry + wave_scan_add(lf, lane);
            carry = __shfl(Fv, 63);
            const float nb = -Fv * LOG2E;
            NBS[i] = nb;
            if (lane == 63) wl[c] = nb;
            if (c == 16 && lane == 0) wl[80] = nb;
        }
        for (int p = PAST + DEC_T + lane; p < NBSL; p += 64) NBS[p] = NEGBIG;
        LDS_WAIT(); asm volatile("" ::: "memory");
        if (lane == 0) { const float t0 = wl[80]; int J = 0; while (J < 16 && wl[J] - t0 < -TH2) ++J; JST[NPB * FH * 17 + s2] = J; }
        LDS_WAIT(); asm volatile("" ::: "memory");
    }
}

constexpr int XS_P = 136, KT_P = 72;
constexpr int L2_XS = 0, L2_KT = L2_XS + 64 * XS_P * 2, L2_VT = L2_KT + 128 * KT_P * 2, L2_WK = L2_VT + 128 * KT_P * 2, L2_END = L2_WK + 256;
struct ChunkId { int b, c, row0; bool samp; };
__device__ __forceinline__ ChunkId chunk_of(int ci) { ChunkId k; k.samp = ci >= NPB * NCH; if (!k.samp) { k.b = ci / NCH; k.c = ci % NCH; k.row0 = k.b * RP + 64 * k.c; } else { k.b = ci - NPB * NCH; k.c = 0; k.row0 = SROW0 + 64 * k.b; } return k; }

__device__ __forceinline__ void p2_item(const FP& P, int item, LAS unsigned char* lds) {
    const int tid = threadIdx.x, lane = tid & 63, wave = __builtin_amdgcn_readfirstlane(tid >> 6);
    unsigned char* ws = P.ws;
    const int ci = item >> 2, mh = item & 3;
    const ChunkId ck = chunk_of(ci);
    bf16_t* Z = (bf16_t*)(ws + WS_Z);
    bf16_t* ZQb = Z + (size_t)ZQ * SE; bf16_t* ZKb = Z + (size_t)ZK * SE; const bf16_t* ZVb = Z + (size_t)ZV * SE;
    const bf16_t* ZMXp = Z + (size_t)ZMX * SE; const bf16_t* ZMV_ = Z + (size_t)ZMV * SE; const bf16_t* GT = Z + (size_t)ZGT * SE;
    bf16_t* XC = (bf16_t*)(ws + WS_A); bf16_t* QM = XC + SE;
    bf16_t* KM = (bf16_t*)P.scr; bf16_t* KVL = KM + SE;
    float* BT = (float*)(ws + WS_MISC + MS_BT); float* IGT = (float*)(ws + WS_MISC + MS_IGT); float* CHS = (float*)(ws + WS_MISC + MS_CHS); float* NL = (float*)(ws + WS_MISC + MS_NL);
    LAS bf16_t* Xs = (LAS bf16_t*)(lds + L2_XS); LAS bf16_t* kTw = (LAS bf16_t*)(lds + L2_KT); LAS bf16_t* vT = (LAS bf16_t*)(lds + L2_VT); LAS float* wk = (LAS float*)(lds + L2_WK);
    const int npad = (!ck.samp && ck.c == 0) ? PADF : 0;
    __syncthreads();
    if (wave == 0) {
        const size_t row = (size_t)ck.row0 + lane; const bool pad = lane < npad;
        const float lf = pad ? 0.f : logsigmoidf_(bf2f(GT[row * 512 + 12 + mh]));
        const float ig = pad ? NEGBIG : bf2f(GT[row * 512 + 8 + mh]);
        const float bt = wave_scan_add(lf, lane);
        const float bL = __shfl(bt, 63);
        const float g = bL - bt + ig;
        const float mloc = wave_max(g);
        wk[lane] = expf(g - mloc);
        BT[row * MH + mh] = bt; IGT[row * MH + mh] = ig;
        if (lane == 0) { CHS[(size_t)item * 2] = bL; CHS[(size_t)item * 2 + 1] = mloc; }
    }
    {
        const int t = tid >> 3, cg = (tid & 7) * 16, col = mh * MD + cg;
        const size_t row = (size_t)ck.row0 + t;
        float acc[16];
#pragma unroll
        for (int j = 0; j < 16; ++j) acc[j] = P.in[I_BCONV][col + j];
#pragma unroll
        for (int i = 0; i < 4; ++i) {
            const int pu = 64 * ck.c + t + i - 3 - (ck.samp ? 0 : PADF);
            float s[16];
            if (pu >= 0) {
                const v4u a = *(const v4u*)(ZMXp + (row + i - 3) * 512 + col), bq = *(const v4u*)(ZMXp + (row + i - 3) * 512 + col + 8);
                s[0] = bflo(a.x); s[1] = bfhi(a.x); s[2] = bflo(a.y); s[3] = bfhi(a.y); s[4] = bflo(a.z); s[5] = bfhi(a.z); s[6] = bflo(a.w); s[7] = bfhi(a.w);
                s[8] = bflo(bq.x); s[9] = bfhi(bq.x); s[10] = bflo(bq.y); s[11] = bfhi(bq.y); s[12] = bflo(bq.z); s[13] = bfhi(bq.z); s[14] = bflo(bq.w); s[15] = bfhi(bq.w);
            } else if (ck.samp) {
                const float* pv = P.in[I_SCV] + ((size_t)ck.b * 3 + (pu + 3)) * MW + col;
#pragma unroll
                for (int j = 0; j < 16; ++j) s[j] = pv[j];
            } else {
#pragma unroll
                for (int j = 0; j < 16; ++j) s[j] = 0.f;
            }
#pragma unroll
            for (int j = 0; j < 16; ++j) acc[j] += P.in[I_WCONV][i * MW + col + j] * s[j];
        }
        const bool padrow = t < npad;
        unsigned w[8];
#pragma unroll
        for (int j = 0; j < 8; ++j) { const float x0 = padrow ? 0.f : siluf_(acc[2 * j]), x1 = padrow ? 0.f : siluf_(acc[2 * j + 1]); w[j] = pk2(x0, x1); }
        const v4u w0 = {w[0], w[1], w[2], w[3]}, w1 = {w[4], w[5], w[6], w[7]};
        *(LAS v4u*)(Xs + t * XS_P + cg) = w0; *(LAS v4u*)(Xs + t * XS_P + cg + 8) = w1;
        *(v4u*)(XC + row * 512 + col) = w0; *(v4u*)(XC + row * 512 + col + 8) = w1;
        const int tl = ck.samp ? t - (DEC_T - 3) : ((ck.c == NCH - 1) ? t - 61 : -1);
        if (tl >= 0) {
            float* oc = P.out + (ck.samp ? OUT_CVS : OUT_CVP) + ((size_t)ck.b * 3 + tl) * MW + col;
            const v4u a = *(const v4u*)(ZMXp + row * 512 + col), bq = *(const v4u*)(ZMXp + row * 512 + col + 8);
            oc[0] = bflo(a.x); oc[1] = bfhi(a.x); oc[2] = bflo(a.y); oc[3] = bfhi(a.y); oc[4] = bflo(a.z); oc[5] = bfhi(a.z); oc[6] = bflo(a.w); oc[7] = bfhi(a.w);
            oc[8] = bflo(bq.x); oc[9] = bfhi(bq.x); oc[10] = bflo(bq.y); oc[11] = bfhi(bq.y); oc[12] = bflo(bq.z); oc[13] = bfhi(bq.z); oc[14] = bflo(bq.w); oc[15] = bfhi(bq.w);
        }
        {
            v4u a = *(const v4u*)(ZMV_ + row * 512 + col), bq = *(const v4u*)(ZMV_ + row * 512 + col + 8);
            if (padrow) { a = (v4u){0u, 0u, 0u, 0u}; bq = a; }
            const unsigned vv[8] = {a.x, a.y, a.z, a.w, bq.x, bq.y, bq.z, bq.w};
#pragma unroll
            for (int j = 0; j < 8; ++j) { vT[(cg + 2 * j) * KT_P + t] = (bf16_t)(vv[j] & 0xffffu); vT[(cg + 2 * j + 1) * KT_P + t] = (bf16_t)(vv[j] >> 16); }
        }
    }
    __syncthreads();
    {
        const int fr = lane & 15, fq = lane >> 4;
        const bf16_t* wq = (const bf16_t*)(ws + WS_WMQ) + (size_t)mh * MD * MD + (size_t)(16 * wave + fr) * MD + 8 * fq;
        const bf16_t* wkk = (const bf16_t*)(ws + WS_WMK) + (size_t)mh * MD * MD + (size_t)(16 * wave + fr) * MD + 8 * fq;
        bf16x8 bq[4], bk[4];
#pragma unroll
        for (int ks = 0; ks < 4; ++ks) { bq[ks] = *(const bf16x8*)(wq + 32 * ks); bk[ks] = *(const bf16x8*)(wkk + 32 * ks); }
        const int e = 16 * wave + fr;
#pragma unroll
        for (int m = 0; m < 4; ++m) {
            f32x4 aq = {0.f, 0.f, 0.f, 0.f}, ak = {0.f, 0.f, 0.f, 0.f};
#pragma unroll
            for (int ks = 0; ks < 4; ++ks) { const bf16x8 a = *(const LAS bf16x8*)(Xs + (16 * m + fr) * XS_P + 32 * ks + 8 * fq); aq = mfma16(a, bq[ks], aq); ak = mfma16(a, bk[ks], ak); }
            const int t0 = 16 * m + 4 * fq;
            const f32x4 wv = *(const LAS f32x4*)(wk + t0);
            ak = ak * 0.08838834764831845f;
#pragma unroll
            for (int r = 0; r < 4; ++r) {
                const size_t row = (size_t)ck.row0 + t0 + r;
                QM[row * 512 + mh * MD + e] = (bf16_t)f2bf(aq[r]);
                KM[row * 512 + mh * MD + e] = (bf16_t)f2bf(ak[r]);
            }
            v2u kw; kw.x = pk2(ak[0] * wv[0], ak[1] * wv[1]); kw.y = pk2(ak[2] * wv[2], ak[3] * wv[3]);
            *(LAS v2u*)(kTw + e * KT_P + t0) = kw;
        }
    }
    __syncthreads();
    {
        const int fr = lane & 15, fq = lane >> 4;
        bf16x8 a[2];
#pragma unroll
        for (int ks = 0; ks < 2; ++ks) a[ks] = *(const LAS bf16x8*)(kTw + (16 * wave + fr) * KT_P + 32 * ks + 8 * fq);
        bf16_t* kvl = KVL + (size_t)item * MD * MD;
#pragma unroll
        for (int n = 0; n < 8; ++n) {
            f32x4 acc = {0.f, 0.f, 0.f, 0.f};
#pragma unroll
            for (int ks = 0; ks < 2; ++ks) { const bf16x8 b = *(const LAS bf16x8*)(vT + (16 * n + fr) * KT_P + 32 * ks + 8 * fq); acc = mfma16(a[ks], b, acc); }
            v2u o; o.x = pk2(acc[0], acc[1]); o.y = pk2(acc[2], acc[3]);
            *(v2u*)(kvl + (size_t)(16 * n + fr) * MD + 16 * wave + 4 * fq) = o;
        }
        if (tid < MD) {
            float s = 0.f;
#pragma unroll
            for (int j = 0; j < 8; ++j) { const v4u x = *(const LAS v4u*)(kTw + tid * KT_P + 8 * j);
                s += (bflo(x.x) + bfhi(x.x)) + (bflo(x.y) + bfhi(x.y)) + (bflo(x.z) + bfhi(x.z)) + (bflo(x.w) + bfhi(x.w)); }
            NL[(size_t)item * MD + tid] = s;
        }
    }
    {
        const int t = tid >> 3, cg = (tid & 7) * 16, col = mh * 128 + cg;
        const size_t row = (size_t)ck.row0 + t;
        if (t >= npad) {
            v4u qa = *(const v4u*)(ZQb + row * 512 + col), qb = *(const v4u*)(ZQb + row * 512 + col + 8);
            v4u ka = *(const v4u*)(ZKb + row * 512 + col), kb = *(const v4u*)(ZKb + row * 512 + col + 8);
            const v4u va = *(const v4u*)(ZVb + row * 512 + col), vb = *(const v4u*)(ZVb + row * 512 + col + 8);
            const unsigned qw[8] = {qa.x, qa.y, qa.z, qa.w, qb.x, qb.y, qb.z, qb.w}, kw[8] = {ka.x, ka.y, ka.z, ka.w, kb.x, kb.y, kb.z, kb.w}, vw[8] = {va.x, va.y, va.z, va.w, vb.x, vb.y, vb.z, vb.w};
            float q[16], k[16]; float sq = 0.f, sk = 0.f;
#pragma unroll
            for (int j = 0; j < 8; ++j) { q[2 * j] = bflo(qw[j]); q[2 * j + 1] = bfhi(qw[j]); k[2 * j] = bflo(kw[j]); k[2 * j + 1] = bfhi(kw[j]); }
#pragma unroll
            for (int j = 0; j < 16; ++j) { sq += q[j] * q[j]; sk += k[j] * k[j]; }
            sq += __shfl_xor(sq, 1); sq += __shfl_xor(sq, 2); sk += __shfl_xor(sk, 1); sk += __shfl_xor(sk, 2);
            const float rq = rsqrtf(sq * (1.f / FD) + EPS) * C2Q, rk = rsqrtf(sk * (1.f / FD) + EPS);
            float* ok; float* ov;
            if (ck.samp) { ok = P.out + OUT_FKS + ((size_t)ck.b * DEC_T + t) * FW + col; ov = P.out + OUT_FVS + ((size_t)ck.b * DEC_T + t) * FW + col; }
            else { const int pos = 64 * ck.c + t - PADF; ok = P.out + OUT_FKP + ((size_t)ck.b * LP + pos) * FW + col; ov = P.out + OUT_FVP + ((size_t)ck.b * LP + pos) * FW + col; }
            unsigned qo[8], ko[8];
#pragma unroll
            for (int j = 0; j < 8; ++j) {
                const float q0 = q[2 * j] * rq * P.in[I_GFQ][col + 2 * j], q1 = q[2 * j + 1] * rq * P.in[I_GFQ][col + 2 * j + 1];
                const float k0 = k[2 * j] * rk * P.in[I_GFK][col + 2 * j], k1 = k[2 * j + 1] * rk * P.in[I_GFK][col + 2 * j + 1];
                qo[j] = pk2(q0, q1); ko[j] = pk2(k0, k1);
                ok[2 * j] = k0; ok[2 * j + 1] = k1; ov[2 * j] = bflo(vw[j]); ov[2 * j + 1] = bfhi(vw[j]);
            }
            const v4u q0v = {qo[0], qo[1], qo[2], qo[3]}, q1v = {qo[4], qo[5], qo[6], qo[7]}, k0v = {ko[0], ko[1], ko[2], ko[3]}, k1v = {ko[4], ko[5], ko[6], ko[7]};
            *(v4u*)(ZQb + row * 512 + col) = q0v; *(v4u*)(ZQb + row * 512 + col + 8) = q1v;
            *(v4u*)(ZKb + row * 512 + col) = k0v; *(v4u*)(ZKb + row * 512 + col + 8) = k1v;
            if (ck.samp) {
                bf16_t* KS = (bf16_t*)(ws + WS_KS) + ((size_t)ck.b * NBSL + PAST + t) * FW + col; bf16_t* VS = (bf16_t*)(ws + WS_VS) + ((size_t)ck.b * NBSL + PAST + t) * FW + col;
                *(v4u*)KS = k0v; *(v4u*)(KS + 8) = k1v; *(v4u*)VS = va; *(v4u*)(VS + 8) = vb;
            }
        }
    }
}
}
namespace fk {
__device__ __forceinline__ void p3_scan(const FP& P) {
    unsigned char* ws = P.ws;
    bf16_t* KVL = (bf16_t*)P.scr + SE;
    float* NL = (float*)(ws + WS_MISC + MS_NL); const float* CHS = (const float*)(ws + WS_MISC + MS_CHS);
    float* MC = (float*)(ws + WS_MISC + MS_MC);
    constexpr int EPS_ = MD * MD / 4 + MD;
    constexpr int NSEQ = (NPB + NB) * MH;
    const int gt = blockIdx.x * 512 + threadIdx.x, NT = gridDim.x * 512;
    for (int e = gt; e < NSEQ * EPS_; e += NT) {
        const int sidx = e / EPS_, w = e % EPS_;
        const bool samp = sidx >= NPB * MH; const int b = samp ? (sidx - NPB * MH) / MH : sidx / MH, h = sidx % MH;
        const int nch = samp ? 1 : NCH;
        const int item0 = samp ? ((NPB * NCH + b) * MH + h) : ((b * NCH) * MH + h);
        float m = samp ? P.in[I_SM][b * MH + h] : 0.f;
        if (w < MD * MD / 4) {
            const int dv = w >> 5, dk = (w & 31) * 4;
            float c0 = 0.f, c1 = 0.f, c2 = 0.f, c3 = 0.f;
            if (samp) { const float* C0 = P.in[I_SC] + ((size_t)b * MH + h) * MD * MD; c0 = C0[(size_t)dk * MD + dv]; c1 = C0[(size_t)(dk + 1) * MD + dv]; c2 = C0[(size_t)(dk + 2) * MD + dv]; c3 = C0[(size_t)(dk + 3) * MD + dv]; }
            for (int cb = 0; cb < nch; cb += 13) {
                v2u kv[13];
#pragma unroll
                for (int j = 0; j < 13; ++j) if (cb + j < nch) kv[j] = *(const v2u*)(KVL + (size_t)(item0 + 4 * (cb + j)) * MD * MD + (size_t)dv * MD + dk);
#pragma unroll
                for (int j = 0; j < 13; ++j) if (cb + j < nch) {
                    const int it = item0 + 4 * (cb + j);
                    const float bL = CHS[(size_t)it * 2], ml = CHS[(size_t)it * 2 + 1];
                    const float mn = fmaxf(bL + m, ml), a = expf(bL + m - mn), s = expf(ml - mn);
                    v2u o; o.x = pk2(c0, c1); o.y = pk2(c2, c3);
                    *(v2u*)(KVL + (size_t)it * MD * MD + (size_t)dv * MD + dk) = o;
                    if (w == 0) MC[it] = m;
                    c0 = a * c0 + s * bflo(kv[j].x); c1 = a * c1 + s * bfhi(kv[j].x); c2 = a * c2 + s * bflo(kv[j].y); c3 = a * c3 + s * bfhi(kv[j].y);
                    m = mn;
                }
            }
            float* oC = P.out + (samp ? OUT_CS : OUT_CP) + ((size_t)b * MH + h) * MD * MD;
            oC[(size_t)dk * MD + dv] = c0; oC[(size_t)(dk + 1) * MD + dv] = c1; oC[(size_t)(dk + 2) * MD + dv] = c2; oC[(size_t)(dk + 3) * MD + dv] = c3;
            if (w == 0) P.out[(samp ? OUT_MS : OUT_MP) + (size_t)b * MH + h] = m;
        } else {
            const int dk = w - MD * MD / 4;
            float n = samp ? P.in[I_SN][((size_t)b * MH + h) * MD + dk] : 0.f;
            for (int c = 0; c < nch; ++c) {
                const int it = item0 + 4 * c;
                const float bL = CHS[(size_t)it * 2], ml = CHS[(size_t)it * 2 + 1];
                const float mn = fmaxf(bL + m, ml), a = expf(bL + m - mn), s = expf(ml - mn);
                const float nl = NL[(size_t)it * MD + dk];
                NL[(size_t)it * MD + dk] = n;
                n = a * n + s * nl; m = mn;
            }
            P.out[(samp ? OUT_NS : OUT_NP) + ((size_t)b * MH + h) * MD + dk] = n;
        }
    }
}

constexpr int L3_K = 0, L3_V = 16384, L3_WS = 32768, L3_END = L3_WS + 8 * 64 * 4;
__device__ __forceinline__ int crow(int r, int hi) { return (r & 3) + 8 * (r >> 2) + 4 * hi; }
typedef short v4i16_t __attribute__((ext_vector_type(4)));
__device__ __forceinline__ s16x4 vtr(const LAS unsigned char* p) { return __builtin_bit_cast(s16x4, __builtin_amdgcn_ds_read_tr16_b64_v4i16((LAS v4i16_t*)p)); }
__device__ __forceinline__ unsigned cvtpk(float lo, float hi) { typedef float f2 __attribute__((ext_vector_type(2))); typedef __bf16 b2 __attribute__((ext_vector_type(2))); f2 v = {lo, hi}; b2 b = __builtin_convertvector(v, b2); return __builtin_bit_cast(unsigned, b); }

__device__ __forceinline__ void attn_unit(const FP& P, int unit, LAS unsigned char* lds) {
    const int tid = threadIdx.x, lane = tid & 63, r32 = lane & 31, hi = lane >> 5, wave = __builtin_amdgcn_readfirstlane(tid >> 6);
    unsigned char* ws = P.ws;
    bf16_t* Z = (bf16_t*)(ws + WS_Z);
    const int* JST = (const int*)(ws + WS_MISC + MS_JST);
    const bf16_t *Kb, *Vb; const float* nb; bf16_t* Qb; int J0, J1, jdiag, nvalid, qpos0;
    if (unit < NPB * FH * 17) {
        const int sq = unit / 17, j = unit % 17, b = sq / FH, fh = sq % FH;
        Kb = Z + (size_t)ZK * SE + (size_t)b * RP * 512 + fh * FD; Vb = Z + (size_t)ZV * SE + (size_t)b * RP * 512 + fh * FD;
        Qb = Z + (size_t)ZQ * SE + ((size_t)b * RP + 256 * j) * 512 + fh * FD;
        nb = (const float*)(ws + WS_MISC + MS_NBP) + (size_t)sq * NBPL;
        J0 = JST[sq * 17 + j]; jdiag = 4 * j; J1 = (j == 16) ? 65 : 4 * j + 4; nvalid = (j == 16) ? 64 : 256; qpos0 = 256 * j;
    } else {
        const int s2 = unit - NPB * FH * 17, b = s2 / FH, fh = s2 % FH;
        Kb = (const bf16_t*)(ws + WS_KS) + (size_t)b * NBSL * 512 + fh * FD; Vb = (const bf16_t*)(ws + WS_VS) + (size_t)b * NBSL * 512 + fh * FD;
        Qb = Z + (size_t)ZQ * SE + ((size_t)SROW0 + b * DEC_T) * 512 + fh * FD;
        nb = (const float*)(ws + WS_MISC + MS_NBS) + (size_t)s2 * NBSL;
        J0 = JST[NPB * FH * 17 + s2]; jdiag = 16; J1 = 17; nvalid = 64; qpos0 = PAST;
    }
    const bool active = wave * 32 < nvalid;
    LAS float* wsf = (LAS float*)(lds + L3_WS) + wave * 64;
    const int skey = tid >> 3, sch = tid & 7;
    const unsigned kdst = L3_K + sch * 1024 + skey * 16, vdst = L3_V + (sch >> 2) * 4096 + skey * 64 + (sch & 3) * 16;
    const bf16_t* ksrc = Kb + (size_t)skey * 512 + sch * 8; const bf16_t* vsrc = Vb + (size_t)skey * 512 + sch * 8;
    bf16x8 qr[4];
#pragma unroll
    for (int d0 = 0; d0 < 4; ++d0) qr[d0] = *(const bf16x8*)(Qb + (size_t)(wave * 32 + r32) * 512 + d0 * 16 + hi * 8);
    float m = -INFINITY, l = 0.f; f32x16 o[2]; o[0] = f32x16{}; o[1] = f32x16{};
    const int qpos = qpos0 + wave * 32 + r32;
    __syncthreads();
    v4u kreg = *(const v4u*)(ksrc + (size_t)J0 * 64 * 512), vreg = *(const v4u*)(vsrc + (size_t)J0 * 64 * 512);
    *(LAS v4u*)(lds + kdst) = kreg; *(LAS v4u*)(lds + vdst) = vreg;
    __syncthreads();
    for (int J = J0; J < J1; ++J) {
        const int slot = (J - J0) & 1;
        if (J + 1 < J1) { kreg = *(const v4u*)(ksrc + (size_t)(J + 1) * 64 * 512); vreg = *(const v4u*)(vsrc + (size_t)(J + 1) * 64 * 512); }
        if (active && 64 * J <= qpos0 + wave * 32 + 31) {
            const LAS unsigned char* Ks = lds + L3_K + slot * 8192; const LAS unsigned char* Vs = lds + L3_V + slot * 8192;
            f32x16 p0 = f32x16{}, p1 = f32x16{};
#pragma unroll
            for (int d0 = 0; d0 < 4; ++d0) {
                const bf16x8 b0 = *(const LAS bf16x8*)(Ks + (2 * d0 + hi) * 1024 + r32 * 16);
                const bf16x8 b1 = *(const LAS bf16x8*)(Ks + (2 * d0 + hi) * 1024 + (32 + r32) * 16);
                p0 = __builtin_amdgcn_mfma_f32_32x32x16_bf16(b0, qr[d0], p0, 0, 0, 0);
                p1 = __builtin_amdgcn_mfma_f32_32x32x16_bf16(b1, qr[d0], p1, 0, 0, 0);
            }
            const float* nbt = nb + 64 * J + 4 * hi;
#pragma unroll
            for (int g = 0; g < 4; ++g) {
                const f32x4 x0 = *(const f32x4*)(nbt + 8 * g), x1 = *(const f32x4*)(nbt + 32 + 8 * g);
#pragma unroll
                for (int i = 0; i < 4; ++i) { p0[4 * g + i] += x0[i]; p1[4 * g + i] += x1[i]; }
            }
            if (J >= jdiag) {
#pragma unroll
                for (int r = 0; r < 16; ++r) { const int kv = 64 * J + crow(r, hi); if (kv > qpos) p0[r] = -INFINITY; if (kv + 32 > qpos) p1[r] = -INFINITY; }
            }
            float mt = p0[0];
#pragma unroll
            for (int r = 1; r < 16; ++r) mt = fmaxf(mt, p0[r]);
#pragma unroll
            for (int r = 0; r < 16; ++r) mt = fmaxf(mt, p1[r]);
            mt = fmaxf(mt, __shfl_xor(mt, 32));
            const float mn = fmaxf(m, mt);
            const float alpha = __builtin_amdgcn_exp2f(m - mn);
            float ps = 0.f;
#pragma unroll
            for (int r = 0; r < 16; ++r) { p0[r] = __builtin_amdgcn_exp2f(p0[r] - mn); p1[r] = __builtin_amdgcn_exp2f(p1[r] - mn); ps += p0[r] + p1[r]; }
            l = l * alpha + ps; m = mn;
            if (hi == 0) wsf[r32] = alpha;
            LDS_WAIT(); asm volatile("" ::: "memory");
#pragma unroll
            for (int g = 0; g < 4; ++g) { const f32x4 al = *(const LAS f32x4*)(wsf + 8 * g + 4 * hi);
#pragma unroll
                for (int i = 0; i < 4; ++i) { o[0][4 * g + i] *= al[i]; o[1][4 * g + i] *= al[i]; } }
            v4u pw[4];
#pragma unroll
            for (int i = 0; i < 4; ++i) { pw[0][i] = cvtpk(p0[2 * i], p0[2 * i + 1]); pw[1][i] = cvtpk(p0[8 + 2 * i], p0[8 + 2 * i + 1]); pw[2][i] = cvtpk(p1[2 * i], p1[2 * i + 1]); pw[3][i] = cvtpk(p1[8 + 2 * i], p1[8 + 2 * i + 1]); }
            const LAS unsigned char* vb = Vs + ((lane >> 4) & 1) * 32 + (lane & 3) * 8 + (4 * hi + ((lane & 15) >> 2)) * 64;
#pragma unroll
            for (int db = 0; db < 2; ++db)
#pragma unroll
                for (int ks = 0; ks < 4; ++ks) {
                    const s16x4 lo = vtr(vb + db * 4096 + ks * 1024), hh = vtr(vb + db * 4096 + ks * 1024 + 512);
                    const bf16x8 vf = {lo[0], lo[1], lo[2], lo[3], hh[0], hh[1], hh[2], hh[3]};
                    o[db] = __builtin_amdgcn_mfma_f32_32x32x16_bf16(__builtin_bit_cast(bf16x8, pw[ks]), vf, o[db], 0, 0, 0);
                }
        }
        if (J + 1 < J1) { *(LAS v4u*)(lds + kdst + (slot ^ 1) * 8192) = kreg; *(LAS v4u*)(lds + vdst + (slot ^ 1) * 8192) = vreg; }
        __syncthreads();
    }
    if (active) {
        l += __shfl_xor(l, 32);
        if (hi == 0) wsf[r32] = 1.f / l;
        LDS_WAIT(); asm volatile("" ::: "memory");
#pragma unroll
        for (int g = 0; g < 4; ++g) { const f32x4 il = *(const LAS f32x4*)(wsf + 8 * g + 4 * hi);
#pragma unroll
            for (int i = 0; i < 4; ++i) {
                const int r = 4 * g + i; bf16_t* orow = Qb + (size_t)(wave * 32 + crow(r, hi)) * 512;
                orow[r32] = (bf16_t)f2bf(o[0][r] * il[i]); orow[32 + r32] = (bf16_t)f2bf(o[1][r] * il[i]);
            } }
    }
}
}
namespace fk {
constexpr int L4_QS = 0, L4_KS = L4_QS + 64 * XS_P * 2, L4_VT = L4_KS + 64 * XS_P * 2, L4_CT = L4_VT + 128 * KT_P * 2, L4_AS = L4_CT + 128 * XS_P * 2, L4_F = L4_AS + 64 * KT_P * 2, L4_END = L4_F + 10 * 64 * 4;
__device__ __forceinline__ void p4_item(const FP& P, int item, LAS unsigned char* lds) {
    const int tid = threadIdx.x, lane = tid & 63, wave = __builtin_amdgcn_readfirstlane(tid >> 6), fr = lane & 15, fq = lane >> 4;
    unsigned char* ws = P.ws;
    const int ci = item >> 2, mh = item & 3;
    const ChunkId ck = chunk_of(ci);
    bf16_t* Z = (bf16_t*)(ws + WS_Z);
    const bf16_t* ZMV_ = Z + (size_t)ZMV * SE; const bf16_t* ZMO_ = Z + (size_t)ZMO * SE; bf16_t* HM = Z + (size_t)ZMX * SE;
    const bf16_t* XC = (const bf16_t*)(ws + WS_A); const bf16_t* QM = XC + SE;
    const bf16_t* KM = (const bf16_t*)P.scr; const bf16_t* KVL = KM + SE;
    const float* BT = (const float*)(ws + WS_MISC + MS_BT); const float* IGT = (const float*)(ws + WS_MISC + MS_IGT); const float* NL = (const float*)(ws + WS_MISC + MS_NL); const float* MC = (const float*)(ws + WS_MISC + MS_MC);
    LAS bf16_t* Qs = (LAS bf16_t*)(lds + L4_QS); LAS bf16_t* Ks = (LAS bf16_t*)(lds + L4_KS); LAS bf16_t* vT = (LAS bf16_t*)(lds + L4_VT); LAS bf16_t* CT = (LAS bf16_t*)(lds + L4_CT); LAS bf16_t* As = (LAS bf16_t*)(lds + L4_AS);
    LAS float* U = (LAS float*)(lds + L4_F); LAS float* Vv = U + 64; LAS float* WI = U + 128; LAS float* EM = U + 192; LAS float* DD = U + 256; LAS float* NC = U + 320;   LAS float* SS = U + 448;
    const int npad = (!ck.samp && ck.c == 0) ? PADF : 0;
    __syncthreads();
    {
        const int t = tid >> 3, cg = (tid & 7) * 16, col = mh * MD + cg; const size_t row = (size_t)ck.row0 + t;
        *(LAS v4u*)(Qs + t * XS_P + cg) = *(const v4u*)(QM + row * 512 + col); *(LAS v4u*)(Qs + t * XS_P + cg + 8) = *(const v4u*)(QM + row * 512 + col + 8);
        *(LAS v4u*)(Ks + t * XS_P + cg) = *(const v4u*)(KM + row * 512 + col); *(LAS v4u*)(Ks + t * XS_P + cg + 8) = *(const v4u*)(KM + row * 512 + col + 8);
        v4u a = *(const v4u*)(ZMV_ + row * 512 + col), bq = *(const v4u*)(ZMV_ + row * 512 + col + 8);
        if (t < npad) { a = (v4u){0u, 0u, 0u, 0u}; bq = a; }
        const unsigned vv[8] = {a.x, a.y, a.z, a.w, bq.x, bq.y, bq.z, bq.w};
#pragma unroll
        for (int j = 0; j < 8; ++j) { vT[(cg + 2 * j) * KT_P + t] = (bf16_t)(vv[j] & 0xffffu); vT[(cg + 2 * j + 1) * KT_P + t] = (bf16_t)(vv[j] >> 16); }
        const int dv = tid >> 2, qq = (tid & 3) * 32; const bf16_t* src = KVL + (size_t)item * MD * MD + (size_t)dv * MD + qq;
#pragma unroll
        for (int j = 0; j < 4; ++j) *(LAS v4u*)(CT + dv * XS_P + qq + 8 * j) = *(const v4u*)(src + 8 * j);
        if (tid < MD) NC[tid] = NL[(size_t)item * MD + tid];
    }
    if (wave == 0) {
        const size_t row = (size_t)ck.row0 + lane;
        const float bt = BT[row * MH + mh], ig = IGT[row * MH + mh], mc = MC[item];
        const float vs = ig - bt;
        const float cm = wave_scan_max(vs, lane);
        const float mt = bt + fmaxf(mc, cm);
        U[lane] = bt - mt; Vv[lane] = vs; WI[lane] = expf(bt + mc - mt); EM[lane] = expf(-mt);
    }
    __syncthreads();
    {
        const int s0 = 16 * (wave & 3), tb = 32 * (wave >> 2);
        f32x4 acc[2] = {{0.f, 0.f, 0.f, 0.f}, {0.f, 0.f, 0.f, 0.f}};
#pragma unroll
        for (int ks = 0; ks < 4; ++ks) {
            const bf16x8 a = *(const LAS bf16x8*)(Ks + (s0 + fr) * XS_P + 32 * ks + 8 * fq);
#pragma unroll
            for (int n = 0; n < 2; ++n) { const bf16x8 b = *(const LAS bf16x8*)(Qs + (tb + 16 * n + fr) * XS_P + 32 * ks + 8 * fq); acc[n] = mfma16(a, b, acc[n]); }
        }
        const int sb = s0 + 4 * fq; const f32x4 vsv = *(const LAS f32x4*)(Vv + sb);
#pragma unroll
        for (int n = 0; n < 2; ++n) {
            const int t = tb + 16 * n + fr; const float ut = U[t];
            float w[4];
#pragma unroll
            for (int r = 0; r < 4; ++r) w[r] = (sb + r <= t) ? expf(ut + vsv[r]) * acc[n][r] : 0.f;
            v2u o; o.x = pk2(w[0], w[1]); o.y = pk2(w[2], w[3]);
            *(LAS v2u*)(As + t * KT_P + sb) = o;
        }
    }
    __syncthreads();
    {
        const int t = tid >> 3, cg = (tid & 7) * 16; const float wi = WI[t];
#pragma unroll
        for (int hh = 0; hh < 2; ++hh) { v4u x = *(LAS v4u*)(Qs + t * XS_P + cg + 8 * hh);
            x.x = pk2(bflo(x.x) * wi, bfhi(x.x) * wi); x.y = pk2(bflo(x.y) * wi, bfhi(x.y) * wi); x.z = pk2(bflo(x.z) * wi, bfhi(x.z) * wi); x.w = pk2(bflo(x.w) * wi, bfhi(x.w) * wi);
            *(LAS v4u*)(Qs + t * XS_P + cg + 8 * hh) = x; }
    }
    __syncthreads();
    if (wave == 0) {
        float d = 0.f;
#pragma unroll
        for (int j = 0; j < 8; ++j) { const v4u x = *(const LAS v4u*)(As + lane * KT_P + 8 * j); d += (bflo(x.x) + bfhi(x.x)) + (bflo(x.y) + bfhi(x.y)) + (bflo(x.z) + bfhi(x.z)) + (bflo(x.w) + bfhi(x.w)); }
#pragma unroll
        for (int j = 0; j < 16; ++j) { const v4u x = *(const LAS v4u*)(Qs + lane * XS_P + 8 * j); const f32x4 n0 = *(const LAS f32x4*)(NC + 8 * j), n1 = *(const LAS f32x4*)(NC + 8 * j + 4);
            d += bflo(x.x) * n0[0] + bfhi(x.x) * n0[1] + bflo(x.y) * n0[2] + bfhi(x.y) * n0[3] + bflo(x.z) * n1[0] + bfhi(x.z) * n1[1] + bflo(x.w) * n1[2] + bfhi(x.w) * n1[3]; }
        DD[lane] = 1.f / fmaxf(fabsf(d), EM[lane]);
    }
    const int t0 = 16 * (wave & 3), dvb = 64 * (wave >> 2);
    f32x4 acc[4] = {{0.f, 0.f, 0.f, 0.f}, {0.f, 0.f, 0.f, 0.f}, {0.f, 0.f, 0.f, 0.f}, {0.f, 0.f, 0.f, 0.f}};
#pragma unroll
    for (int ks = 0; ks < 2; ++ks) {
        const bf16x8 a = *(const LAS bf16x8*)(As + (t0 + fr) * KT_P + 32 * ks + 8 * fq);
#pragma unroll
        for (int n = 0; n < 4; ++n) { const bf16x8 b = *(const LAS bf16x8*)(vT + (dvb + 16 * n + fr) * KT_P + 32 * ks + 8 * fq); acc[n] = mfma16(a, b, acc[n]); }
    }
#pragma unroll
    for (int ks = 0; ks < 4; ++ks) {
        const bf16x8 a = *(const LAS bf16x8*)(Qs + (t0 + fr) * XS_P + 32 * ks + 8 * fq);
#pragma unroll
        for (int n = 0; n < 4; ++n) { const bf16x8 b = *(const LAS bf16x8*)(CT + (dvb + 16 * n + fr) * XS_P + 32 * ks + 8 * fq); acc[n] = mfma16(a, b, acc[n]); }
    }
    __syncthreads();
    float hv[4][4]; float ssq[4] = {0.f, 0.f, 0.f, 0.f};
    const f32x4 ddv = *(const LAS f32x4*)(DD + t0 + 4 * fq);
#pragma unroll
    for (int n = 0; n < 4; ++n)
#pragma unroll
        for (int r = 0; r < 4; ++r) {
            const size_t row = (size_t)ck.row0 + t0 + 4 * fq + r; const int col = mh * MD + dvb + 16 * n + fr;
            const float og = sigmoidf_(bf2f(ZMO_[row * 512 + col]));
            hv[n][r] = og * acc[n][r] * ddv[r]; ssq[r] += hv[n][r] * hv[n][r];
        }
#pragma unroll
    for (int r = 0; r < 4; ++r) { float s = ssq[r]; s += __shfl_xor(s, 1); s += __shfl_xor(s, 2); s += __shfl_xor(s, 4); s += __shfl_xor(s, 8); ssq[r] = s; }
    if (fr == 0) {
#pragma unroll
        for (int r = 0; r < 4; ++r) SS[(wave >> 2) * 64 + t0 + 4 * fq + r] = ssq[r];
    }
    __syncthreads();
#pragma unroll
    for (int r = 0; r < 4; ++r) {
        const int t = t0 + 4 * fq + r; const float rn = rsqrtf((SS[t] + SS[64 + t]) * (1.f / MD) + EPS);
        const size_t row = (size_t)ck.row0 + t;
#pragma unroll
        for (int n = 0; n < 4; ++n) { const int col = mh * MD + dvb + 16 * n + fr;
            const float v = hv[n][r] * rn * P.in[I_GMN][col] + P.in[I_SKIP][col] * bf2f(XC[row * 512 + col]);
            HM[row * 512 + col] = (bf16_t)f2bf(v); }
    }
}
}
namespace pg8 {
__device__ __forceinline__ float fsigmoid(float x) { return __builtin_amdgcn_rcpf(1.f + __builtin_amdgcn_exp2f(-1.4426950408889634f * x)); }
__device__ __forceinline__ float bflo_(unsigned w) { return __builtin_bit_cast(float, w << 16); }
__device__ __forceinline__ float bfhi_(unsigned w) { return __builtin_bit_cast(float, w & 0xffff0000u); }
template <int MODE> struct EpiGate {
    static constexpr bool PERM = true, AFTER_DRAIN = false;
    bf16_t* MG; const bf16_t* G; size_t gstride;
    __device__ __forceinline__ void operator()(const f32x4 (&acc)[2][2][4][2], const Unit& u, int wr, int wc, int fr, int fq) const {
        const int row0 = u.pm * BM + wr * 64 + fr, col0 = u.pn * BM + wc * 32 + 8 * fq;
#pragma unroll
        for (int ai = 0; ai < 2; ++ai)
#pragma unroll
            for (int m = 0; m < 4; ++m) { const size_t row = (size_t)(row0 + ai * HALF + m * 16);
#pragma unroll
                for (int bj = 0; bj < 2; ++bj) { const int c = col0 + bj * HALF;
                    const u32x4 g = *(const u32x4*)(G + (size_t)(c >> 9) * gstride + row * 512 + (c & 511));
                    f32x4 v0 = acc[ai][bj][m][0], v1 = acc[ai][bj][m][1];
                    v0[0] *= fsigmoid(bflo_(g.x)); v0[1] *= fsigmoid(bfhi_(g.x)); v0[2] *= fsigmoid(bflo_(g.y)); v0[3] *= fsigmoid(bfhi_(g.y));
                    v1[0] *= fsigmoid(bflo_(g.z)); v1[1] *= fsigmoid(bfhi_(g.z)); v1[2] *= fsigmoid(bflo_(g.w)); v1[3] *= fsigmoid(bfhi_(g.w));
                    bf16_t* dst = MG + row * 1024 + c;
                    if (MODE == 1) { const u32x4 o = *(const u32x4*)dst;
                        v0[0] += bflo_(o.x); v0[1] += bfhi_(o.x); v0[2] += bflo_(o.y); v0[3] += bfhi_(o.y); v1[0] += bflo_(o.z); v1[1] += bfhi_(o.z); v1[2] += bflo_(o.w); v1[3] += bfhi_(o.w); }
                    u32x4 w; w.x = cvt_pk_bf16(v0[0], v0[1]); w.y = cvt_pk_bf16(v0[2], v0[3]); w.z = cvt_pk_bf16(v1[0], v1[1]); w.w = cvt_pk_bf16(v1[2], v1[3]);
                    *(u32x4*)dst = w; } }
    }
};
struct EpiSwiGLU {
    static constexpr bool PERM = true, AFTER_DRAIN = false;
    bf16_t* ACT; int ldc;
    __device__ __forceinline__ void operator()(const f32x4 (&acc)[2][2][4][2], const Unit& u, int wr, int wc, int fr, int fq) const {
        const int row0 = u.pm * BM + wr * 64 + fr, col0 = u.pn * HALF + wc * 32 + 8 * fq;
#pragma unroll
        for (int ai = 0; ai < 2; ++ai)
#pragma unroll
            for (int m = 0; m < 4; ++m) { const size_t row = (size_t)(row0 + ai * HALF + m * 16);
                f32x4 v[2];
#pragma unroll
                for (int n = 0; n < 2; ++n) { const f32x4 g = acc[ai][0][m][n], uu = acc[ai][1][m][n];
#pragma unroll
                    for (int i = 0; i < 4; ++i) v[n][i] = g[i] * fsigmoid(g[i]) * uu[i]; }
                u32x4 w; w.x = cvt_pk_bf16(v[0][0], v[0][1]); w.y = cvt_pk_bf16(v[0][2], v[0][3]); w.z = cvt_pk_bf16(v[1][0], v[1][1]); w.w = cvt_pk_bf16(v[1][2], v[1][3]);
                *(u32x4*)(ACT + row * ldc + col0) = w; }
    }
};
}

namespace fk {
#define XB_TMO      128
#define XB_XCNT(j)  (256  + 64 * (j))
#define XB_XSUB(j)  (1280 + 64 * (j))
#define XB_XGEN(j)  (2304 + 64 * (j))
#define XB_TOP      3328
#define XB_TOPGEN   3392
#define XCD_BAR_WORDS 3456
#define XB_SPIN_CAP (1u << 18)

__device__ __forceinline__ unsigned xb_ld(unsigned* p)              { return __hip_atomic_load(p, __ATOMIC_RELAXED, __HIP_MEMORY_SCOPE_AGENT); }
__device__ __forceinline__ unsigned xb_add(unsigned* p, unsigned v) { return __hip_atomic_fetch_add(p, v, __ATOMIC_RELAXED, __HIP_MEMORY_SCOPE_AGENT); }
__device__ __forceinline__ unsigned xb_xcc_id() { return (unsigned)__builtin_amdgcn_s_getreg((3 << 11) | 20) & 0xFu; }
#define XB_SPIN(cond, bar) do { unsigned _sp = 0; while (cond) { __builtin_amdgcn_s_sleep(1); \
    if ((++_sp & 255u) == 0u) { if (xb_ld(&(bar)[XB_TMO])) break; if (_sp > XB_SPIN_CAP) { atomicAdd(&(bar)[XB_TMO], 1u); break; } } } } while (0)

struct XcdBarrier {
    unsigned* bar; unsigned x;
    volatile LAS unsigned* st;
};

__device__ __forceinline__ XcdBarrier xcd_barrier_post(unsigned* bar, volatile LAS unsigned* st) {
    XcdBarrier b; b.bar = bar; b.x = xb_xcc_id(); b.st = st;
    if (threadIdx.x == 0) (void)xb_add(&bar[XB_XCNT(b.x)], 1u);
    return b;
}
__device__ __forceinline__ void xcd_barrier_complete(unsigned* bar, unsigned x, unsigned& nloc, unsigned& nx) {
    const unsigned G = gridDim.x * gridDim.y * gridDim.z;
    unsigned sum, cnt, mine, sp = 0u;
    for (;;) {
        sum = 0u; cnt = 0u; mine = 0u;
#pragma unroll
        for (unsigned j = 0; j < 16; ++j) { const unsigned c = xb_ld(&bar[XB_XCNT(j)]); sum += c; cnt += (c > 0u) ? 1u : 0u; mine = (j == x) ? c : mine; }
        if (sum == G) break;
        __builtin_amdgcn_s_sleep(1);
        if ((++sp & 255u) == 0u) { if (xb_ld(&bar[XB_TMO])) break; if (sp > XB_SPIN_CAP) { atomicAdd(&bar[XB_TMO], 1u); break; } }
    }
    nloc = mine > 0u ? mine : 1u; nx = cnt > 0u ? cnt : 1u;
}

__device__ __forceinline__ void xcd_barrier(const XcdBarrier& b) {
    asm volatile("s_waitcnt vmcnt(0)" ::: "memory");
    __syncthreads();
    if (threadIdx.x == 0) {
        unsigned* bar = b.bar;
        __builtin_amdgcn_s_waitcnt(0);
        unsigned nloc = b.st[0], nx = b.st[1];
        if (nloc == 0u) { xcd_barrier_complete(bar, b.x, nloc, nx); b.st[0] = nloc; b.st[1] = nx; }
        const unsigned old = xb_add(&bar[XB_XSUB(b.x)], 1u);
        const unsigned gen = old / nloc;
        if (old + 1u == (gen + 1u) * nloc) {
            __builtin_amdgcn_fence(__ATOMIC_RELEASE, "agent");
            asm volatile("s_waitcnt vmcnt(0)" ::: "memory");
            const unsigned og = xb_add(&bar[XB_TOP], 1u);
            const unsigned tg = og / nx;
            if (og + 1u == (tg + 1u) * nx) xb_add(&bar[XB_TOPGEN], 1u);
            else XB_SPIN(xb_ld(&bar[XB_TOPGEN]) == tg, bar);
            __builtin_amdgcn_fence(__ATOMIC_ACQUIRE, "agent");
            xb_add(&bar[XB_XGEN(b.x)], 1u);
            asm volatile("s_waitcnt vmcnt(0)" ::: "memory");
        } else {
            XB_SPIN(xb_ld(&bar[XB_XGEN(b.x)]) == gen, bar);
            __builtin_amdgcn_fence(__ATOMIC_ACQUIRE, "agent");
            asm volatile("s_waitcnt vmcnt(0)" ::: "memory");
        }
    }
    __syncthreads();
}

__device__ __forceinline__ float* yrow(const FP& P, int r, int which  ) {
    if (r >= MREAL) return nullptr;
#if FAST_NPB == 8
    if (r < SROW0) { const int b = r / RP, p = r % RP; if (p < PADF + NMETA) return nullptr; return P.out + OUT_YP + ((size_t)b * SEQ + (p - PADF - NMETA)) * D; }
    return P.out + OUT_YS + (size_t)(r - SROW0) * D;
#else
    if (r < SROW0) { const int p = r % RP; if (p < PADF + NMETA) return nullptr; }
    return (float*)(P.scr + 3 * SB + 4096) + ((size_t)which * M + r) * D;
#endif
}
__device__ __forceinline__ void p7_mid(const FP& P) {
    const int lane = threadIdx.x & 63, gw = blockIdx.x * 8 + (threadIdx.x >> 6), NGW = gridDim.x * 8;
    const bf16_t* OB = (const bf16_t*)(P.ws + WS_Z) + (size_t)ZMX * SE; bf16_t* A = (bf16_t*)(P.ws + WS_A);
    for (int r = gw; r < MREAL; r += NGW) {
        float* x1 = yrow(P, r, 0); if (!x1) continue;
        const float* x = fast_xrow(P, r);
        f32x4 v[4]; float s = 0.f;
#pragma unroll
        for (int j = 0; j < 4; ++j) { const v2u w = *(const v2u*)(OB + (size_t)r * D + 4 * lane + 256 * j); v[j] = (f32x4){bflo(w.x), bfhi(w.x), bflo(w.y), bfhi(w.y)};
            s += (v[j].x * v[j].x + v[j].y * v[j].y) + (v[j].z * v[j].z + v[j].w * v[j].w); }
        const float r1 = rsqrtf(wave_sum(s) * (1.f / D) + EPS);
        float s2 = 0.f;
#pragma unroll
        for (int j = 0; j < 4; ++j) { const f32x4 xv = *((const f32x4*)x + lane + 64 * j), g = *((const f32x4*)P.in[I_GPOST] + lane + 64 * j);
            v[j] = xv + v[j] * r1 * g; s2 += (v[j].x * v[j].x + v[j].y * v[j].y) + (v[j].z * v[j].z + v[j].w * v[j].w);
            *((f32x4*)x1 + lane + 64 * j) = v[j]; }
        const float r2 = rsqrtf(wave_sum(s2) * (1.f / D) + EPS);
#pragma unroll
        for (int j = 0; j < 4; ++j) { const f32x4 g = *((const f32x4*)P.in[I_GPREF] + lane + 64 * j); const f32x4 w = v[j] * r2 * g;
            v2u o; o.x = pk2(w.x, w.y); o.y = pk2(w.z, w.w); *(v2u*)(A + (size_t)r * D + 4 * lane + 256 * j) = o; }
    }
}
__device__ __forceinline__ void p10_final(const FP& P) {
    const int lane = threadIdx.x & 63, gw = blockIdx.x * 8 + (threadIdx.x >> 6), NGW = gridDim.x * 8;
    const bf16_t* FO = (const bf16_t*)(P.ws + WS_Z) + (size_t)ZMX * SE;
    for (int r = gw; r < MREAL; r += NGW) {
        const float* x1 = yrow(P, r, 0); if (!x1) continue; float* y = yrow(P, r, 1);
        f32x4 v[4]; float s = 0.f;
#pragma unroll
        for (int j = 0; j < 4; ++j) { const v2u w = *(const v2u*)(FO + (size_t)r * D + 4 * lane + 256 * j); v[j] = (f32x4){bflo(w.x), bfhi(w.x), bflo(w.y), bfhi(w.y)};
            s += (v[j].x * v[j].x + v[j].y * v[j].y) + (v[j].z * v[j].z + v[j].w * v[j].w); }
        const float r1 = rsqrtf(wave_sum(s) * (1.f / D) + EPS);
#pragma unroll
        for (int j = 0; j < 4; ++j) { const f32x4 xv = *((const f32x4*)x1 + lane + 64 * j), g = *((const f32x4*)P.in[I_GPOSTF] + lane + 64 * j);
            *((f32x4*)y + lane + 64 * j) = xv + v[j] * r1 * g; }
    }
}

constexpr int RING_BYTES = 131072, MISC_OFF = RING_BYTES + 320, LDS_BYTES = 147456, NPH = 11;
__global__ void __launch_bounds__(512, 2) fast_kernel(FP P) {
    extern __shared__ __attribute__((aligned(16))) unsigned char lds_[];
    LAS unsigned char* lds = (LAS unsigned char*)lds_;
    volatile LAS unsigned* MISC = (volatile LAS unsigned*)(lds + MISC_OFF);
    const int tid = threadIdx.x, lane = tid & 63, wave = __builtin_amdgcn_readfirstlane(tid >> 6);
    unsigned char* ws = P.ws;
    unsigned* ctl = (unsigned*)(ws + WS_CTL);
    for (int u = tid; u < (LDS_BYTES - RING_BYTES) / 4; u += 512) ((LAS unsigned*)(lds + RING_BYTES))[u] = 0u;
    __syncthreads();
    XcdBarrier bar = xcd_barrier_post(ctl + CW_BAR, MISC + 8);
    const int lo = P.ph_lo, hi = P.ph_hi;
#define IN(k) (lo <= (k) && (k) < hi)
#define SEAM(k) do { if (IN(k) && IN((k) + 1)) xcd_barrier(bar); } while (0)
    bf16_t* Z = (bf16_t*)(ws + WS_Z); bf16_t* A = (bf16_t*)(ws + WS_A);
    if (IN(0)) { p0_prologue(P, lds); } SEAM(0);
    if (IN(1)) {
        pg8::Gemm g{A, (const bf16_t*)(ws + WS_WIN), M, NZ, D}; pg8::StaticOrder S; S.init(M, NZ, gridDim.x, (int)blockIdx.x);
        pg8::EpiBf16<0> E{Z, 512, (const float*)(ws + WS_BIAS), 512, SE, 1.f};
        pg8::gemm_phase<pg8::EpiBf16<0>, pg8::StaticOrder, true, true>(lds, g, S, E);
    } SEAM(1);
    if (IN(2)) {
        LAS float* wl = (LAS float*)(lds + wave * 512);
        for (int sq = blockIdx.x * 8 + wave; sq < (NPB + NB) * FH; sq += gridDim.x * 8) p2_fscan(P, sq, wl, lane);
        for (int it = blockIdx.x; it < NITEM_L; it += gridDim.x) p2_item(P, it, lds);
    } SEAM(2);
    if (IN(3)) {
        p3_scan(P);
        constexpr int NU_P = NPB * FH * 17, NU = NU_P + NB * FH;
        for (;;) {
            __syncthreads();
            if (tid == 0) MISC[16] = atomicAdd(ctl + CW_QUE, 1u);
            __syncthreads();
            const int q = (int)MISC[16];
            if (q >= NU) break;
            int unit = q;
            if (q < NU_P) { const int jj = q / (NPB * FH), sq = q % (NPB * FH); unit = sq * 17 + (16 - jj); }
            attn_unit(P, unit, lds);
        }
    } SEAM(3);
    if (IN(4)) { for (int it = blockIdx.x; it < NITEM_L; it += gridDim.x) p4_item(P, it, lds); __syncthreads(); } SEAM(4);
    if (IN(5)) {
        bf16_t* MG = Z + (size_t)ZK * SE;
        pg8::StaticOrder S; S.init(M, D, gridDim.x, (int)blockIdx.x);
        { pg8::Gemm g{Z + (size_t)ZQ * SE, (const bf16_t*)(ws + WS_WFOX), M, D, FW}; pg8::EpiGate<0> E{MG, Z + (size_t)ZGA * SE, SE};
          pg8::gemm_phase<pg8::EpiGate<0>, pg8::StaticOrder, true, true>(lds, g, S, E); }
        VM_WAIT(); __syncthreads();
        { pg8::Gemm g{Z + (size_t)ZMX * SE, (const bf16_t*)(ws + WS_WML), M, D, MW}; pg8::EpiGate<1> E{MG, Z + (size_t)ZGB * SE, SE};
          pg8::gemm_phase<pg8::EpiGate<1>, pg8::StaticOrder, true, true>(lds, g, S, E); }
    } SEAM(5);
    if (IN(6)) {
        pg8::Gemm g{Z + (size_t)ZK * SE, (const bf16_t*)(ws + WS_WOUT), M, D, D}; pg8::StaticOrder S; S.init(M, D, gridDim.x, (int)blockIdx.x);
        pg8::EpiBf16<0> E{Z + (size_t)ZMX * SE, D, nullptr, 0, 0, 1.f};
        pg8::gemm_phase<pg8::EpiBf16<0>, pg8::StaticOrder, true, true>(lds, g, S, E);
    } SEAM(6);
    if (IN(7)) { p7_mid(P); } SEAM(7);
    if (IN(8)) {
        pg8::Gemm g{A, (const bf16_t*)(ws + WS_WGU), M, 2 * DFF, D}; pg8::StaticOrder S; S.init(M, 2 * DFF, gridDim.x, (int)blockIdx.x);
        pg8::EpiSwiGLU E{Z + (size_t)ZMO * SE, DFF};
        pg8::gemm_phase<pg8::EpiSwiGLU, pg8::StaticOrder, true, true>(lds, g, S, E);
    } SEAM(8);
    if (IN(9)) {
        pg8::Gemm g{Z + (size_t)ZMO * SE, (const bf16_t*)(ws + WS_WDN), M, D, DFF}; pg8::StaticOrder S; S.init(M, D, gridDim.x, (int)blockIdx.x);
        pg8::EpiBf16<0> E{Z + (size_t)ZMX * SE, D, nullptr, 0, 0, 1.f};
        pg8::gemm_phase<pg8::EpiBf16<0>, pg8::StaticOrder, true, true>(lds, g, S, E);
    } SEAM(9);
    if (IN(10)) { p10_final(P); }
#undef IN
#undef SEAM
}
}

#ifndef DBG
#define DBG 0
#endif
#ifndef DBG_PH
#define DBG_PH 11
#endif
#ifndef DBG_SPLIT
#define DBG_SPLIT 0
#endif
#ifndef CMPB
#define CMPB 0
#endif
#if DBG
constexpr int NSLOT = 64;
struct Groups { int slot[5][12]; int nslot[5]; float thr; float unit; };
__global__ void cmp_kernel(const void* fast, int is_bf16, long ldf, long frow0, int fcol0, const float* naive, long ldn, int ncol0, int T, int ncols, float fscale, float* acc) {
    float sd = 0.f, sn = 0.f;
    for (long e = (long)blockIdx.x * 256 + threadIdx.x; e < (long)T * ncols; e += (long)gridDim.x * 256) {
        const long t = e / ncols; const int c = (int)(e % ncols);
        float f = is_bf16 ? fk::bf2f(((const unsigned short*)fast)[(frow0 + t) * ldf + fcol0 + c]) : ((const float*)fast)[(frow0 + t) * ldf + fcol0 + c];
        const float n = naive[t * ldn + ncol0 + c];
        f *= fscale; const float d = f - n; sd += d * d; sn += n * n;
    }
    sd = wave_sum(sd); sn = wave_sum(sn);
    if ((threadIdx.x & 63) == 0) { atomicAdd(acc, sd); atomicAdd(acc + 1, sn); }
}
__global__ void inject_kernel(const float* acc, Groups G, float* y, int n) {
    int mask = 0; float dmax = 0.f;
    for (int g = 0; g < 5; ++g) for (int i = 0; i < G.nslot[g]; ++i) {
        const int s = G.slot[g][i]; const float sd = acc[2 * s], sn = acc[2 * s + 1];
        const float d = (sn > 0.f) ? sqrtf(sd / sn) : 9.f;
        if (!(d < G.thr)) mask |= 1 << g; else dmax = fmaxf(dmax, d);
    }
    const float inj = mask ? G.unit * (float)mask : dmax;
    for (int i = blockIdx.x * 256 + threadIdx.x; i < n; i += gridDim.x * 256) y[i] *= (1.f + inj);
}
#endif

extern "C" void kernel_launch(void* const* d_in, const int* in_sizes, int n_in, void* d_out, int out_size, void* d_ws, size_t ws_size, hipStream_t stream) {
    static int grid = 0;
    if (!grid) {
        int dev = 0, cus = 0, per_cu = 0;
        hipGetDevice(&dev);
        hipDeviceGetAttribute(&cus, hipDeviceAttributeMultiprocessorCount, dev);
        hipFuncSetAttribute((const void*)fk::fast_kernel, hipFuncAttributeMaxDynamicSharedMemorySize, fk::LDS_BYTES);
        hipOccupancyMaxActiveBlocksPerMultiprocessor(&per_cu, fk::fast_kernel, 512, fk::LDS_BYTES);
        if (per_cu < 1) fprintf(stderr, "kernel_launch: occupancy query says %d blocks/CU\n", per_cu);
        grid = cus;
        size_t need = fk::WS_FASTEND;
#if DBG
        need += (W_END + 8 * 1024 * 1024) * sizeof(float);
#endif
        if ((size_t)out_size != OUT_TOTAL || n_in != 29 || ws_size < need)
            fprintf(stderr, "kernel_launch: unexpected sizes out=%d (want %zu) n_in=%d ws=%zu (need %zu)\n", out_size, OUT_TOTAL, n_in, ws_size, need);
    }
    unsigned char* ws = (unsigned char*)d_ws;
    hipMemsetAsync(ws + fk::WS_CTL, 0, fk::CTL_ZERO_BYTES, stream);
    fk::FP F{};
    for (int i = 0; i < 29; ++i) F.in[i] = (const float*)d_in[i];
    F.out = (float*)d_out; F.ws = ws;
#if FAST_NPB == 8
    F.scr = (unsigned char*)d_out;
#else
    F.scr = ws + fk::WS_SCR;
#endif
#if !DBG
    F.ph_lo = 0; F.ph_hi = fk::NPH;
    { void* args[] = {&F}; hipError_t e = hipLaunchCooperativeKernel((void*)fk::fast_kernel, dim3(grid), dim3(512), args, fk::LDS_BYTES, stream);
      if (e != hipSuccess) fprintf(stderr, "cooperative launch failed: %s (grid %d)\n", hipGetErrorString(e), grid); }
#else
    float* dbg = (float*)(ws + fk::WS_FASTEND);
    float* nws = dbg + 8 * 1024 * 1024;
    hipMemsetAsync(dbg, 0, 2 * NSLOT * sizeof(float), stream);
#if DBG_SPLIT
    for (int p = 0; p < DBG_PH; ++p) { F.ph_lo = p; F.ph_hi = p + 1; hipLaunchKernelGGL(fk::fast_kernel, dim3(grid), dim3(512), fk::LDS_BYTES, stream, F); }
#else
    F.ph_lo = 0; F.ph_hi = DBG_PH;
    { void* args[] = {&F}; hipError_t e = hipLaunchCooperativeKernel((void*)fk::fast_kernel, dim3(grid), dim3(512), args, fk::LDS_BYTES, stream);
      if (e != hipSuccess) fprintf(stderr, "cooperative launch failed: %s (grid %d)\n", hipGetErrorString(e), grid); }
#endif
    float* out = (float*)d_out;
    float* snp = dbg + 1024;
    float* sns = snp + 6 * 1024 * 1024;
    const size_t SN_FK = 0, SN_FV = (size_t)LP * FW, SN_LF = SN_FV + (size_t)LP * FW, SN_C = SN_LF + (size_t)LP * FH, SN_N = SN_C + MH * MD * MD, SN_M = SN_N + MH * MD, SN_CV = SN_M + 16;
    auto snap = [&](float* dst, bool samp) {
        const int b = CMPB, T = samp ? DEC_T : LP;
        hipMemcpyAsync(dst + SN_FK, out + (samp ? OUT_FKS : OUT_FKP) + (size_t)b * T * FW, (size_t)T * FW * 4, hipMemcpyDeviceToDevice, stream);
        hipMemcpyAsync(dst + SN_FV, out + (samp ? OUT_FVS : OUT_FVP) + (size_t)b * T * FW, (size_t)T * FW * 4, hipMemcpyDeviceToDevice, stream);
        hipMemcpyAsync(dst + SN_LF, out + (samp ? OUT_LFS : OUT_LFP) + (size_t)b * T * FH, (size_t)T * FH * 4, hipMemcpyDeviceToDevice, stream);
        hipMemcpyAsync(dst + SN_C, out + (samp ? OUT_CS : OUT_CP) + (size_t)b * MH * MD * MD, (size_t)MH * MD * MD * 4, hipMemcpyDeviceToDevice, stream);
        hipMemcpyAsync(dst + SN_N, out + (samp ? OUT_NS : OUT_NP) + (size_t)b * MH * MD, (size_t)MH * MD * 4, hipMemcpyDeviceToDevice, stream);
        hipMemcpyAsync(dst + SN_M, out + (samp ? OUT_MS : OUT_MP) + (size_t)b * MH, (size_t)MH * 4, hipMemcpyDeviceToDevice, stream);
        hipMemcpyAsync(dst + SN_CV, out + (samp ? OUT_CVS : OUT_CVP) + (size_t)b * 3 * MW, (size_t)3 * MW * 4, hipMemcpyDeviceToDevice, stream);
    };
    snap(snp, false); snap(sns, true);
    Params P{};
    for (int i = 0; i < 29; ++i) P.in[i] = (const float*)d_in[i];
    P.out = out; P.ws = nws;
    auto cmp = [&](int slot, const void* fast, int is_bf16, long ldf, long frow0, int fcol0, const float* naive, long ldn, int ncol0, int T, int ncols, float scale) {
        hipLaunchKernelGGL(cmp_kernel, dim3(256), dim3(256), 0, stream, fast, is_bf16, ldf, frow0, fcol0, naive, ldn, ncol0, T, ncols, scale, dbg + 2 * slot);
    };
    const fk::bf16_t* Zb = (const fk::bf16_t*)(ws + fk::WS_Z);
    auto zbuf = [&](int i) { return (const void*)(Zb + (size_t)i * fk::SE); };
    auto hook = [&](int it, int s) {
        const bool samp = it >= NB; const int b = samp ? it - NB : it;
        if (b != CMPB) return;
        const int so = samp ? 32 : 0; const int T = samp ? DEC_T : LP;
        const long r0 = samp ? (long)fk::SROW0 + b * DEC_T : (long)b * fk::RP + fk::PADF;
        const float* sn = samp ? sns : snp;
        if (s == 2) {
            cmp(so + 2, zbuf(fk::ZV), 1, 512, r0, 0, nws + W_Z, DIN, O_FV, T, 512, 1.f);
            cmp(so + 3, zbuf(fk::ZMV), 1, 512, r0, 0, nws + W_Z, DIN, O_MV, T, 512, 1.f);
            cmp(so + 23, zbuf(fk::ZMX), 1, 512, r0, 0, nws + W_Z, DIN, O_MX, T, 512, 1.f);
            cmp(so + 4, zbuf(fk::ZGA), 1, 512, r0, 0, nws + W_Z, DIN, O_GA, T, 512, 1.f);
            if (DBG_PH <= 3) { cmp(so + 1, zbuf(fk::ZK), 1, 512, r0, 0, nws + W_Z, DIN, O_FK, T, 512, 1.f); }
            if (DBG_PH == 3) { cmp(so + 0, zbuf(fk::ZQ), 1, 512, r0, 0, nws + W_Z, DIN, O_FQ, T, 512, 1.f / fk::C2Q); }
            cmp(so + 17, sn + SN_FK, 0, FW, 0, 0, out + (samp ? OUT_FKS : OUT_FKP) + (size_t)b * T * FW, FW, 0, T, FW, 1.f);
            cmp(so + 18, sn + SN_LF, 0, FH, 0, 0, out + (samp ? OUT_LFS : OUT_LFP) + (size_t)b * T * FH, FH, 0, T, FH, 1.f);
        }
        if (s == 3) {
            const float* nbp = samp ? (const float*)(ws + fk::WS_MISC + fk::MS_NBS) + (size_t)(b * FH + 3) * fk::NBSL : (const float*)(ws + fk::WS_MISC + fk::MS_NBP) + (size_t)(b * FH + 3) * fk::NBPL + fk::PADF;
            const int TT = samp ? PAST + DEC_T : LP;
            cmp(so + 5, nbp, 0, 1, 0, 0, nws + W_FC, FH, 3, TT, 1, -1.f / fk::LOG2E);
        }
        if (s == 4 && DBG_PH >= 4) cmp(so + 9, zbuf(fk::ZQ), 1, 512, r0, 0, nws + W_AT, FW, 0, T, 512, 1.f);
        if (s == 5) { cmp(so + 6, ws + fk::WS_A, 1, 512, r0, 0, nws + W_XC, MW, 0, T, 512, 1.f);
                      cmp(so + 22, sn + SN_CV, 0, MW, 0, 0, out + (samp ? OUT_CVS : OUT_CVP) + (size_t)b * 3 * MW, MW, 0, 3, MW, 1.f); }
        if (s == 6) { cmp(so + 7, (const fk::bf16_t*)(ws + fk::WS_A) + fk::SE, 1, 512, r0, 0, nws + W_MQ, MW, 0, T, 512, 1.f);
                      if (DBG_PH <= 7) cmp(so + 8, F.scr, 1, 512, r0, 0, nws + W_MK, MW, 0, T, 512, 1.f); }
        if (s == 7 && DBG_PH >= 4) { cmp(so + 19, sn + SN_C, 0, 1, 0, 0, out + (samp ? OUT_CS : OUT_CP) + (size_t)b * MH * MD * MD, 1, 0, MH * MD * MD, 1, 1.f);
                      cmp(so + 20, sn + SN_N, 0, 1, 0, 0, out + (samp ? OUT_NS : OUT_NP) + (size_t)b * MH * MD, 1, 0, MH * MD, 1, 1.f);
                      cmp(so + 21, sn + SN_M, 0, 1, 0, 0, out + (samp ? OUT_MS : OUT_MP) + (size_t)b * MH, 1, 0, MH, 1, 1.f); }
        if (s == 8 && DBG_PH >= 5 && DBG_PH <= 6) cmp(so + 10, zbuf(fk::ZMX), 1, 512, r0, 0, nws + W_HM, MW, 0, T, 512, 1.f);
        if (s == 10 && DBG_PH >= 6) cmp(so + 11, zbuf(fk::ZK), 1, 1024, r0, 0, nws + W_YA, D, 0, T, D, 1.f);
        if (s == 11 && DBG_PH == 7) cmp(so + 12, zbuf(fk::ZMX), 1, 1024, r0, 0, nws + W_OB, D, 0, T, D, 1.f);
        if (s == 12 && DBG_PH >= 8) cmp(so + 13, ws + fk::WS_A, 1, 1024, r0 + (samp ? 0 : NMETA), 0, nws + W_H2 + (samp ? 0 : (size_t)NMETA * D), D, 0, T - (samp ? 0 : NMETA), D, 1.f);
        if (s == 14 && DBG_PH >= 9) cmp(so + 14, zbuf(fk::ZMO), 1, DFF, r0 + (samp ? 0 : NMETA), 0, nws + W_ACT + (samp ? 0 : (size_t)NMETA * DFF), DFF, 0, T - (samp ? 0 : NMETA), DFF, 1.f);
        if (s == 15 && DBG_PH >= 10) cmp(so + 15, zbuf(fk::ZMX), 1, 1024, r0 + (samp ? 0 : NMETA), 0, nws + W_FFO + (samp ? 0 : (size_t)NMETA * D), D, 0, T - (samp ? 0 : NMETA), D, 1.f);
#if FAST_NPB != 8
        if (s == 16 && DBG_PH >= 11) { const int t0 = samp ? 0 : NMETA;
            cmp(so + 16, (const float*)(F.scr + 3 * fk::SB + 4096) + (size_t)fk::M * D, 0, D, r0 + t0, 0, out + (samp ? OUT_YS + (size_t)b * DEC_T * D : OUT_YP + (size_t)b * SEQ * D), D, 0, T - t0, D, 1.f); }
#endif
    };
    const int order[2] = {NB + CMPB, CMPB};
    for (int oi = 0; oi < 2 * NB; ++oi) {
        int it = -1;
        if (oi < 2) it = order[oi]; else { int cnt = -1; for (int c = 0; c < 2 * NB; ++c) { if (c == order[0] || c == order[1]) continue; if (++cnt == oi - 2) { it = c; break; } } }
        P.item_lo = it; P.item_hi = it + 1; P.stage_lo = 0; P.stage_hi = NSTAGE;
        StageLoop<NSTAGE - 1>::launch_hook(P, 2048, stream, it, hook);
    }
    Groups G{};
    G.thr = 0.03f; G.unit = 0.05f;
    { const int g0[] = DBG_G0; const int g1[] = DBG_G1; const int g2[] = DBG_G2; const int g3[] = DBG_G3; const int g4[] = DBG_G4;
      const int* gs[5] = {g0, g1, g2, g3, g4}; const int ns[5] = {(int)(sizeof(g0) / 4), (int)(sizeof(g1) / 4), (int)(sizeof(g2) / 4), (int)(sizeof(g3) / 4), (int)(sizeof(g4) / 4)};
      for (int g = 0; g < 5; ++g) { int k = 0; for (int i = 0; i < ns[g]; ++i) if (gs[g][i] >= 0) G.slot[g][k++] = gs[g][i]; G.nslot[g] = k; } }
    hipLaunchKernelGGL(inject_kernel, dim3(256), dim3(256), 0, stream, (const float*)dbg, G, out + OUT_YS, NB * DEC_T * D);
#endif
}
```

```cpp
#define FAST_NPB 8
#define DBG 0
#include <hip/hip_runtime.h>
#include <hip/hip_cooperative_groups.h>
#include <cstdio>
#include <cstdint>
namespace cg = cooperative_groups;


constexpr int D = 1024, NB = 8, SEQ = 4096, NMETA = 16, LP = NMETA + SEQ, DEC_T = 64, PAST = 1024;
constexpr int FH = 8, FD = 64, FW = 512, MH = 4, MD = 128, MW = 512;
constexpr int DFF = 2816, DIN = 5136;
constexpr int O_FQ = 0, O_FK = 512, O_FV = 1024, O_FF = 1536, O_MX = 1544, O_MV = 2056, O_MO = 2568, O_MI = 3080, O_MF = 3084, O_GA = 3088, O_GB = 4112;
constexpr float EPS = 1e-6f;
constexpr size_t OUT_YP = 0;
constexpr size_t OUT_YS = OUT_YP + (size_t)NB * SEQ * D;
constexpr size_t OUT_FKP = OUT_YS + (size_t)NB * DEC_T * D;
constexpr size_t OUT_FVP = OUT_FKP + (size_t)NB * LP * FW;
constexpr size_t OUT_LFP = OUT_FVP + (size_t)NB * LP * FW;
constexpr size_t OUT_CP = OUT_LFP + (size_t)NB * LP * FH;
constexpr size_t OUT_NP = OUT_CP + (size_t)NB * MH * MD * MD;
constexpr size_t OUT_MP = OUT_NP + (size_t)NB * MH * MD;
constexpr size_t OUT_CVP = OUT_MP + (size_t)NB * MH;
constexpr size_t OUT_FKS = OUT_CVP + (size_t)NB * 3 * MW;
constexpr size_t OUT_FVS = OUT_FKS + (size_t)NB * DEC_T * FW;
constexpr size_t OUT_LFS = OUT_FVS + (size_t)NB * DEC_T * FW;
constexpr size_t OUT_CS = OUT_LFS + (size_t)NB * DEC_T * FH;
constexpr size_t OUT_NS = OUT_CS + (size_t)NB * MH * MD * MD;
constexpr size_t OUT_MS = OUT_NS + (size_t)NB * MH * MD;
constexpr size_t OUT_CVS = OUT_MS + (size_t)NB * MH;
constexpr size_t OUT_TOTAL = OUT_CVS + (size_t)NB * 3 * MW;

constexpr size_t TM = LP;
constexpr size_t W_H = 0;
constexpr size_t W_Z = W_H + TM * D;
constexpr size_t W_LOGF = W_Z + TM * DIN;
constexpr size_t W_FC = W_LOGF + TM * FH;
constexpr size_t W_AT = W_FC + (TM + PAST) * FH;
constexpr size_t W_XC = W_AT + TM * FW;
constexpr size_t W_MQ = W_XC + TM * MW;
constexpr size_t W_MK = W_MQ + TM * MW;
constexpr size_t W_NUM = W_MK + TM * MW;
constexpr size_t W_DEN = W_NUM + TM * MW;
constexpr size_t W_MT = W_DEN + TM * MH;
constexpr size_t W_HM = W_MT + TM * MH;
constexpr size_t W_YA = W_HM + TM * MW;
constexpr size_t W_YB = W_YA + TM * D;
constexpr size_t W_OB = W_YB + TM * D;
constexpr size_t W_X1 = W_OB + TM * D;
constexpr size_t W_H2 = W_X1 + TM * D;
constexpr size_t W_GU = W_Z;
constexpr size_t W_ACT = W_MQ;
constexpr size_t W_FFO = W_YB;
constexpr size_t W_END = W_H2 + TM * D;
static_assert(W_Z + TM * 2 * DFF <= W_MQ && W_MQ + TM * DFF <= W_YB, "naive aliases");

struct Params {
    const float* in[29];
    float* out;
    float* ws;
    int item_lo, item_hi, stage_lo, stage_hi;
};

enum { I_XP = 0, I_XS, I_CK, I_CV, I_CLF, I_SC, I_SN, I_SM, I_SCV, I_META, I_WIN, I_BIN, I_GFQ, I_GFK, I_WCONV, I_BCONV, I_WMQ, I_WMK, I_GMN, I_SKIP,
       I_WFOX, I_WML, I_WOUT, I_GPRE, I_GPOST, I_GPREF, I_GPOSTF, I_WGU, I_WDN };

__device__ __forceinline__ float wave_sum(float v) {
#pragma unroll
    for (int o = 1; o < 64; o <<= 1) v += __shfl_xor(v, o);
    return v;
}
__device__ __forceinline__ float wave_max(float v) {
#pragma unroll
    for (int o = 1; o < 64; o <<= 1) v = fmaxf(v, __shfl_xor(v, o));
    return v;
}
__device__ __forceinline__ float sigmoidf_(float x) { return 1.f / (1.f + expf(-x)); }
__device__ __forceinline__ float logsigmoidf_(float x) { return fminf(x, 0.f) - log1pf(expf(-fabsf(x))); }
__device__ __forceinline__ float siluf_(float x) { return x * sigmoidf_(x); }

#ifndef DBG
#define DBG 0
#endif
#ifndef DBG_G0
#define DBG_G0 {-1}
#define DBG_G1 {-1}
#define DBG_G2 {-1}
#define DBG_G3 {-1}
#define DBG_G4 {-1}
#endif
#if DBG
struct Item { int T; int b; bool samp; };
__device__ __forceinline__ Item get_item(int it) { Item I; I.samp = it >= NB; I.b = I.samp ? it - NB : it; I.T = I.samp ? DEC_T : LP; return I; }

__device__ __forceinline__ const float* xrow(const Params& P, const Item& I, int t) {
    if (I.samp) return P.in[I_XS] + ((size_t)I.b * DEC_T + t) * D;
    if (t < NMETA) return P.in[I_META] + (size_t)t * D;
    return P.in[I_XP] + ((size_t)I.b * SEQ + (t - NMETA)) * D;
}

__device__ __forceinline__ void sgemm(const float* A, int lda, const float* B, int ldb, float* C, int ldc, int M, int N, int K, const float* bias, float alpha, float* sm) {
    float (*As)[68] = (float (*)[68])sm;
    float (*Bs)[68] = (float (*)[68])(sm + 16 * 68);
    const int tid = threadIdx.x, tx = tid & 15, ty = tid >> 4;
    const int nbn = (N + 63) / 64, nbm = (M + 63) / 64;
    for (int vb = blockIdx.x; vb < nbm * nbn; vb += gridDim.x) {
        const int bm = vb / nbn, bn = vb % nbn;
        float acc[4][4];
#pragma unroll
        for (int i = 0; i < 4; ++i)
#pragma unroll
            for (int j = 0; j < 4; ++j) acc[i][j] = 0.f;
        for (int k0 = 0; k0 < K; k0 += 16) {
            {
                const int r = tid >> 2, kq = (tid & 3) * 4, gr = bm * 64 + r;
                float4 v = make_float4(0.f, 0.f, 0.f, 0.f);
                if (gr < M) v = *(const float4*)(A + (size_t)gr * lda + k0 + kq);
                As[kq + 0][r] = v.x; As[kq + 1][r] = v.y; As[kq + 2][r] = v.z; As[kq + 3][r] = v.w;
            }
            {
                const int kk = tid >> 4, nq = (tid & 15) * 4, gn = bn * 64 + nq;
                float4 v = make_float4(0.f, 0.f, 0.f, 0.f);
                if (gn < N) v = *(const float4*)(B + (size_t)(k0 + kk) * ldb + gn);
                *(float4*)&Bs[kk][nq] = v;
            }
            __syncthreads();
#pragma unroll
            for (int kk = 0; kk < 16; ++kk) {
                const float4 a = *(const float4*)&As[kk][ty * 4];
                const float4 b = *(const float4*)&Bs[kk][tx * 4];
                const float av[4] = {a.x, a.y, a.z, a.w}, bv[4] = {b.x, b.y, b.z, b.w};
#pragma unroll
                for (int i = 0; i < 4; ++i)
#pragma unroll
                    for (int j = 0; j < 4; ++j) acc[i][j] += av[i] * bv[j];
            }
            __syncthreads();
        }
#pragma unroll
        for (int i = 0; i < 4; ++i) {
            const int gr = bm * 64 + ty * 4 + i;
            if (gr < M) {
                const int gn = bn * 64 + tx * 4;
                if (gn < N) {
                    float4 o;
                    o.x = alpha * acc[i][0] + (bias ? bias[gn + 0] : 0.f);
                    o.y = alpha * acc[i][1] + (bias ? bias[gn + 1] : 0.f);
                    o.z = alpha * acc[i][2] + (bias ? bias[gn + 2] : 0.f);
                    o.w = alpha * acc[i][3] + (bias ? bias[gn + 3] : 0.f);
                    *(float4*)(C + (size_t)gr * ldc + gn) = o;
                }
            }
        }
    }
}

__device__ __forceinline__ void st_norm_in(const Params& P, const Item& I) {
    const int lane = threadIdx.x & 63, wv = threadIdx.x >> 6;
    float* H = P.ws + W_H;
    const float* g = P.in[I_GPRE];
    for (int t = blockIdx.x * 4 + wv; t < I.T; t += gridDim.x * 4) {
        const float* x = xrow(P, I, t);
        float v[16]; float ss = 0.f;
#pragma unroll
        for (int j = 0; j < 16; ++j) { v[j] = x[lane + 64 * j]; ss += v[j] * v[j]; }
        ss = wave_sum(ss);
        const float r = rsqrtf(ss * (1.f / D) + EPS);
#pragma unroll
        for (int j = 0; j < 16; ++j) H[(size_t)t * D + lane + 64 * j] = v[j] * r * g[lane + 64 * j];
    }
}
__device__ __forceinline__ void st_fox_prep(const Params& P, const Item& I) {
    const int lane = threadIdx.x & 63, wv = threadIdx.x >> 6;
    float* Z = P.ws + W_Z; float* LOGF = P.ws + W_LOGF;
    float* ok = P.out + (I.samp ? OUT_FKS + (size_t)I.b * DEC_T * FW : OUT_FKP + (size_t)I.b * LP * FW);
    float* ov = P.out + (I.samp ? OUT_FVS + (size_t)I.b * DEC_T * FW : OUT_FVP + (size_t)I.b * LP * FW);
    float* olf = P.out + (I.samp ? OUT_LFS + (size_t)I.b * DEC_T * FH : OUT_LFP + (size_t)I.b * LP * FH);
    for (int t = blockIdx.x * 4 + wv; t < I.T; t += gridDim.x * 4) {
        float* z = Z + (size_t)t * DIN;
        const int c0 = lane * 8;
        float q[8], k[8]; float sq = 0.f, sk = 0.f;
#pragma unroll
        for (int j = 0; j < 8; ++j) { q[j] = z[O_FQ + c0 + j]; k[j] = z[O_FK + c0 + j]; sq += q[j] * q[j]; sk += k[j] * k[j]; }
#pragma unroll
        for (int o = 1; o < 8; o <<= 1) { sq += __shfl_xor(sq, o); sk += __shfl_xor(sk, o); }
        const float rq = rsqrtf(sq * (1.f / FD) + EPS), rk = rsqrtf(sk * (1.f / FD) + EPS);
#pragma unroll
        for (int j = 0; j < 8; ++j) {
            const float qn = q[j] * rq * P.in[I_GFQ][c0 + j], kn = k[j] * rk * P.in[I_GFK][c0 + j];
            z[O_FQ + c0 + j] = qn; z[O_FK + c0 + j] = kn;
            ok[(size_t)t * FW + c0 + j] = kn;
            ov[(size_t)t * FW + c0 + j] = z[O_FV + c0 + j];
        }
        if (lane < FH) { const float lf = logsigmoidf_(z[O_FF + lane]); LOGF[(size_t)t * FH + lane] = lf; olf[(size_t)t * FH + lane] = lf; }
    }
}
__device__ __forceinline__ void st_fcum(const Params& P, const Item& I) {
    if (blockIdx.x != 0 || threadIdx.x >= FH) return;
    const int h = threadIdx.x;
    float* FC = P.ws + W_FC; const float* LOGF = P.ws + W_LOGF;
    float acc = 0.f; int base = 0;
    if (I.samp) {
        const float* cl = P.in[I_CLF] + (size_t)I.b * PAST * FH;
        for (int i = 0; i < PAST; ++i) { acc += cl[(size_t)i * FH + h]; FC[(size_t)i * FH + h] = acc; }
        base = PAST;
    }
    for (int t = 0; t < I.T; ++t) { acc += LOGF[(size_t)t * FH + h]; FC[(size_t)(base + t) * FH + h] = acc; }
}
__device__ __forceinline__ void st_attn(const Params& P, const Item& I, float* sm) {
    const int lane = threadIdx.x & 63, wv = threadIdx.x >> 6;
    const float* Z = P.ws + W_Z; const float* FC = P.ws + W_FC; float* AT = P.ws + W_AT;
    float* qs = sm + wv * 64;
    const int base = I.samp ? PAST : 0;
    const float* ck = P.in[I_CK] + (size_t)I.b * PAST * FW;
    const float* cv = P.in[I_CV] + (size_t)I.b * PAST * FW;
    const int nunits = I.T * FH;
    for (int u = blockIdx.x * 4 + wv; u < nunits; u += gridDim.x * 4) {
        const int t = u / FH, h = u % FH;
        qs[lane] = Z[(size_t)t * DIN + O_FQ + h * FD + lane];
        __builtin_amdgcn_wave_barrier();
        const int qpos = base + t;
        const float Fq = FC[(size_t)qpos * FH + h];
        float m = -INFINITY, l = 0.f; float o[64];
#pragma unroll
        for (int d = 0; d < 64; ++d) o[d] = 0.f;
        for (int i = lane; i <= qpos; i += 64) {
            const float* kr; const float* vr;
            if (i < base) { kr = ck + (size_t)i * FW + h * FD; vr = cv + (size_t)i * FW + h * FD; }
            else { kr = Z + (size_t)(i - base) * DIN + O_FK + h * FD; vr = Z + (size_t)(i - base) * DIN + O_FV + h * FD; }
            float dot = 0.f;
#pragma unroll
            for (int d = 0; d < 64; d += 4) { const float4 kk = *(const float4*)(kr + d); dot += kk.x * qs[d] + kk.y * qs[d + 1] + kk.z * qs[d + 2] + kk.w * qs[d + 3]; }
            const float sc = dot * 0.125f + (Fq - FC[(size_t)i * FH + h]);
            const float mn = fmaxf(m, sc), corr = expf(m - mn), p = expf(sc - mn);
            l = l * corr + p;
#pragma unroll
            for (int d = 0; d < 64; d += 4) { const float4 vv = *(const float4*)(vr + d);
                o[d] = o[d] * corr + p * vv.x; o[d + 1] = o[d + 1] * corr + p * vv.y; o[d + 2] = o[d + 2] * corr + p * vv.z; o[d + 3] = o[d + 3] * corr + p * vv.w; }
            m = mn;
        }
        const float Mx = wave_max(m);
        const float sc_l = (m == -INFINITY) ? 0.f : expf(m - Mx);
        const float L = wave_sum(l * sc_l);
        float mine = 0.f;
#pragma unroll
        for (int d = 0; d < 64; ++d) { const float s = wave_sum(o[d] * sc_l); if (lane == d) mine = s; }
        AT[(size_t)t * FW + h * FD + lane] = mine / L;
    }
}
__device__ __forceinline__ void st_conv(const Params& P, const Item& I) {
    const float* Z = P.ws + W_Z; float* XC = P.ws + W_XC;
    const float* wc = P.in[I_WCONV]; const float* bc = P.in[I_BCONV];
    const float* prev = P.in[I_SCV] + (size_t)I.b * 3 * MW;
    const int n = I.T * MW;
    for (int e = blockIdx.x * blockDim.x + threadIdx.x; e < n; e += gridDim.x * blockDim.x) {
        const int t = e / MW, c = e % MW;
        float y = bc[c];
#pragma unroll
        for (int i = 0; i < 4; ++i) {
            const int u = t + i - 3;
            float s;
            if (u >= 0) s = Z[(size_t)u * DIN + O_MX + c]; else s = I.samp ? prev[(size_t)(u + 3) * MW + c] : 0.f;
            y += wc[i * MW + c] * s;
        }
        XC[e] = siluf_(y);
    }
    float* oc = P.out + (I.samp ? OUT_CVS : OUT_CVP) + (size_t)I.b * 3 * MW;
    for (int e = blockIdx.x * blockDim.x + threadIdx.x; e < 3 * MW; e += gridDim.x * blockDim.x) {
        const int j = e / MW, c = e % MW;
        oc[e] = Z[(size_t)(I.T - 3 + j) * DIN + O_MX + c];
    }
}
__device__ __forceinline__ void st_mlstm(const Params& P, const Item& I, float* sm) {
    if (blockIdx.x >= MH) return;
    const int h = blockIdx.x, j = threadIdx.x;
    const float* Z = P.ws + W_Z; const float* MQ = P.ws + W_MQ; const float* MK = P.ws + W_MK;
    float* NUM = P.ws + W_NUM; float* DEN = P.ws + W_DEN; float* MT = P.ws + W_MT;
    float* qs = sm;
    float* ks = sm + 8 * 128;
    float c[128];
    float m = 0.f;
    if (I.samp) {
        m = P.in[I_SM][I.b * MH + h];
        const float* C0 = P.in[I_SC] + ((size_t)I.b * MH + h) * MD * MD;
        const float* n0 = P.in[I_SN] + ((size_t)I.b * MH + h) * MD;
#pragma unroll
        for (int dk = 0; dk < 128; ++dk) c[dk] = (j < 128) ? C0[(size_t)dk * MD + j] : (j == 128 ? n0[dk] : 0.f);
    } else {
#pragma unroll
        for (int dk = 0; dk < 128; ++dk) c[dk] = 0.f;
    }
    for (int t0 = 0; t0 < I.T; t0 += 8) {
        __syncthreads();
        for (int e = threadIdx.x; e < 8 * 128; e += blockDim.x) {
            const int tt = e >> 7, d = e & 127;
            const bool ok = (t0 + tt) < I.T;
            qs[e] = ok ? MQ[(size_t)(t0 + tt) * MW + h * MD + d] : 0.f;
            ks[e] = ok ? MK[(size_t)(t0 + tt) * MW + h * MD + d] : 0.f;
        }
        __syncthreads();
        const int nt = (I.T - t0) < 8 ? (I.T - t0) : 8;
        for (int tt = 0; tt < nt; ++tt) {
            const int t = t0 + tt;
            const float* z = Z + (size_t)t * DIN;
            const float lf = logsigmoidf_(z[O_MF + h]), ig = z[O_MI + h];
            const float mn = fmaxf(lf + m, ig);
            const float a = expf(lf + m - mn), bb = expf(ig - mn);
            const float vj = (j < 128) ? z[O_MV + h * MD + j] : 1.f;
            const float bv = bb * vj;
            float acc0 = 0.f, acc1 = 0.f, acc2 = 0.f, acc3 = 0.f;
#pragma unroll
            for (int dk = 0; dk < 128; dk += 4) {
                const float4 kk = *(const float4*)(ks + tt * 128 + dk);
                const float4 qq = *(const float4*)(qs + tt * 128 + dk);
                c[dk] = a * c[dk] + bv * kk.x; acc0 += qq.x * c[dk];
                c[dk + 1] = a * c[dk + 1] + bv * kk.y; acc1 += qq.y * c[dk + 1];
                c[dk + 2] = a * c[dk + 2] + bv * kk.z; acc2 += qq.z * c[dk + 2];
                c[dk + 3] = a * c[dk + 3] + bv * kk.w; acc3 += qq.w * c[dk + 3];
            }
            const float acc = (acc0 + acc1) + (acc2 + acc3);
            if (j < 128) NUM[(size_t)t * MW + h * MD + j] = acc;
            else if (j == 128) { DEN[(size_t)t * MH + h] = acc; MT[(size_t)t * MH + h] = mn; }
            m = mn;
        }
    }
    float* oC = P.out + (I.samp ? OUT_CS : OUT_CP) + ((size_t)I.b * MH + h) * MD * MD;
    float* on = P.out + (I.samp ? OUT_NS : OUT_NP) + ((size_t)I.b * MH + h) * MD;
    float* om = P.out + (I.samp ? OUT_MS : OUT_MP) + (size_t)I.b * MH + h;
#pragma unroll
    for (int dk = 0; dk < 128; ++dk) { if (j < 128) oC[(size_t)dk * MD + j] = c[dk]; else if (j == 128) on[dk] = c[dk]; }
    if (j == 0) *om = m;
}
__device__ __forceinline__ void st_hm(const Params& P, const Item& I) {
    const int lane = threadIdx.x & 63, wv = threadIdx.x >> 6;
    const float* Z = P.ws + W_Z; const float* NUM = P.ws + W_NUM; const float* DEN = P.ws + W_DEN; const float* MT = P.ws + W_MT; const float* XC = P.ws + W_XC;
    float* HM = P.ws + W_HM;
    for (int t = blockIdx.x * 4 + wv; t < I.T; t += gridDim.x * 4) {
        const int c0 = lane * 8, h = lane >> 4;
        const float den = DEN[(size_t)t * MH + h], mt = MT[(size_t)t * MH + h];
        const float dd = fmaxf(fabsf(den), expf(-mt));
        float v[8]; float ss = 0.f;
#pragma unroll
        for (int jj = 0; jj < 8; ++jj) { const float hc = NUM[(size_t)t * MW + c0 + jj] / dd; v[jj] = sigmoidf_(Z[(size_t)t * DIN + O_MO + c0 + jj]) * hc; ss += v[jj] * v[jj]; }
#pragma unroll
        for (int o = 1; o < 16; o <<= 1) ss += __shfl_xor(ss, o);
        const float r = rsqrtf(ss * (1.f / MD) + EPS);
#pragma unroll
        for (int jj = 0; jj < 8; ++jj) HM[(size_t)t * MW + c0 + jj] = v[jj] * r * P.in[I_GMN][c0 + jj] + P.in[I_SKIP][c0 + jj] * XC[(size_t)t * MW + c0 + jj];
    }
}
__device__ __forceinline__ void st_merge(const Params& P, const Item& I) {
    const float* Z = P.ws + W_Z; float* YA = P.ws + W_YA; const float* YB = P.ws + W_YB;
    const int n = I.T * D;
    for (int e = blockIdx.x * blockDim.x + threadIdx.x; e < n; e += gridDim.x * blockDim.x) {
        const int t = e / D, c = e % D;
        YA[e] = sigmoidf_(Z[(size_t)t * DIN + O_GA + c]) * YA[e] + sigmoidf_(Z[(size_t)t * DIN + O_GB + c]) * YB[e];
    }
}
__device__ __forceinline__ void st_mid(const Params& P, const Item& I) {
    const int lane = threadIdx.x & 63, wv = threadIdx.x >> 6;
    const float* OB = P.ws + W_OB; float* X1 = P.ws + W_X1; float* H2 = P.ws + W_H2;
    for (int t = blockIdx.x * 4 + wv; t < I.T; t += gridDim.x * 4) {
        const float* x = xrow(P, I, t);
        float v[16]; float ss = 0.f;
#pragma unroll
        for (int jj = 0; jj < 16; ++jj) { v[jj] = OB[(size_t)t * D + lane + 64 * jj]; ss += v[jj] * v[jj]; }
        ss = wave_sum(ss);
        const float r = rsqrtf(ss * (1.f / D) + EPS);
        float s2 = 0.f;
#pragma unroll
        for (int jj = 0; jj < 16; ++jj) { v[jj] = x[lane + 64 * jj] + v[jj] * r * P.in[I_GPOST][lane + 64 * jj]; s2 += v[jj] * v[jj]; }
        s2 = wave_sum(s2);
        const float r2 = rsqrtf(s2 * (1.f / D) + EPS);
#pragma unroll
        for (int jj = 0; jj < 16; ++jj) { X1[(size_t)t * D + lane + 64 * jj] = v[jj]; H2[(size_t)t * D + lane + 64 * jj] = v[jj] * r2 * P.in[I_GPREF][lane + 64 * jj]; }
    }
}
__device__ __forceinline__ void st_act(const Params& P, const Item& I) {
    const float* GU = P.ws + W_GU; float* ACT = P.ws + W_ACT;
    const int n = I.T * DFF;
    for (int e = blockIdx.x * blockDim.x + threadIdx.x; e < n; e += gridDim.x * blockDim.x) {
        const int t = e / DFF, c = e % DFF;
        ACT[e] = siluf_(GU[(size_t)t * 2 * DFF + c]) * GU[(size_t)t * 2 * DFF + DFF + c];
    }
}
__device__ __forceinline__ void st_final(const Params& P, const Item& I) {
    const int lane = threadIdx.x & 63, wv = threadIdx.x >> 6;
    const float* FFO = P.ws + W_FFO; const float* X1 = P.ws + W_X1;
    for (int t = blockIdx.x * 4 + wv; t < I.T; t += gridDim.x * 4) {
        float* y;
        if (I.samp) y = P.out + OUT_YS + ((size_t)I.b * DEC_T + t) * D;
        else { if (t < NMETA) continue; y = P.out + OUT_YP + ((size_t)I.b * SEQ + (t - NMETA)) * D; }
        float v[16]; float ss = 0.f;
#pragma unroll
        for (int jj = 0; jj < 16; ++jj) { v[jj] = FFO[(size_t)t * D + lane + 64 * jj]; ss += v[jj] * v[jj]; }
        ss = wave_sum(ss);
        const float r = rsqrtf(ss * (1.f / D) + EPS);
#pragma unroll
        for (int jj = 0; jj < 16; ++jj) y[lane + 64 * jj] = X1[(size_t)t * D + lane + 64 * jj] + v[jj] * r * P.in[I_GPOSTF][lane + 64 * jj];
    }
}

constexpr int NSTAGE = 17;
template <int s> __device__ __forceinline__ void run_stage(const Params& P, const Item& I, float* sm) {
    float* ws = P.ws;
    switch (s) {
    case 0: st_norm_in(P, I); break;
    case 1: sgemm(ws + W_H, D, P.in[I_WIN], DIN, ws + W_Z, DIN, I.T, DIN, D, P.in[I_BIN], 1.f, sm); break;
    case 2: st_fox_prep(P, I); break;
    case 3: st_fcum(P, I); break;
    case 4: st_attn(P, I, sm); break;
    case 5: st_conv(P, I); break;
    case 6:
        for (int h = 0; h < MH; ++h) {
            sgemm(ws + W_XC + h * MD, MW, P.in[I_WMQ] + (size_t)h * MD * MD, MD, ws + W_MQ + h * MD, MW, I.T, MD, MD, nullptr, 1.f, sm);
            sgemm(ws + W_XC + h * MD, MW, P.in[I_WMK] + (size_t)h * MD * MD, MD, ws + W_MK + h * MD, MW, I.T, MD, MD, nullptr, 0.08838834764831845f, sm);
        }
        break;
    case 7: st_mlstm(P, I, sm); break;
    case 8: st_hm(P, I); break;
    case 9:
        sgemm(ws + W_AT, FW, P.in[I_WFOX], D, ws + W_YA, D, I.T, D, FW, nullptr, 1.f, sm);
        sgemm(ws + W_HM, MW, P.in[I_WML], D, ws + W_YB, D, I.T, D, MW, nullptr, 1.f, sm);
        break;
    case 10: st_merge(P, I); break;
    case 11: sgemm(ws + W_YA, D, P.in[I_WOUT], D, ws + W_OB, D, I.T, D, D, nullptr, 1.f, sm); break;
    case 12: st_mid(P, I); break;
    case 13: sgemm(ws + W_H2, D, P.in[I_WGU], 2 * DFF, ws + W_GU, 2 * DFF, I.T, 2 * DFF, D, nullptr, 1.f, sm); break;
    case 14: st_act(P, I); break;
    case 15: sgemm(ws + W_ACT, DFF, P.in[I_WDN], D, ws + W_FFO, D, I.T, D, DFF, nullptr, 1.f, sm); break;
    case 16: st_final(P, I); break;
    }
}

template <int s> __global__ void __launch_bounds__(256) stage_kernel(Params P) {
    __shared__ __attribute__((aligned(16))) float sm[2304];
    for (int it = P.item_lo; it < P.item_hi; ++it) { const Item I = get_item(it); run_stage<s>(P, I, sm); }
}
template <int s> struct StageLoop {
    static void launch(const Params& P, int grid, hipStream_t stream) { StageLoop<s - 1>::launch(P, grid, stream); hipLaunchKernelGGL(stage_kernel<s>, dim3(grid), dim3(256), 0, stream, P); }
    template <class H> static void launch_hook(const Params& P, int grid, hipStream_t stream, int it, H& hook) { StageLoop<s - 1>::launch_hook(P, grid, stream, it, hook); hipLaunchKernelGGL(stage_kernel<s>, dim3(grid), dim3(256), 0, stream, P); hook(it, s); }
};
template <> struct StageLoop<-1> {
    static void launch(const Params&, int, hipStream_t) {}
    template <class H> static void launch_hook(const Params&, int, hipStream_t, int, H&) {}
};
#endif

namespace pg8 {
#define PG8_LAS __attribute__((address_space(3)))
typedef unsigned short bf16_t;
typedef short bf16x8 __attribute__((ext_vector_type(8)));
typedef float f32x4 __attribute__((ext_vector_type(4)));
typedef unsigned u32x4 __attribute__((ext_vector_type(4)));
constexpr int BM = 256, BK = 64, HALF = 128, HTB = HALF * BK * 2  , STAGE_BYTES = 8 * HTB, NXCD = 8, WGM = 8;

__host__ __device__ __forceinline__ int lds_byte(int r, int c) { const int st = (r >> 4) * 2 + (c >> 5), rr = r & 15, cc = c & 31, ob = rr * 64 + cc * 2; return st * 1024 + (ob ^ (((ob >> 9) & 1) << 5)); }
__host__ __device__ __forceinline__ void stage_rc(int b, int& R, int& C) { const int st = b / 1024, sb = b % 1024, swz = sb ^ (((sb >> 9) & 1) << 5); R = (st >> 1) * 16 + swz / 64; C = (st & 1) * 32 + (swz % 64) / 2; }
__host__ __device__ __forceinline__ int perm32(int rho) { const int n = rho >> 4, i = rho & 15; return 8 * (i >> 2) + 4 * n + (i & 3); }

struct Unit { int pm, pn, rb; };
struct Gemm { const bf16_t* A; const bf16_t* Bt; int M, N, K; const bf16_t* A2 = nullptr; int lda = 0; };

struct StaticOrder {
    int nM, nN, nwg, G, c, rp, roff;
    __host__ __device__ void init(int M, int N, int G_, int c_, int rp_ = 0, int roff_ = 0) { nM = M / BM; nN = N / BM; nwg = nM * nN; G = G_; c = c_; rp = rp_; roff = roff_; }
    __host__ __device__ bool next(int i, Unit& u) const {
        const long L = (long)i * G + c; if (L >= nwg) return false;
        int wgid = (int)L; { const int q = nwg / NXCD, r = nwg % NXCD, xcd = wgid % NXCD, off = wgid / NXCD; wgid = (xcd < r ? xcd * (q + 1) : r * (q + 1) + (xcd - r) * q) + off; }
        const int nig = WGM * nN, gid = wgid / nig, fm = gid * WGM, gsz = (nM - fm) < WGM ? (nM - fm) : WGM;
        u.pm = fm + ((wgid % nig) % gsz); u.pn = (wgid % nig) / gsz; u.rb = rp ? (u.pm >> 4) * rp + roff + (u.pm & 15) * BM : u.pm * BM; return true;
    }
    __device__ __forceinline__ void a_ready(const Unit&) const {}
    __device__ __forceinline__ void done(const Unit&) const {}
};

__device__ __forceinline__ unsigned cvt_pk_bf16(float lo, float hi) { unsigned r; asm volatile("v_cvt_pk_bf16_f32 %0, %1, %2" : "=v"(r) : "v"(lo), "v"(hi)); return r; }
typedef float f32x2 __attribute__((ext_vector_type(2)));
__device__ __forceinline__ f32x2 gelu_pk(f32x2 v) {
    const f32x2 av = __builtin_elementwise_abs(v), d = av * 0.2316418882f + 1.0f;
    f32x2 t; t.x = __builtin_amdgcn_rcpf(d.x); t.y = __builtin_amdgcn_rcpf(d.y);
    f32x2 q = t * 0.5307027145f + (-0.7265760135f); q = q * t + 0.7107068705f; q = q * t + (-0.142248368f); q = q * t + 0.127414796f; q = q * t;
    const f32x2 s = (v * v) * (-0.72134752044f);
    f32x2 e; e.x = __builtin_amdgcn_exp2f(s.x); e.y = __builtin_amdgcn_exp2f(s.y);
    const f32x2 m = v * (q * e), r = v - m;
    f32x2 o; o.x = v.x < 0.f ? m.x : r.x; o.y = v.y < 0.f ? m.y : r.y; return o;
}

template <int ACT  > struct EpiBf16 {
    static constexpr bool PERM = true, AFTER_DRAIN = false, HAS_MID = false; static_assert(ACT == 0 || ACT == 1, "EpiBf16: ACT is 0 (none) or 1 (gelu_pk)");
    bf16_t* O; int ldc; const float* bias; int split_cols; size_t split_stride; float scale0;
    __device__ __forceinline__ void operator()(const f32x4 (&acc)[2][2][4][2], const Unit& u, int wr, int wc, int fr, int fq) const {
        const int row0 = u.rb + wr * 64 + fr; int colt = u.pn * BM; bf16_t* base = O;
        float sc = 1.f; if (split_cols) { const int t = colt / split_cols; base += (size_t)t * split_stride; colt -= t * split_cols; if (t == 0) sc = scale0; }
        const int col0 = colt + wc * 32 + 8 * fq, bcol0 = u.pn * BM + wc * 32 + 8 * fq;
        f32x4 bv[2][2];
#pragma unroll
        for (int bj = 0; bj < 2; ++bj)
#pragma unroll
            for (int n = 0; n < 2; ++n) bv[bj][n] = bias ? *(const f32x4*)(bias + bcol0 + bj * HALF + 4 * n) : (f32x4){0.f, 0.f, 0.f, 0.f};
#pragma unroll
        for (int ai = 0; ai < 2; ++ai)
#pragma unroll
            for (int m = 0; m < 4; ++m) { bf16_t* rowp = base + (size_t)(row0 + ai * HALF + m * 16) * ldc + col0;
#pragma unroll
                for (int bj = 0; bj < 2; ++bj) { f32x4 v0 = acc[ai][bj][m][0] + bv[bj][0], v1 = acc[ai][bj][m][1] + bv[bj][1];
                    if (ACT == 1) { f32x2 a = gelu_pk((f32x2){v0[0], v0[1]}), b = gelu_pk((f32x2){v0[2], v0[3]}), c = gelu_pk((f32x2){v1[0], v1[1]}), d = gelu_pk((f32x2){v1[2], v1[3]});
                        v0 = (f32x4){a.x, a.y, b.x, b.y}; v1 = (f32x4){c.x, c.y, d.x, d.y}; }
                    v0 = v0 * sc; v1 = v1 * sc; u32x4 w; w.x = cvt_pk_bf16(v0[0], v0[1]); w.y = cvt_pk_bf16(v0[2], v0[3]); w.z = cvt_pk_bf16(v1[0], v1[1]); w.w = cvt_pk_bf16(v1[2], v1[3]);
                    *(u32x4*)(rowp + bj * HALF) = w; } }
    }
};
template <class Epi, class Sched, bool ALIGN_EPI = false, bool SP2 = false>
__device__ __forceinline__ void gemm_phase(PG8_LAS unsigned char* lds, const Gemm g, const Sched& S, const Epi& E) {
    const int tid = threadIdx.x, wid = __builtin_amdgcn_readfirstlane(tid >> 6), lane = tid & 63, wr = wid >> 2, wc = wid & 3, fr = lane & 15, fq = lane >> 4;
    const int K = g.K, nt = K / BK, lda = g.lda ? g.lda : g.K, nth = nt / 2;
    unsigned voffA[2], voffB[2];
#pragma unroll
    for (int i = 0; i < 2; ++i) { int R, C; stage_rc(tid * 16 + i * 8192, R, C); const int Rb = Epi::PERM ? ((R & ~31) + perm32(R & 31)) : R;
        voffA[i] = (unsigned)(R * lda + C) * 2u; voffB[i] = (unsigned)(Rb * K + C) * 2u; }
    const size_t kstep = (size_t)(BK * 2);
    const size_t hstep = (size_t)HALF * K * 2;
    const size_t hstepA = (size_t)HALF * lda * 2;
    const size_t tstep = 2 * hstep;
    const unsigned ldsw = (unsigned)wid * 1024u;
    const int aoff = lds_byte(wr * 64 + fr, fq * 8), boff = lds_byte(wc * 32 + fr, fq * 8);
#define PG8_SA(b, h) (((b) * 2 + (h)) * HTB)
#define PG8_SB(b, h) ((4 + (b) * 2 + (h)) * HTB)
#define PG8_STAGE(bufoff, gbase, voff) do { _Pragma("unroll") for (int _i = 0; _i < 2; ++_i) \
        __builtin_amdgcn_global_load_lds((const unsigned*)((const char*)(gbase) + (voff)[_i]), (PG8_LAS unsigned*)(lds + (bufoff) + ldsw + _i * 8192), 16, 0, 0); } while (0)
#define PG8_LDA(dst, b, h) do { _Pragma("unroll") for (int m = 0; m < 4; ++m) _Pragma("unroll") for (int k = 0; k < 2; ++k) dst[m][k] = *(const PG8_LAS bf16x8*)(lds + PG8_SA(b, h) + aoff + m * 2048 + k * 1024); } while (0)
#define PG8_LDB(dst, b, h) do { _Pragma("unroll") for (int n = 0; n < 2; ++n) _Pragma("unroll") for (int k = 0; k < 2; ++k) dst[n][k] = *(const PG8_LAS bf16x8*)(lds + PG8_SB(b, h) + boff + n * 2048 + k * 1024); } while (0)
#define PG8_MMA(ai, bj, At, Bt) do { __builtin_amdgcn_s_setprio(1); _Pragma("unroll") for (int m = 0; m < 4; ++m) _Pragma("unroll") for (int n = 0; n < 2; ++n) _Pragma("unroll") for (int k = 0; k < 2; ++k) \
        acc[ai][bj][m][n] = __builtin_amdgcn_mfma_f32_16x16x32_bf16(Bt[n][k], At[m][k], acc[ai][bj][m][n], 0, 0, 0); __builtin_amdgcn_s_setprio(0); } while (0)
#define PG8_WAIT_V(n) asm volatile("s_waitcnt vmcnt(" #n ")" ::: "memory")
#define PG8_WAIT_L(n) asm volatile("s_waitcnt lgkmcnt(" #n ")" ::: "memory")
#define PG8_BAR __builtin_amdgcn_s_barrier()
#define PG8_SCHED __builtin_amdgcn_sched_barrier(0)
    Unit cur, nxt; int ui = 0;
    if (!S.next(0, cur)) return;
    f32x4 acc[2][2][4][2];
#pragma unroll
    for (int a = 0; a < 2; ++a)
#pragma unroll
        for (int b = 0; b < 2; ++b)
#pragma unroll
            for (int m = 0; m < 4; ++m)
#pragma unroll
                for (int n = 0; n < 2; ++n) acc[a][b][m][n] = (f32x4){0.f, 0.f, 0.f, 0.f};
    bf16x8 At[4][2], B0[2][2], B1[2][2];
    const char* cA = (const char*)g.A + (size_t)cur.rb * (size_t)lda * 2; const char* cA2 = g.A2 ? (const char*)g.A2 + (size_t)cur.rb * (size_t)lda * 2 : nullptr; const char* cB = (const char*)g.Bt + (size_t)cur.pn * tstep;
    S.a_ready(cur);
    if constexpr (SP2) {
        PG8_STAGE(PG8_SB(0, 0), cB, voffB); PG8_STAGE(PG8_SB(0, 1), cB + hstep, voffB); PG8_STAGE(PG8_SA(0, 0), cA, voffA); PG8_STAGE(PG8_SA(0, 1), cA + hstepA, voffA);
        if (wr == 1) PG8_BAR;
        PG8_WAIT_V(2); PG8_BAR;
        PG8_STAGE(PG8_SB(1, 0), cB + kstep, voffB); PG8_STAGE(PG8_SA(1, 0), cA + kstep, voffA); PG8_STAGE(PG8_SB(1, 1), cB + hstep + kstep, voffB);
        PG8_WAIT_V(6); PG8_BAR;
    } else {
        PG8_STAGE(PG8_SB(0, 0), cB, voffB); PG8_STAGE(PG8_SA(0, 0), cA, voffA); PG8_STAGE(PG8_SB(0, 1), cB + hstep, voffB); PG8_STAGE(PG8_SA(0, 1), cA + hstepA, voffA);
        if (wr == 1) PG8_BAR;
        PG8_WAIT_V(4); PG8_BAR;
        PG8_STAGE(PG8_SB(1, 0), cB + kstep, voffB); PG8_STAGE(PG8_SA(1, 0), cA + kstep, voffA); PG8_STAGE(PG8_SB(1, 1), cB + hstep + kstep, voffB);
        PG8_WAIT_V(6); PG8_BAR;
    }
    for (;;) {
        const bool has_next = S.next(ui + 1, nxt);
        const char* nA = has_next ? (const char*)g.A + (size_t)nxt.rb * (size_t)lda * 2 : cA; const char* nB = has_next ? (const char*)g.Bt + (size_t)nxt.pn * tstep : cB;
        for (int t = 0; t < nt; t += 2) {
            const bool last = (t == nt - 2);
            const char* a1 = (cA2 && t + 1 >= nth) ? cA2 + (size_t)(t + 1 - nth) * kstep : cA + (size_t)(t + 1) * kstep;
            if constexpr (Epi::HAS_MID) { if (t == nth) E.mid(acc, cur, wr, wc, fr, fq); }
            const char* a2 = last ? nA : ((cA2 && t + 2 >= nth) ? cA2 + (size_t)(t + 2 - nth) * kstep : cA + (size_t)(t + 2) * kstep); const char* b2 = last ? nB : cB + (size_t)(t + 2) * kstep;
            const char* a3 = a2 + kstep; const char* b3 = b2 + kstep;
            if (last && has_next) S.a_ready(nxt);
            if constexpr (SP2) {
            PG8_LDB(B0, 0, 0); PG8_LDB(B1, 0, 1); PG8_SCHED; PG8_LDA(At, 0, 0); PG8_STAGE(PG8_SA(1, 1), a1 + hstepA, voffA);
            PG8_WAIT_V(8); PG8_WAIT_L(0); PG8_BAR; PG8_MMA(0, 0, At, B0); PG8_MMA(0, 1, At, B1); PG8_BAR; PG8_SCHED;
            PG8_LDA(At, 0, 1); PG8_STAGE(PG8_SB(0, 0), b2, voffB); PG8_STAGE(PG8_SB(0, 1), b2 + hstep, voffB); PG8_STAGE(PG8_SA(0, 0), a2, voffA);
            PG8_WAIT_V(8); PG8_WAIT_L(0); PG8_BAR; PG8_MMA(1, 0, At, B0); PG8_MMA(1, 1, At, B1); PG8_BAR; PG8_SCHED;
            PG8_LDB(B0, 1, 0); PG8_LDB(B1, 1, 1); PG8_SCHED; PG8_LDA(At, 1, 0); PG8_STAGE(PG8_SA(0, 1), a2 + hstepA, voffA);
            PG8_WAIT_V(8); PG8_WAIT_L(0); PG8_BAR; PG8_MMA(0, 0, At, B0); PG8_MMA(0, 1, At, B1); PG8_BAR; PG8_SCHED;
            PG8_LDA(At, 1, 1); PG8_STAGE(PG8_SB(1, 0), b3, voffB); PG8_STAGE(PG8_SB(1, 1), b3 + hstep, voffB); PG8_STAGE(PG8_SA(1, 0), a3, voffA);
            PG8_WAIT_V(8); PG8_WAIT_L(0); PG8_BAR; PG8_MMA(1, 0, At, B0); PG8_MMA(1, 1, At, B1); PG8_BAR; PG8_SCHED;
            } else {
            PG8_LDB(B0, 0, 0); PG8_SCHED; PG8_LDA(At, 0, 0); PG8_STAGE(PG8_SA(1, 1), a1 + hstepA, voffA);
            PG8_WAIT_L(8); PG8_BAR; PG8_WAIT_L(0); PG8_MMA(0, 0, At, B0); PG8_BAR; PG8_SCHED;
            PG8_LDB(B1, 0, 1); PG8_STAGE(PG8_SB(0, 0), b2, voffB);
            PG8_BAR; PG8_WAIT_L(0); PG8_MMA(0, 1, At, B1); PG8_BAR;
            PG8_LDA(At, 0, 1); PG8_STAGE(PG8_SA(0, 0), a2, voffA);
            PG8_BAR; PG8_WAIT_L(0); PG8_MMA(1, 0, At, B0); PG8_BAR; PG8_SCHED;
            PG8_STAGE(PG8_SB(0, 1), b2 + hstep, voffB);
            PG8_WAIT_V(6); PG8_BAR; PG8_MMA(1, 1, At, B1); PG8_BAR;
            PG8_LDB(B0, 1, 0); PG8_SCHED; PG8_LDA(At, 1, 0); PG8_STAGE(PG8_SA(0, 1), a2 + hstepA, voffA);
            PG8_WAIT_L(8); PG8_BAR; PG8_WAIT_L(0); PG8_MMA(0, 0, At, B0); PG8_BAR; PG8_SCHED;
            PG8_LDB(B1, 1, 1); PG8_STAGE(PG8_SB(1, 0), b3, voffB);
            PG8_BAR; PG8_WAIT_L(0); PG8_MMA(0, 1, At, B1); PG8_BAR;
            PG8_LDA(At, 1, 1); PG8_STAGE(PG8_SA(1, 0), a3, voffA);
            PG8_BAR; PG8_WAIT_L(0); PG8_MMA(1, 0, At, B0); PG8_BAR; PG8_SCHED;
            PG8_STAGE(PG8_SB(1, 1), b3 + hstep, voffB);
            PG8_WAIT_V(6); PG8_BAR; PG8_MMA(1, 1, At, B1); PG8_BAR;
            }
        }
        if constexpr (ALIGN_EPI) { if (wr == 0) PG8_BAR; }
        if constexpr (!Epi::AFTER_DRAIN) { E(acc, cur, wr, wc, fr, fq); S.done(cur); }
        if (!has_next) break;
#pragma unroll
        for (int a = 0; a < 2; ++a)
#pragma unroll
            for (int b = 0; b < 2; ++b)
#pragma unroll
                for (int m = 0; m < 4; ++m)
#pragma unroll
                    for (int n = 0; n < 2; ++n) acc[a][b][m][n] = (f32x4){0.f, 0.f, 0.f, 0.f};
        cur = nxt; cA = nA; cB = nB; ++ui; if (g.A2) cA2 = (const char*)g.A2 + (size_t)cur.rb * (size_t)lda * 2;
        if constexpr (ALIGN_EPI) { if (wr == 1) PG8_BAR; }
    }
    PG8_WAIT_V(0);
    if constexpr (!ALIGN_EPI) { if (wr == 0) PG8_BAR; }
    PG8_BAR;
    if constexpr (Epi::AFTER_DRAIN) { E.fused(acc, cur, wr, wc, fr, fq, lds, wid, lane); S.done(cur); }
#undef PG8_SA
#undef PG8_SB
#undef PG8_STAGE
#undef PG8_LDA
#undef PG8_LDB
#undef PG8_MMA
#undef PG8_WAIT_V
#undef PG8_WAIT_L
#undef PG8_BAR
#undef PG8_SCHED
}
}

#ifndef FAST_NPB
#define FAST_NPB 8
#endif
#define LAS __attribute__((address_space(3)))
#define GAS __attribute__((address_space(1)))
namespace fk {
using pg8::bf16_t;
typedef unsigned v4u __attribute__((ext_vector_type(4)));
typedef unsigned v2u __attribute__((ext_vector_type(2)));
typedef float f32x4 __attribute__((ext_vector_type(4)));
typedef float f32x16 __attribute__((ext_vector_type(16)));
typedef short bf16x8 __attribute__((ext_vector_type(8)));
typedef short s16x4 __attribute__((ext_vector_type(4)));
constexpr int NPB = FAST_NPB;
constexpr int RP = 4160, PADF = 48, NCH = RP / 64;
constexpr int SROW0 = NPB * RP;
constexpr int MREAL = SROW0 + NB * DEC_T;
constexpr int M = (MREAL + 255) / 256 * 256;
constexpr size_t SE = (size_t)M * 512;
constexpr size_t SB = SE * 2;
constexpr int NZ = 5376;
constexpr size_t MiB = 1u << 20;
constexpr size_t alignM(size_t x) { return (x + MiB - 1) / MiB * MiB; }
constexpr size_t WS_CTL = 0, CTL_ZERO_BYTES = 1 * MiB;
constexpr size_t WS_WIN = 1 * MiB, WS_WGU = 12 * MiB, WS_WDN = 23 * MiB, WS_WOUT = 29 * MiB, WS_WFOX = 31 * MiB, WS_WML = 32 * MiB, WS_WMQ = 33 * MiB, WS_WMK = 33 * MiB + 131072, WS_BIAS = 34 * MiB;
constexpr size_t WS_A = 35 * MiB;
constexpr size_t WS_Z = WS_A + alignM(2 * SB);
constexpr int ZQ = 0, ZK = 1, ZV = 2, ZMX = 3, ZMV = 4, ZMO = 5, ZGA = 6, ZGB = 8, ZGT = 10;
constexpr size_t WS_MISC = alignM(WS_Z + 11 * SB);
constexpr int NBPL = 4416;
constexpr int NBSL = 1280;
constexpr int NITEM_L = (NPB * NCH + NB) * MH;
constexpr size_t MS_NBP = 0;
constexpr size_t MS_NBS = MS_NBP + (size_t)NPB * FH * NBPL * 4;
constexpr size_t MS_BT = MS_NBS + (size_t)NB * FH * NBSL * 4;
constexpr size_t MS_IGT = MS_BT + (size_t)M * MH * 4;
constexpr size_t MS_CHS = MS_IGT + (size_t)M * MH * 4;
constexpr size_t MS_NL = MS_CHS + (size_t)NITEM_L * 2 * 4;
constexpr size_t MS_JST = MS_NL + (size_t)NITEM_L * MD * 4;
constexpr int TOTP_L = 80, TOTS_L = 32;
constexpr size_t MS_TOTS = MS_JST + (size_t)NPB * FH * TOTP_L * 4;
constexpr size_t MS_TH2 = MS_TOTS + (size_t)NB * FH * TOTS_L * 4;
constexpr size_t MS_MC = MS_TH2 + 64;
constexpr size_t MS_END = MS_MC + (size_t)NITEM_L * 4;
constexpr size_t WS_KS = alignM(WS_MISC + MS_END);
constexpr size_t WS_VS = WS_KS + (size_t)NB * NBSL * FW * 2;
constexpr size_t WS_SCR = alignM(WS_VS + (size_t)NB * NBSL * FW * 2);
constexpr size_t SCR_BYTES = 3 * SB + 4096;
#if FAST_NPB == 8
constexpr size_t WS_FASTEND = WS_SCR;
static_assert(SCR_BYTES <= (size_t)NB * SEQ * D * 4, "scratch fits y_prompt");
#else
constexpr size_t WS_FASTEND = alignM(WS_SCR + SCR_BYTES + 2 * (size_t)M * D * 4);
#endif
constexpr int CW_TMO = 0, CW_BAR = 4096, CW_QUE = 16384;

struct FP { const float* in[29]; float* out; unsigned char* ws; unsigned char* scr; int ph_lo, ph_hi; };

#define LDS_WAIT() asm volatile("s_waitcnt lgkmcnt(0)" ::: "memory")
#define VM_WAIT() asm volatile("s_waitcnt vmcnt(0)" ::: "memory")
__device__ __forceinline__ unsigned f2bf(float f) { unsigned u = __builtin_bit_cast(unsigned, f); return (u + 0x7fffu + ((u >> 16) & 1u)) >> 16; }
__device__ __forceinline__ unsigned pk2(float lo, float hi) { return f2bf(lo) | (f2bf(hi) << 16); }
__device__ __forceinline__ float bf2f(unsigned short b) { return __builtin_bit_cast(float, (unsigned)b << 16); }
__device__ __forceinline__ float bflo(unsigned w) { return __builtin_bit_cast(float, w << 16); }
__device__ __forceinline__ float bfhi(unsigned w) { return __builtin_bit_cast(float, w & 0xffff0000u); }

__host__ __device__ __forceinline__ int fox_perm(int c) { const int blk = c >> 9, h = (c >> 6) & 7, d = c & 63; return blk * 512 + (h >> 2) * 256 + (d >> 5) * 128 + (h & 3) * 32 + (d & 31); }
template <bool FOXPERM = false>
__device__ __forceinline__ void tr_item(const float* W, int K, int N, int col0, int ncols, bf16_t* WT, int row_off, LAS float* scr, int item, int lane, int pitch = 0) {
    const int nblk = ncols / 32, kb = item / nblk, nb = item % nblk, k0 = 64 * kb, n0 = 32 * nb; if (!pitch) pitch = K;
    const int d0 = FOXPERM ? fox_perm(n0) : n0;
#pragma unroll 8
    for (int i = 0; i < 32; ++i) { const int kk = 2 * i + (lane >> 5); scr[kk * 33 + (lane & 31)] = W[(size_t)(k0 + kk) * N + col0 + n0 + (lane & 31)]; }
    LDS_WAIT(); asm volatile("" ::: "memory");
    const int c = lane & 7;
#pragma unroll
    for (int j = 0; j < 4; ++j) { const int n = (lane >> 3) + 8 * j; const LAS float* s = scr + (8 * c) * 33 + n;
        v4u o; o.x = pk2(s[0 * 33], s[1 * 33]); o.y = pk2(s[2 * 33], s[3 * 33]); o.z = pk2(s[4 * 33], s[5 * 33]); o.w = pk2(s[6 * 33], s[7 * 33]);
        *(v4u*)(WT + (size_t)(row_off + d0 + n) * pitch + k0 + 8 * c) = o; }
    LDS_WAIT(); asm volatile("" ::: "memory");
}
__device__ __forceinline__ const float* fast_xrow(const FP& P, int r) {
    if (r < SROW0) { const int b = r / RP, p = r % RP; if (p < PADF) return nullptr; const int t = p - PADF;
        return t < NMETA ? P.in[I_META] + (size_t)t * D : P.in[I_XP] + ((size_t)b * SEQ + (t - NMETA)) * D; }
    if (r < MREAL) return P.in[I_XS] + (size_t)(r - SROW0) * D;
    return nullptr;
}
__device__ __forceinline__ void p0_prologue(const FP& P, LAS unsigned char* lds) {
    const int tid = threadIdx.x, lane = tid & 63, wave = tid >> 6;
    const int gw = blockIdx.x * 8 + wave, NGW = gridDim.x * 8;
    unsigned char* ws = P.ws;
    bf16_t* Win_t = (bf16_t*)(ws + WS_WIN); bf16_t* Wgu_t = (bf16_t*)(ws + WS_WGU); bf16_t* Wdn_t = (bf16_t*)(ws + WS_WDN); bf16_t* Wout_t = (bf16_t*)(ws + WS_WOUT);
    bf16_t* Wfox_t = (bf16_t*)(ws + WS_WFOX); bf16_t* Wml_t = (bf16_t*)(ws + WS_WML); bf16_t* Wmq_t = (bf16_t*)(ws + WS_WMQ); bf16_t* Wmk_t = (bf16_t*)(ws + WS_WMK);
    LAS float* scr = (LAS float*)(lds + wave * 16384);
    constexpr int I_IN = 16 * (5120 / 32), I_GU = 44 * 64, I_DN = 44 * 32, I_OUT = 16 * 32, I_FOX = 8 * 32, I_MQ = 4 * 8;
    constexpr int NITEMS = I_IN + I_GU + I_DN + I_OUT + 2 * I_FOX + 2 * I_MQ;
    for (int it = gw; it < NITEMS; it += NGW) {
        int r = it;
        if (r < I_IN) {
            if (r < 768) { tr_item<true>(P.in[I_WIN], D, DIN, 0, 1536, Win_t, 0, scr, r, lane); continue; } r -= 768;
            if (r < 256) { tr_item(P.in[I_WIN], D, DIN, O_MX, 512, Win_t, 1536, scr, r, lane); continue; } r -= 256;
            if (r < 256) { tr_item(P.in[I_WIN], D, DIN, O_MV, 512, Win_t, 2048, scr, r, lane); continue; } r -= 256;
            if (r < 256) { tr_item(P.in[I_WIN], D, DIN, O_MO, 512, Win_t, 2560, scr, r, lane); continue; } r -= 256;
            if (r < 512) { tr_item(P.in[I_WIN], D, DIN, O_GA, 1024, Win_t, 3072, scr, r, lane); continue; } r -= 512;
            tr_item(P.in[I_WIN], D, DIN, O_GB, 1024, Win_t, 4096, scr, r, lane); continue;
        }
        r -= I_IN;
        if (r < I_GU) { const int sg = r / 64, j = sg >> 1, u = sg & 1; tr_item(P.in[I_WGU], D, 2 * DFF, u * DFF + 128 * j, 128, Wgu_t, 256 * j + 128 * u, scr, r % 64, lane); continue; }
        r -= I_GU;
        if (r < I_DN) { tr_item(P.in[I_WDN], DFF, D, 0, D, Wdn_t, 0, scr, r, lane); continue; } r -= I_DN;
        if (r < I_OUT) { tr_item(P.in[I_WOUT], D, D, 0, D, Wout_t, 0, scr, r, lane); continue; } r -= I_OUT;
        if (r < I_FOX) { tr_item(P.in[I_WFOX], FW, D, 0, D, Wfox_t, 0, scr, r, lane, 2 * FW); continue; } r -= I_FOX;
        if (r < I_FOX) { tr_item(P.in[I_WML], MW, D, 0, D, Wfox_t + FW, 0, scr, r, lane, 2 * FW); continue; } r -= I_FOX;
        if (r < I_MQ) { const int h = r / 8; tr_item(P.in[I_WMQ] + (size_t)h * MD * MD, MD, MD, 0, MD, Wmq_t + (size_t)h * MD * MD, 0, scr, r % 8, lane); continue; } r -= I_MQ;
        { const int h = r / 8; tr_item(P.in[I_WMK] + (size_t)h * MD * MD, MD, MD, 0, MD, Wmk_t + (size_t)h * MD * MD, 0, scr, r % 8, lane); }
    }
    {
        const int gt = blockIdx.x * 512 + tid, NT = gridDim.x * 512;
        for (int e = gt; e < 256 * D; e += NT) {
            const int g = e / D, k = e % D;
            float v = 0.f;
            if (g < 16) { const int oc = g < 8 ? O_FF + g : (g < 12 ? O_MI + (g - 8) : O_MF + (g - 12)); v = P.in[I_WIN][(size_t)k * DIN + oc]; }
            Win_t[(size_t)(5120 + g) * D + k] = (bf16_t)f2bf(v);
        }
        float* bias_p = (float*)(ws + WS_BIAS);
        for (int n = gt; n < NZ; n += NT) {
            int oc = -1;
            if (n < 1536) { const int blk = n >> 9, pn = (n >> 8) & 1, bj = (n >> 7) & 1, wcc = (n >> 5) & 3, i5 = n & 31; oc = blk * 512 + (4 * pn + wcc) * 64 + 32 * bj + i5; } else if (n < 2048) oc = O_MX + (n - 1536); else if (n < 2560) oc = O_MV + (n - 2048); else if (n < 3072) oc = O_MO + (n - 2560);
            else if (n < 4096) oc = O_GA + (n - 3072); else if (n < 5120) oc = O_GB + (n - 4096); else if (n < 5128) oc = O_FF + (n - 5120); else if (n < 5132) oc = O_MI + (n - 5128); else if (n < 5136) oc = O_MF + (n - 5132);
            bias_p[n] = oc >= 0 ? P.in[I_BIN][oc] : 0.f;
        }
        bf16_t* KS = (bf16_t*)(ws + WS_KS); bf16_t* VS = (bf16_t*)(ws + WS_VS);
        for (int e = gt; e < NB * NBSL * (FW / 4); e += NT) {
            const int c4 = e % (FW / 4), i = (e / (FW / 4)) % NBSL, b = e / ((FW / 4) * NBSL);
            if (i >= PAST && i < PAST + DEC_T) continue;
            float4 kv = make_float4(0.f, 0.f, 0.f, 0.f), vv = kv;
            if (i < PAST) { kv = *(const float4*)(P.in[I_CK] + ((size_t)b * PAST + i) * FW + c4 * 4); vv = *(const float4*)(P.in[I_CV] + ((size_t)b * PAST + i) * FW + c4 * 4); }
            v2u ko, vo; ko.x = pk2(kv.x, kv.y); ko.y = pk2(kv.z, kv.w); vo.x = pk2(vv.x, vv.y); vo.y = pk2(vv.z, vv.w);
            *(v2u*)(KS + ((size_t)b * NBSL + i) * FW + c4 * 4) = ko; *(v2u*)(VS + ((size_t)b * NBSL + i) * FW + c4 * 4) = vo;
        }
    }
    bf16_t* A = (bf16_t*)(ws + WS_A);
    for (int r0 = gw; r0 < M; r0 += 2 * NGW) {
        const float* x[2]; int rr[2]; bool inr[2];
#pragma unroll
        for (int q = 0; q < 2; ++q) { rr[q] = r0 + q * NGW; inr[q] = rr[q] < M; x[q] = inr[q] ? fast_xrow(P, rr[q]) : nullptr; }
        f32x4 v[2][4]; float s[2] = {0.f, 0.f};
#pragma unroll
        for (int q = 0; q < 2; ++q) { const f32x4* xr = (const f32x4*)(x[q] ? x[q] : P.in[I_XS]) + lane;
#pragma unroll
            for (int j = 0; j < 4; ++j) { v[q][j] = xr[64 * j]; s[q] += (v[q][j].x * v[q][j].x + v[q][j].y * v[q][j].y) + (v[q][j].z * v[q][j].z + v[q][j].w * v[q][j].w); } }
        float rs[2];
#pragma unroll
        for (int q = 0; q < 2; ++q) rs[q] = rsqrtf(wave_sum(s[q]) * (1.f / D) + EPS);
#pragma unroll
        for (int j = 0; j < 4; ++j) { const f32x4 g = *((const f32x4*)P.in[I_GPRE] + lane + 64 * j);
#pragma unroll
            for (int q = 0; q < 2; ++q) if (inr[q]) { unsigned long long* o8 = (unsigned long long*)(A + (size_t)rr[q] * D) + lane;
                const f32x4 w = v[q][j] * rs[q] * g; o8[64 * j] = x[q] ? ((unsigned long long)pk2(w.x, w.y) | ((unsigned long long)pk2(w.z, w.w) << 32)) : 0ull; } }
    }
}
}
namespace fk {
constexpr float LOG2E = 1.4426950408889634f;
constexpr float C2Q = 0.125f * LOG2E;
constexpr float NEGBIG = -1e30f;
constexpr float SKIP_THR = 32.f;

__device__ __forceinline__ float wave_scan_add(float v, int lane) {
#pragma unroll
    for (int o = 1; o < 64; o <<= 1) { const float u = __shfl_up(v, o); if (lane >= o) v += u; }
    return v;
}
__device__ __forceinline__ float wave_scan_max(float v, int lane) {
#pragma unroll
    for (int o = 1; o < 64; o <<= 1) { const float u = __shfl_up(v, o); if (lane >= o) v = fmaxf(v, u); }
    return v;
}
__device__ __forceinline__ float fexp(float x) { return __builtin_amdgcn_exp2f(x * LOG2E); }
__device__ __forceinline__ float fsig(float x) { return __builtin_amdgcn_rcpf(1.f + __builtin_amdgcn_exp2f(-LOG2E * x)); }
__device__ __forceinline__ f32x4 mfma16(bf16x8 a, bf16x8 b, f32x4 c) { return __builtin_amdgcn_mfma_f32_16x16x32_bf16(a, b, c, 0, 0, 0); }

struct ZB {
    bf16_t* z;
    __device__ __forceinline__ bf16_t* buf(int i) const { return z + (size_t)i * SE; }
};


struct EpiIn {
    static constexpr bool PERM = true, AFTER_DRAIN = false, HAS_MID = false;
    bf16_t* Z; const float* bias; const float* gq; const float* gk; float* out; bf16_t* KS; bf16_t* VS;
    __device__ __forceinline__ void operator()(const pg8::f32x4 (&acc)[2][2][4][2], const pg8::Unit& u, int wr, int wc, int fr, int fq) const {
        using pg8::cvt_pk_bf16;
        const int row0 = u.rb + wr * 64 + fr;
        const int bcol0 = u.pn * 256 + wc * 32 + 8 * fq;
        f32x4 bv[2][2];
#pragma unroll
        for (int bj = 0; bj < 2; ++bj)
#pragma unroll
            for (int n = 0; n < 2; ++n) bv[bj][n] = *(const f32x4*)(bias + bcol0 + bj * 128 + 4 * n);
        if (u.pn >= 10 && u.pn < 20) {
            const bool iso = u.pn < 12, isb = u.pn >= 16; unsigned char* g8 = (unsigned char*)(Z + (size_t)(iso ? ZMO : (isb ? ZGB : ZGA)) * SE);
            const int gp = iso ? 512 : 1024;
            const int c0 = (u.pn - (iso ? 10 : (isb ? 16 : 12))) * 256 + wc * 32 + 8 * fq; const float lo = isb ? 1.f : 0.f;
#pragma unroll
            for (int ai = 0; ai < 2; ++ai)
#pragma unroll
                for (int m = 0; m < 4; ++m) { unsigned char* rowp = g8 + (size_t)(row0 + ai * 128 + m * 16) * gp + c0;
#pragma unroll
                    for (int bj = 0; bj < 2; ++bj) { const f32x4 v0 = acc[ai][bj][m][0] + bv[bj][0], v1 = acc[ai][bj][m][1] + bv[bj][1];
                        unsigned q[8];
#pragma unroll
                        for (int i = 0; i < 4; ++i) { q[i] = (unsigned)fmaxf(lo, __builtin_rintf(255.f * fsig(v0[i]))); q[4 + i] = (unsigned)fmaxf(lo, __builtin_rintf(255.f * fsig(v1[i]))); }
                        v2u w; w.x = q[0] | (q[1] << 8) | (q[2] << 16) | (q[3] << 24); w.y = q[4] | (q[5] << 8) | (q[6] << 16) | (q[7] << 24);
                        *(v2u*)(rowp + bj * 128) = w; } }
            return;
        }
        if (u.pn >= 6) {
            const int t = (u.pn * 256) / 512, col0 = u.pn * 256 - t * 512 + wc * 32 + 8 * fq; bf16_t* base = Z + (size_t)t * SE;
#pragma unroll
            for (int ai = 0; ai < 2; ++ai)
#pragma unroll
                for (int m = 0; m < 4; ++m) { bf16_t* rowp = base + (size_t)(row0 + ai * 128 + m * 16) * 512 + col0;
#pragma unroll
                    for (int bj = 0; bj < 2; ++bj) { const f32x4 v0 = acc[ai][bj][m][0] + bv[bj][0], v1 = acc[ai][bj][m][1] + bv[bj][1];
                        v4u w; w.x = cvt_pk_bf16(v0[0], v0[1]); w.y = cvt_pk_bf16(v0[2], v0[3]); w.z = cvt_pk_bf16(v1[0], v1[1]); w.w = cvt_pk_bf16(v1[2], v1[3]);
                        *(v4u*)(rowp + bj * 128) = w; } }
            return;
        }
        const int kind = u.pn >> 1, h = 4 * (u.pn & 1) + wc, cb = h * 64 + 8 * fq;
        f32x4 gv[2][2];
#pragma unroll
        for (int bj = 0; bj < 2; ++bj)
#pragma unroll
            for (int n = 0; n < 2; ++n) gv[bj][n] = kind == 2 ? (f32x4){1.f, 1.f, 1.f, 1.f} : *(const f32x4*)((kind == 0 ? gq : gk) + cb + 32 * bj + 4 * n);
#pragma unroll
        for (int ai = 0; ai < 2; ++ai)
#pragma unroll
            for (int m = 0; m < 4; ++m) {
                const int row = row0 + ai * 128 + m * 16;
                f32x4 v[2][2]; float ss = 0.f;
#pragma unroll
                for (int bj = 0; bj < 2; ++bj)
#pragma unroll
                    for (int n = 0; n < 2; ++n) { v[bj][n] = acc[ai][bj][m][n] + bv[bj][n]; ss += (v[bj][n][0] * v[bj][n][0] + v[bj][n][1] * v[bj][n][1]) + (v[bj][n][2] * v[bj][n][2] + v[bj][n][3] * v[bj][n][3]); }
                if (kind < 2) {
                    ss += __shfl_xor(ss, 16); ss += __shfl_xor(ss, 32);
                    const float rn = rsqrtf(ss * (1.f / FD) + EPS) * (kind == 0 ? C2Q : 1.f);
#pragma unroll
                    for (int bj = 0; bj < 2; ++bj)
#pragma unroll
                        for (int n = 0; n < 2; ++n) v[bj][n] = v[bj][n] * rn * gv[bj][n];
                }
                float* of = nullptr; bf16_t* sb = nullptr;
                if (kind >= 1) {
                    if (row < SROW0) { const int b = row / RP, p = row - b * RP; if (p >= PADF) of = out + (kind == 1 ? OUT_FKP : OUT_FVP) + ((size_t)b * LP + (p - PADF)) * FW + cb; }
                    else if (row < MREAL) { const int rs = row - SROW0, b = rs / DEC_T, t = rs - b * DEC_T; of = out + (kind == 1 ? OUT_FKS : OUT_FVS) + (size_t)rs * FW + cb;
                        sb = (kind == 1 ? KS : VS) + ((size_t)b * NBSL + PAST + t) * FW + cb; }
                }
                bf16_t* zd = Z + (size_t)kind * SE + (size_t)row * 512 + cb;
#pragma unroll
                for (int bj = 0; bj < 2; ++bj) {
                    v4u w; w.x = cvt_pk_bf16(v[bj][0][0], v[bj][0][1]); w.y = cvt_pk_bf16(v[bj][0][2], v[bj][0][3]); w.z = cvt_pk_bf16(v[bj][1][0], v[bj][1][1]); w.w = cvt_pk_bf16(v[bj][1][2], v[bj][1][3]);
                    *(v4u*)(zd + 32 * bj) = w;
                    if (sb) *(v4u*)(sb + 32 * bj) = w;
                    if (of) { *(f32x4*)(of + 32 * bj) = v[bj][0]; *(f32x4*)(of + 32 * bj + 4) = v[bj][1]; }
                }
            }
    }
};

constexpr int NFT_P = NPB * FH * NCH, NFT = NFT_P + NB * FH * 17;
__device__ __forceinline__ void p2_flocal(const FP& P, int task, int lane) {
    unsigned char* ws = P.ws;
    const bf16_t* GT = (const bf16_t*)(ws + WS_Z) + (size_t)ZGT * SE;
    float* TOTP = (float*)(ws + WS_MISC + MS_JST); float* TOTS = (float*)(ws + WS_MISC + MS_TOTS);
    if (task == 0) {
        float gq = 0.f, gk = 0.f;
#pragma unroll
        for (int j = 0; j < 8; ++j) { gq = fmaxf(gq, fabsf(P.in[I_GFQ][lane + 64 * j])); gk = fmaxf(gk, fabsf(P.in[I_GFK][lane + 64 * j])); }
        gq = wave_max(gq); gk = wave_max(gk);
        if (lane == 0) *(float*)(ws + WS_MISC + MS_TH2) = SKIP_THR + 2.f * C2Q * 64.f * gq * gk + 6.f;
    }
    if (task < NFT_P) {
        const int sq = task / NCH, c = task % NCH, b = sq / FH, fh = sq % FH;
        float* NBP = (float*)(ws + WS_MISC + MS_NBP) + (size_t)sq * NBPL;
        const int p = 64 * c + lane; const size_t row = (size_t)b * RP + p; const bool pad = p < PADF;
        const float lf = pad ? 0.f : logsigmoidf_(bf2f(GT[row * 512 + fh]));
        const float Fv = wave_scan_add(lf, lane);
        NBP[p] = pad ? NEGBIG : -Fv * LOG2E;
        if (!pad) P.out[OUT_LFP + ((size_t)b * LP + (p - PADF)) * FH + fh] = lf;
        if (lane == 63) TOTP[sq * TOTP_L + c] = -Fv * LOG2E;
        if (c == NCH - 1) for (int q = RP + lane; q < NBPL; q += 64) NBP[q] = NEGBIG;
    } else {
        const int t2 = task - NFT_P, s2 = t2 / 17, c = t2 % 17, b = s2 / FH, fh = s2 % FH;
        float* NBS = (float*)(ws + WS_MISC + MS_NBS) + (size_t)s2 * NBSL;
        float lf;
        if (c < 16) lf = P.in[I_CLF][((size_t)b * PAST + 64 * c + lane) * FH + fh];
        else { lf = logsigmoidf_(bf2f(GT[((size_t)SROW0 + b * DEC_T + lane) * 512 + fh])); P.out[OUT_LFS + ((size_t)b * DEC_T + lane) * FH + fh] = lf; }
        const float Fv = wave_scan_add(lf, lane);
        NBS[64 * c + lane] = -Fv * LOG2E;
        if (lane == 63) TOTS[s2 * TOTS_L + c] = -Fv * LOG2E;
        if (c == 16) for (int q = PAST + DEC_T + lane; q < NBSL; q += 64) NBS[q] = NEGBIG;
    }
}

constexpr int XS_P = 136, KT_P = 72;
constexpr int L2_XS = 0, L2_KT = L2_XS + 64 * XS_P * 2, L2_VT = L2_KT + 128 * KT_P * 2, L2_WK = L2_VT + 128 * KT_P * 2, L2_CW = L2_WK + 256, L2_END = L2_CW + 640 * 4;
struct ChunkId { int b, c, row0; bool samp; };
__device__ __forceinline__ ChunkId chunk_of(int ci) { ChunkId k; k.samp = ci >= NPB * NCH; if (!k.samp) { k.b = ci / NCH; k.c = ci % NCH; k.row0 = k.b * RP + 64 * k.c; } else { k.b = ci - NPB * NCH; k.c = 0; k.row0 = SROW0 + 64 * k.b; } return k; }

__device__ __forceinline__ void p2_load(const FP& P, int item, int tid, v4u (&mx)[4][2], v4u (&mv)[2], float& g_mi, float& g_mf) {
    const bf16_t* Z = (const bf16_t*)(P.ws + WS_Z);
    const bf16_t* ZMXp = Z + (size_t)ZMX * SE; const bf16_t* ZMVp = Z + (size_t)ZMV * SE; const bf16_t* GT = Z + (size_t)ZGT * SE;
    const int ci = item >> 2, mh = item & 3; const ChunkId ck = chunk_of(ci);
    const int t = tid >> 3, col = mh * MD + (tid & 7) * 16; const size_t row = (size_t)ck.row0 + t;
#pragma unroll
    for (int i = 0; i < 4; ++i) {
        const int pu = 64 * ck.c + t + i - 3 - (ck.samp ? 0 : PADF);
        if (pu >= 0) { mx[i][0] = *(const v4u*)(ZMXp + (row + i - 3) * 512 + col); mx[i][1] = *(const v4u*)(ZMXp + (row + i - 3) * 512 + col + 8); }
        else { mx[i][0] = (v4u){0u, 0u, 0u, 0u}; mx[i][1] = mx[i][0]; }
    }
    mv[0] = *(const v4u*)(ZMVp + row * 512 + col); mv[1] = *(const v4u*)(ZMVp + row * 512 + col + 8);
    if (tid < 64) { g_mi = bf2f(GT[((size_t)ck.row0 + tid) * 512 + 8 + mh]); g_mf = bf2f(GT[((size_t)ck.row0 + tid) * 512 + 12 + mh]); }
}
__device__ __forceinline__ void unpack16(const v4u a, const v4u b, float (&s)[16]) {
    s[0] = bflo(a.x); s[1] = bfhi(a.x); s[2] = bflo(a.y); s[3] = bfhi(a.y); s[4] = bflo(a.z); s[5] = bfhi(a.z); s[6] = bflo(a.w); s[7] = bfhi(a.w);
    s[8] = bflo(b.x); s[9] = bfhi(b.x); s[10] = bflo(b.y); s[11] = bfhi(b.y); s[12] = bflo(b.z); s[13] = bfhi(b.z); s[14] = bflo(b.w); s[15] = bfhi(b.w);
}
__device__ __forceinline__ void p2_phase(const FP& P, LAS unsigned char* lds) {
    const int tid = threadIdx.x, lane = tid & 63, wave = __builtin_amdgcn_readfirstlane(tid >> 6), fr = lane & 15, fq = lane >> 4;
    unsigned char* ws = P.ws;
    bf16_t* XC = (bf16_t*)(ws + WS_A); bf16_t* KVL = (bf16_t*)P.scr;
    float* BT = (float*)(ws + WS_MISC + MS_BT); float* IGT = (float*)(ws + WS_MISC + MS_IGT); float* CHS = (float*)(ws + WS_MISC + MS_CHS); float* NL = (float*)(ws + WS_MISC + MS_NL);
    LAS bf16_t* Xs = (LAS bf16_t*)(lds + L2_XS); LAS bf16_t* kTw = (LAS bf16_t*)(lds + L2_KT); LAS bf16_t* vT = (LAS bf16_t*)(lds + L2_VT); LAS float* wk = (LAS float*)(lds + L2_WK);
    v4u mx[4][2], mv[2]; float g_mi = 0.f, g_mf = 0.f;
    int item = blockIdx.x;
    if (item < NITEM_L) p2_load(P, item, tid, mx, mv, g_mi, g_mf);
    bf16x8 bk[4]; int mh_loaded = -1, cw_mh = -1;
    LAS float* CWs = (LAS float*)(lds + L2_CW);
    for (; item < NITEM_L; item += gridDim.x) {
        const int ci = item >> 2, mh = item & 3; const ChunkId ck = chunk_of(ci);
        const int npad = (!ck.samp && ck.c == 0) ? PADF : 0;
        __syncthreads();
        if (mh != cw_mh) {
            for (int e = tid; e < 640; e += 512) CWs[e] = e < 512 ? P.in[I_WCONV][(e >> 7) * MW + mh * MD + (e & 127)] : P.in[I_BCONV][mh * MD + e - 512];
            cw_mh = mh; __syncthreads();
        }
        if (wave == 0) {
            const size_t row = (size_t)ck.row0 + lane; const bool pad = lane < npad;
            const float lf = pad ? 0.f : logsigmoidf_(g_mf), ig = pad ? NEGBIG : g_mi;
            const float bt = wave_scan_add(lf, lane), bL = __shfl(bt, 63);
            const float g = bL - bt + ig, mloc = wave_max(g);
            wk[lane] = fexp(g - mloc);
            BT[row * MH + mh] = bt; IGT[row * MH + mh] = ig;
            if (lane == 0) { CHS[(size_t)item * 2] = bL; CHS[(size_t)item * 2 + 1] = mloc; }
        }
        {
            const int t = tid >> 3, cg = (tid & 7) * 16, col = mh * MD + cg; const size_t row = (size_t)ck.row0 + t;
            float acc[16];
            { const LAS f32x4* bcp = (const LAS f32x4*)(CWs + 512 + cg);
#pragma unroll
              for (int j = 0; j < 4; ++j) { const f32x4 bb = bcp[j]; acc[4 * j] = bb[0]; acc[4 * j + 1] = bb[1]; acc[4 * j + 2] = bb[2]; acc[4 * j + 3] = bb[3]; } }
#pragma unroll
            for (int i = 0; i < 4; ++i) {
                float s[16]; unpack16(mx[i][0], mx[i][1], s);
                if (ck.samp) { const int pu = t + i - 3; if (pu < 0) { const float* pv = P.in[I_SCV] + ((size_t)ck.b * 3 + (pu + 3)) * MW + col;
#pragma unroll
                    for (int j = 0; j < 16; ++j) s[j] = pv[j]; } }
                const LAS f32x4* wcp = (const LAS f32x4*)(CWs + i * 128 + cg);
#pragma unroll
                for (int j = 0; j < 4; ++j) { const f32x4 ww = wcp[j]; acc[4 * j] += ww[0] * s[4 * j]; acc[4 * j + 1] += ww[1] * s[4 * j + 1]; acc[4 * j + 2] += ww[2] * s[4 * j + 2]; acc[4 * j + 3] += ww[3] * s[4 * j + 3]; }
            }
            const bool padrow = t < npad;
            unsigned w[8];
#pragma unroll
            for (int j = 0; j < 8; ++j) { const float x0 = padrow ? 0.f : acc[2 * j] * fsig(acc[2 * j]), x1 = padrow ? 0.f : acc[2 * j + 1] * fsig(acc[2 * j + 1]); w[j] = pk2(x0, x1); }
            const v4u w0 = {w[0], w[1], w[2], w[3]}, w1 = {w[4], w[5], w[6], w[7]};
            *(LAS v4u*)(Xs + t * XS_P + cg) = w0; *(LAS v4u*)(Xs + t * XS_P + cg + 8) = w1;
            *(v4u*)(XC + row * 512 + col) = w0; *(v4u*)(XC + row * 512 + col + 8) = w1;
            const int tl = ck.samp ? t - (DEC_T - 3) : ((ck.c == NCH - 1) ? t - 61 : -1);
            if (tl >= 0) { float* oc = P.out + (ck.samp ? OUT_CVS : OUT_CVP) + ((size_t)ck.b * 3 + tl) * MW + col; float s[16]; unpack16(mx[3][0], mx[3][1], s);
#pragma unroll
                for (int j = 0; j < 16; ++j) oc[j] = s[j]; }
            v4u a = mv[0], bq = mv[1];
            if (padrow) { a = (v4u){0u, 0u, 0u, 0u}; bq = a; }
            const unsigned vv[8] = {a.x, a.y, a.z, a.w, bq.x, bq.y, bq.z, bq.w};
#pragma unroll
            for (int j = 0; j < 8; ++j) { vT[(cg + 2 * j) * KT_P + t] = (bf16_t)(vv[j] & 0xffffu); vT[(cg + 2 * j + 1) * KT_P + t] = (bf16_t)(vv[j] >> 16); }
        }
        if (item + (int)gridDim.x < NITEM_L) p2_load(P, item + gridDim.x, tid, mx, mv, g_mi, g_mf);
        __syncthreads();
        {
            if (mh != mh_loaded) { const bf16_t* wkk = (const bf16_t*)(ws + WS_WMK) + (size_t)mh * MD * MD + (size_t)(16 * wave + fr) * MD + 8 * fq;
#pragma unroll
                for (int ks = 0; ks < 4; ++ks) bk[ks] = *(const bf16x8*)(wkk + 32 * ks);
                mh_loaded = mh; }
            const int e = 16 * wave + fr;
#pragma unroll
            for (int m = 0; m < 4; ++m) {
                f32x4 ak = {0.f, 0.f, 0.f, 0.f};
#pragma unroll
                for (int ks = 0; ks < 4; ++ks) { const bf16x8 a = *(const LAS bf16x8*)(Xs + (16 * m + fr) * XS_P + 32 * ks + 8 * fq); ak = mfma16(a, bk[ks], ak); }
                const int t0 = 16 * m + 4 * fq; const f32x4 wv = *(const LAS f32x4*)(wk + t0);
                ak = ak * 0.08838834764831845f;
                const float k0 = bflo(pk2(ak[0], 0.f)), k1 = bflo(pk2(ak[1], 0.f)), k2 = bflo(pk2(ak[2], 0.f)), k3 = bflo(pk2(ak[3], 0.f));
                v2u kw; kw.x = pk2(k0 * wv[0], k1 * wv[1]); kw.y = pk2(k2 * wv[2], k3 * wv[3]);
                *(LAS v2u*)(kTw + e * KT_P + t0) = kw;
            }
        }
        __syncthreads();
        {
            bf16x8 a[2];
#pragma unroll
            for (int ks = 0; ks < 2; ++ks) a[ks] = *(const LAS bf16x8*)(kTw + (16 * wave + fr) * KT_P + 32 * ks + 8 * fq);
            bf16_t* kvl = KVL + (size_t)item * MD * MD;
#pragma unroll
            for (int n = 0; n < 8; ++n) {
                f32x4 acc = {0.f, 0.f, 0.f, 0.f};
#pragma unroll
                for (int ks = 0; ks < 2; ++ks) { const bf16x8 b = *(const LAS bf16x8*)(vT + (16 * n + fr) * KT_P + 32 * ks + 8 * fq); acc = mfma16(a[ks], b, acc); }
                v2u o; o.x = pk2(acc[0], acc[1]); o.y = pk2(acc[2], acc[3]);
                *(v2u*)(kvl + (size_t)(16 * n + fr) * MD + 16 * wave + 4 * fq) = o;
            }
            if (tid < MD) {
                float s = 0.f;
#pragma unroll
                for (int j = 0; j < 8; ++j) { const v4u x = *(const LAS v4u*)(kTw + tid * KT_P + 8 * j);
                    s += (bflo(x.x) + bfhi(x.x)) + (bflo(x.y) + bfhi(x.y)) + (bflo(x.z) + bfhi(x.z)) + (bflo(x.w) + bfhi(x.w)); }
                NL[(size_t)item * MD + tid] = s;
            }
        }
    }
}
}
namespace fk {
__device__ __forceinline__ void p3_scan(const FP& P) {
    unsigned char* ws = P.ws;
    bf16_t* KVL = (bf16_t*)P.scr;
    float* NL = (float*)(ws + WS_MISC + MS_NL); const float* CHS = (const float*)(ws + WS_MISC + MS_CHS);
    float* MC = (float*)(ws + WS_MISC + MS_MC);
    constexpr int EPS_ = MD * MD / 4 + MD;
    constexpr int NSEQ = (NPB + NB) * MH;
    const int gt = blockIdx.x * 512 + threadIdx.x, NT = gridDim.x * 512;
    for (int e = gt; e < NSEQ * EPS_; e += NT) {
        const int sidx = e / EPS_, w = e % EPS_;
        const bool samp = sidx >= NPB * MH; const int b = samp ? (sidx - NPB * MH) / MH : sidx / MH, h = sidx % MH;
        const int nch = samp ? 1 : NCH;
        const int item0 = samp ? ((NPB * NCH + b) * MH + h) : ((b * NCH) * MH + h);
        float m = samp ? P.in[I_SM][b * MH + h] : 0.f;
        if (w < MD * MD / 4) {
            const int dv = w >> 5, dk = (w & 31) * 4;
            float c0 = 0.f, c1 = 0.f, c2 = 0.f, c3 = 0.f;
            if (samp) { const float* C0 = P.in[I_SC] + ((size_t)b * MH + h) * MD * MD; c0 = C0[(size_t)dk * MD + dv]; c1 = C0[(size_t)(dk + 1) * MD + dv]; c2 = C0[(size_t)(dk + 2) * MD + dv]; c3 = C0[(size_t)(dk + 3) * MD + dv]; }
            for (int cb = 0; cb < nch; cb += 13) {
                v2u kv[13]; float blv[13], mlv[13];
#pragma unroll
                for (int j = 0; j < 13; ++j) if (cb + j < nch) { const int it = item0 + 4 * (cb + j); kv[j] = *(const v2u*)(KVL + (size_t)it * MD * MD + (size_t)dv * MD + dk); blv[j] = CHS[(size_t)it * 2]; mlv[j] = CHS[(size_t)it * 2 + 1]; }
#pragma unroll
                for (int j = 0; j < 13; ++j) if (cb + j < nch) {
                    const int it = item0 + 4 * (cb + j);
                    const float bL = blv[j], ml = mlv[j];
                    const float mn = fmaxf(bL + m, ml), a = fexp(bL + m - mn), s = fexp(ml - mn);
                    v2u o; o.x = pk2(c0, c1); o.y = pk2(c2, c3);
                    *(v2u*)(KVL + (size_t)it * MD * MD + (size_t)dv * MD + dk) = o;
                    if (w == 0) MC[it] = m;
                    c0 = a * c0 + s * bflo(kv[j].x); c1 = a * c1 + s * bfhi(kv[j].x); c2 = a * c2 + s * bflo(kv[j].y); c3 = a * c3 + s * bfhi(kv[j].y);
                    m = mn;
                }
            }
            float* oC = P.out + (samp ? OUT_CS : OUT_CP) + ((size_t)b * MH + h) * MD * MD;
            oC[(size_t)dk * MD + dv] = c0; oC[(size_t)(dk + 1) * MD + dv] = c1; oC[(size_t)(dk + 2) * MD + dv] = c2; oC[(size_t)(dk + 3) * MD + dv] = c3;
            if (w == 0) P.out[(samp ? OUT_MS : OUT_MP) + (size_t)b * MH + h] = m;
        } else {
            const int dk = w - MD * MD / 4;
            float n = samp ? P.in[I_SN][((size_t)b * MH + h) * MD + dk] : 0.f;
            for (int cb = 0; cb < nch; cb += 13) {
                float nlv[13], blv[13], mlv[13];
#pragma unroll
                for (int j = 0; j < 13; ++j) if (cb + j < nch) { const int it = item0 + 4 * (cb + j); nlv[j] = NL[(size_t)it * MD + dk]; blv[j] = CHS[(size_t)it * 2]; mlv[j] = CHS[(size_t)it * 2 + 1]; }
#pragma unroll
                for (int j = 0; j < 13; ++j) if (cb + j < nch) {
                    const int it = item0 + 4 * (cb + j);
                    const float mn = fmaxf(blv[j] + m, mlv[j]), a = fexp(blv[j] + m - mn), s = fexp(mlv[j] - mn);
                    NL[(size_t)it * MD + dk] = n;
                    n = a * n + s * nlv[j]; m = mn;
                }
            }
            P.out[(samp ? OUT_NS : OUT_NP) + ((size_t)b * MH + h) * MD + dk] = n;
        }
    }
}

constexpr int L3_K = 0, L3_V = 16384, L3_WS = 32768, L3_OFF = L3_WS + 8 * 64 * 4, L3_END = L3_OFF + 128 * 4;
__device__ __forceinline__ int crow(int r, int hi) { return (r & 3) + 8 * (r >> 2) + 4 * hi; }
typedef short v4i16_t __attribute__((ext_vector_type(4)));
__device__ __forceinline__ s16x4 vtr(const LAS unsigned char* p) { return __builtin_bit_cast(s16x4, __builtin_amdgcn_ds_read_tr16_b64_v4i16((LAS v4i16_t*)p)); }
__device__ __forceinline__ unsigned cvtpk(float lo, float hi) { typedef float f2 __attribute__((ext_vector_type(2))); typedef __bf16 b2 __attribute__((ext_vector_type(2))); f2 v = {lo, hi}; b2 b = __builtin_convertvector(v, b2); return __builtin_bit_cast(unsigned, b); }

__device__ __forceinline__ void attn_unit(const FP& P, int unit, LAS unsigned char* lds) {
    const int tid = threadIdx.x, lane = tid & 63, r32 = lane & 31, hi = lane >> 5, wave = __builtin_amdgcn_readfirstlane(tid >> 6);
    unsigned char* ws = P.ws;
    bf16_t* Z = (bf16_t*)(ws + WS_Z);
    const bf16_t *Kb, *Vb; const float* nb; const float* tot; bf16_t* Qb; int J0, J1, jdiag, nvalid, qpos0, ntot, t0;
    if (unit < NPB * FH * 17) {
        const int sq = unit / 17, j = unit % 17, b = sq / FH, fh = sq % FH;
        Kb = Z + (size_t)ZK * SE + (size_t)b * RP * 512 + fh * FD; Vb = Z + (size_t)ZV * SE + (size_t)b * RP * 512 + fh * FD;
        Qb = Z + (size_t)ZQ * SE + ((size_t)b * RP + 256 * j) * 512 + fh * FD;
        nb = (const float*)(ws + WS_MISC + MS_NBP) + (size_t)sq * NBPL;
        tot = (const float*)(ws + WS_MISC + MS_JST) + sq * TOTP_L; ntot = NCH; t0 = j == 0 ? PADF : 256 * j;
        jdiag = 4 * j; J1 = (j == 16) ? 65 : 4 * j + 4; nvalid = (j == 16) ? 64 : 256; qpos0 = 256 * j;
    } else {
        const int s2 = unit - NPB * FH * 17, b = s2 / FH, fh = s2 % FH;
        Kb = (const bf16_t*)(ws + WS_KS) + (size_t)b * NBSL * 512 + fh * FD; Vb = (const bf16_t*)(ws + WS_VS) + (size_t)b * NBSL * 512 + fh * FD;
        Qb = Z + (size_t)ZQ * SE + ((size_t)SROW0 + b * DEC_T) * 512 + fh * FD;
        nb = (const float*)(ws + WS_MISC + MS_NBS) + (size_t)s2 * NBSL;
        tot = (const float*)(ws + WS_MISC + MS_TOTS) + s2 * TOTS_L; ntot = 17; t0 = PAST;
        jdiag = 16; J1 = 17; nvalid = 64; qpos0 = PAST;
    }
    const bool active = wave * 32 < nvalid;
    LAS float* wsf = (LAS float*)(lds + L3_WS) + wave * 64;
    const int skey = tid >> 3, sch = tid & 7;
    const unsigned kdst = L3_K + sch * 1024 + skey * 16, vdst = L3_V + (sch >> 2) * 4096 + skey * 64 + (sch & 3) * 16;
    const bf16_t* ksrc = Kb + (size_t)skey * 512 + sch * 8; const bf16_t* vsrc = Vb + (size_t)skey * 512 + sch * 8;
    bf16x8 qr[4];
#pragma unroll
    for (int d0 = 0; d0 < 4; ++d0) qr[d0] = *(const bf16x8*)(Qb + (size_t)(wave * 32 + r32) * 512 + d0 * 16 + hi * 8);
    float m = -INFINITY, l = 0.f; f32x16 o[2]; o[0] = f32x16{}; o[1] = f32x16{};
    const int qpos = qpos0 + wave * 32 + r32;
    LAS float* OFF = (LAS float*)(lds + L3_OFF);
    __syncthreads();
    if (wave == 0) {
        const float v0 = lane < ntot ? tot[lane] : 0.f, v1 = (64 + lane) < ntot ? tot[64 + lane] : 0.f;
        const float s0 = wave_scan_add(v0, lane);
        const float s1 = __shfl(s0, 63) + wave_scan_add(v1, lane);
        OFF[lane + 1] = s0; if (lane == 0) { OFF[0] = 0.f; OFF[65] = s1; }
        const int c0 = t0 >> 6;
        const float offc = c0 == 0 ? 0.f : __shfl(s0, c0 - 1);
        const float nbT0 = nb[t0] + offc;
        const float th2 = *(const float*)(ws + WS_MISC + MS_TH2);
        unsigned long long mk = __ballot(s0 - nbT0 >= -th2);
        if (jdiag < 64) mk &= (1ull << jdiag) - 1ull;
        const int j0 = mk ? __builtin_ctzll(mk) : jdiag;
        if (lane == 0) ((LAS int*)OFF)[80] = j0;
#pragma unroll
        for (int w = 1; w < 8; ++w) {
            const int tw = t0 > qpos0 + 32 * w ? t0 : qpos0 + 32 * w, cw = tw >> 6, jd = cw;
            const float offw = cw == 0 ? 0.f : __shfl(s0, cw - 1 < 63 ? cw - 1 : 63);
            const float nbw = nb[tw] + (cw <= 64 ? offw : 0.f);
            unsigned long long mw = __ballot(s0 - nbw >= -th2);
            if (jd < 64) mw &= (1ull << jd) - 1ull;
            const int jw = mw ? __builtin_ctzll(mw) : jd;
            if (lane == 0) ((LAS int*)OFF)[80 + w] = jw;
        }
    }
    __syncthreads();
    J0 = ((LAS int*)OFF)[80];
    const int Jw = wave == 0 ? J0 : ((LAS int*)OFF)[80 + wave];
    v4u kreg = *(const v4u*)(ksrc + (size_t)J0 * 64 * 512), vreg = *(const v4u*)(vsrc + (size_t)J0 * 64 * 512);
    *(LAS v4u*)(lds + kdst) = kreg; *(LAS v4u*)(lds + vdst) = vreg;
    __syncthreads();
    for (int J = J0; J < J1; ++J) {
        const int slot = (J - J0) & 1;
        if (J + 1 < J1) { kreg = *(const v4u*)(ksrc + (size_t)(J + 1) * 64 * 512); vreg = *(const v4u*)(vsrc + (size_t)(J + 1) * 64 * 512); }
        if (active && J >= Jw && 64 * J <= qpos0 + wave * 32 + 31) {
            const LAS unsigned char* Ks = lds + L3_K + slot * 8192; const LAS unsigned char* Vs = lds + L3_V + slot * 8192;
            const float* nbt = nb + 64 * J + 4 * hi; const float offJ = OFF[J];
            f32x4 nx0[4], nx1[4];
#pragma unroll
            for (int g = 0; g < 4; ++g) { nx0[g] = *(const f32x4*)(nbt + 8 * g); nx1[g] = *(const f32x4*)(nbt + 32 + 8 * g); }
            f32x16 p0 = f32x16{}, p1 = f32x16{};
#pragma unroll
            for (int d0 = 0; d0 < 4; ++d0) {
                const bf16x8 b0 = *(const LAS bf16x8*)(Ks + (2 * d0 + hi) * 1024 + r32 * 16);
                const bf16x8 b1 = *(const LAS bf16x8*)(Ks + (2 * d0 + hi) * 1024 + (32 + r32) * 16);
                p0 = __builtin_amdgcn_mfma_f32_32x32x16_bf16(b0, qr[d0], p0, 0, 0, 0);
                p1 = __builtin_amdgcn_mfma_f32_32x32x16_bf16(b1, qr[d0], p1, 0, 0, 0);
            }
#pragma unroll
            for (int g = 0; g < 4; ++g) {
#pragma unroll
                for (int i = 0; i < 4; ++i) { p0[4 * g + i] += nx0[g][i] + offJ; p1[4 * g + i] += nx1[g][i] + offJ; }
            }
            if (J >= jdiag) {
#pragma unroll
                for (int r = 0; r < 16; ++r) { const int kv = 64 * J + crow(r, hi); if (kv > qpos) p0[r] = -INFINITY; if (kv + 32 > qpos) p1[r] = -INFINITY; }
            }
            float mt = p0[0];
#pragma unroll
            for (int r = 1; r < 16; ++r) mt = fmaxf(mt, p0[r]);
#pragma unroll
            for (int r = 0; r < 16; ++r) mt = fmaxf(mt, p1[r]);
            mt = fmaxf(mt, __shfl_xor(mt, 32));
            const float mn = fmaxf(m, mt);
            const float alpha = __builtin_amdgcn_exp2f(m - mn);
            float ps = 0.f;
#pragma unroll
            for (int r = 0; r < 16; ++r) { p0[r] = __builtin_amdgcn_exp2f(p0[r] - mn); p1[r] = __builtin_amdgcn_exp2f(p1[r] - mn); ps += p0[r] + p1[r]; }
            l = l * alpha + ps; m = mn;
            if (hi == 0) wsf[r32] = alpha;
            LDS_WAIT(); asm volatile("" ::: "memory");
#pragma unroll
            for (int g = 0; g < 4; ++g) { const f32x4 al = *(const LAS f32x4*)(wsf + 8 * g + 4 * hi);
#pragma unroll
                for (int i = 0; i < 4; ++i) { o[0][4 * g + i] *= al[i]; o[1][4 * g + i] *= al[i]; } }
            v4u pw[4];
#pragma unroll
            for (int i = 0; i < 4; ++i) { pw[0][i] = cvtpk(p0[2 * i], p0[2 * i + 1]); pw[1][i] = cvtpk(p0[8 + 2 * i], p0[8 + 2 * i + 1]); pw[2][i] = cvtpk(p1[2 * i], p1[2 * i + 1]); pw[3][i] = cvtpk(p1[8 + 2 * i], p1[8 + 2 * i + 1]); }
            const LAS unsigned char* vb = Vs + ((lane >> 4) & 1) * 32 + (lane & 3) * 8 + (4 * hi + ((lane & 15) >> 2)) * 64;
#pragma unroll
            for (int db = 0; db < 2; ++db)
#pragma unroll
                for (int ks = 0; ks < 4; ++ks) {
                    const s16x4 lo = vtr(vb + db * 4096 + ks * 1024), hh = vtr(vb + db * 4096 + ks * 1024 + 512);
                    const bf16x8 vf = {lo[0], lo[1], lo[2], lo[3], hh[0], hh[1], hh[2], hh[3]};
                    o[db] = __builtin_amdgcn_mfma_f32_32x32x16_bf16(__builtin_bit_cast(bf16x8, pw[ks]), vf, o[db], 0, 0, 0);
                }
        }
        if (J + 1 < J1) { *(LAS v4u*)(lds + kdst + (slot ^ 1) * 8192) = kreg; *(LAS v4u*)(lds + vdst + (slot ^ 1) * 8192) = vreg; }
        __syncthreads();
    }
    if (active) {
        l += __shfl_xor(l, 32);
        if (hi == 0) wsf[r32] = 1.f / l;
        LDS_WAIT(); asm volatile("" ::: "memory");
#pragma unroll
        for (int g = 0; g < 4; ++g) { const f32x4 il = *(const LAS f32x4*)(wsf + 8 * g + 4 * hi);
#pragma unroll
            for (int i = 0; i < 4; ++i) {
                const int r = 4 * g + i; bf16_t* orow = Qb + (size_t)(wave * 32 + crow(r, hi)) * 512;
                orow[r32] = (bf16_t)f2bf(o[0][r] * il[i]); orow[32 + r32] = (bf16_t)f2bf(o[1][r] * il[i]);
            } }
    }
}
}
namespace fk {
constexpr int L4_QS = 0, L4_KS = L4_QS + 64 * XS_P * 2, L4_XS = L4_KS + 64 * XS_P * 2, L4_VT = L4_XS + 64 * XS_P * 2, L4_CT = L4_VT + 128 * KT_P * 2, L4_AS = L4_CT + 128 * XS_P * 2, L4_F = L4_AS + 64 * KT_P * 2, L4_GS = L4_F + 10 * 64 * 4, L4_END = L4_GS + 256 * 4;
static_assert(L4_END <= 131072, "P4 LDS");
struct P4Pre { v4u xc[2], mv[2], mo, ct[4]; float nc, bt, ig, mc; };
__device__ __forceinline__ void p4_load(const FP& P, int item, int tid, P4Pre& R) {
    const bf16_t* Z = (const bf16_t*)(P.ws + WS_Z);
    const bf16_t* ZMVp = Z + (size_t)ZMV * SE; const bf16_t* ZMOp = Z + (size_t)ZMO * SE; const bf16_t* XC = (const bf16_t*)(P.ws + WS_A); const bf16_t* KVL = (const bf16_t*)P.scr;
    const float* BT = (const float*)(P.ws + WS_MISC + MS_BT); const float* IGT = (const float*)(P.ws + WS_MISC + MS_IGT); const float* NL = (const float*)(P.ws + WS_MISC + MS_NL); const float* MC = (const float*)(P.ws + WS_MISC + MS_MC);
    const int ci = item >> 2, mh = item & 3; const ChunkId ck = chunk_of(ci);
    const int t = tid >> 3, col = mh * MD + (tid & 7) * 16; const size_t row = (size_t)ck.row0 + t;
    R.xc[0] = *(const v4u*)(XC + row * 512 + col); R.xc[1] = *(const v4u*)(XC + row * 512 + col + 8);
    R.mv[0] = *(const v4u*)(ZMVp + row * 512 + col); R.mv[1] = *(const v4u*)(ZMVp + row * 512 + col + 8);
    R.mo = *(const v4u*)((const unsigned char*)ZMOp + row * 512 + col);
    const bf16_t* src = KVL + (size_t)item * MD * MD + (size_t)(tid >> 2) * MD + (tid & 3) * 32;
#pragma unroll
    for (int j = 0; j < 4; ++j) R.ct[j] = *(const v4u*)(src + 8 * j);
    R.nc = tid < MD ? NL[(size_t)item * MD + tid] : 0.f;
    if (tid < 64) { R.bt = BT[((size_t)ck.row0 + tid) * MH + mh]; R.ig = IGT[((size_t)ck.row0 + tid) * MH + mh]; R.mc = MC[item]; }
}
__device__ __forceinline__ void p4_phase(const FP& P, LAS unsigned char* lds) {
    const int tid = threadIdx.x, lane = tid & 63, wave = __builtin_amdgcn_readfirstlane(tid >> 6), fr = lane & 15, fq = lane >> 4;
    unsigned char* ws = P.ws;
    bf16_t* HM = (bf16_t*)(ws + WS_Z) + (size_t)ZMX * SE;
    LAS bf16_t* Qs = (LAS bf16_t*)(lds + L4_QS); LAS bf16_t* Ks = (LAS bf16_t*)(lds + L4_KS); LAS bf16_t* Xs = (LAS bf16_t*)(lds + L4_XS); LAS bf16_t* vT = (LAS bf16_t*)(lds + L4_VT);
    LAS bf16_t* CT = (LAS bf16_t*)(lds + L4_CT); LAS bf16_t* As = (LAS bf16_t*)(lds + L4_AS); LAS bf16_t* MOs = Ks;
    LAS float* U = (LAS float*)(lds + L4_F); LAS float* Vv = U + 64; LAS float* WI = U + 128; LAS float* EM = U + 192; LAS float* DD = U + 256; LAS float* NC = U + 320;   LAS float* SS = U + 448;
    P4Pre R;
    int item = blockIdx.x;
    if (item < NITEM_L) p4_load(P, item, tid, R);
    bf16x8 aq[4], ak[4]; int mh_loaded = -1, gs_mh = -1;
    LAS float* GS = (LAS float*)(lds + L4_GS);
    for (; item < NITEM_L; item += gridDim.x) {
        const int ci = item >> 2, mh = item & 3; const ChunkId ck = chunk_of(ci);
        const int npad = (!ck.samp && ck.c == 0) ? PADF : 0;
        if (mh != mh_loaded) { const bf16_t* wq = (const bf16_t*)(ws + WS_WMQ) + (size_t)mh * MD * MD + (size_t)(16 * wave + fr) * MD + 8 * fq; const bf16_t* wkk = (const bf16_t*)(ws + WS_WMK) + (size_t)mh * MD * MD + (size_t)(16 * wave + fr) * MD + 8 * fq;
#pragma unroll
          for (int ks = 0; ks < 4; ++ks) { aq[ks] = *(const bf16x8*)(wq + 32 * ks); ak[ks] = *(const bf16x8*)(wkk + 32 * ks); }
          mh_loaded = mh; }
        __syncthreads();
        if (mh != gs_mh) { if (tid < 256) GS[tid] = tid < 128 ? P.in[I_GMN][mh * MD + tid] : P.in[I_SKIP][mh * MD + tid - 128]; gs_mh = mh; }
        const v4u mo0 = R.mo;
        {
            const int t = tid >> 3, cg = (tid & 7) * 16;
            *(LAS v4u*)(Xs + t * XS_P + cg) = R.xc[0]; *(LAS v4u*)(Xs + t * XS_P + cg + 8) = R.xc[1];
            v4u a = R.mv[0], bq = R.mv[1];
            if (t < npad) { a = (v4u){0u, 0u, 0u, 0u}; bq = a; }
            const unsigned vv[8] = {a.x, a.y, a.z, a.w, bq.x, bq.y, bq.z, bq.w};
#pragma unroll
            for (int j = 0; j < 8; ++j) { vT[(cg + 2 * j) * KT_P + t] = (bf16_t)(vv[j] & 0xffffu); vT[(cg + 2 * j + 1) * KT_P + t] = (bf16_t)(vv[j] >> 16); }
            const int dv = tid >> 2, qq = (tid & 3) * 32;
#pragma unroll
            for (int j = 0; j < 4; ++j) *(LAS v4u*)(CT + dv * XS_P + qq + 8 * j) = R.ct[j];
            if (tid < MD) NC[tid] = R.nc;
        }
        if (wave == 0) {
            const float bt = R.bt, ig = R.ig, mc = R.mc;
            const float vs = ig - bt, cm = wave_scan_max(vs, lane), mt = bt + fmaxf(mc, cm);
            U[lane] = bt - mt; Vv[lane] = vs; WI[lane] = fexp(bt + mc - mt); EM[lane] = fexp(-mt);
        }
        if (item + (int)gridDim.x < NITEM_L) p4_load(P, item + gridDim.x, tid, R);
        __syncthreads();
        {
#pragma unroll
            for (int n = 0; n < 4; ++n) {
                f32x4 cq = {0.f, 0.f, 0.f, 0.f}, ckk = {0.f, 0.f, 0.f, 0.f};
#pragma unroll
                for (int ks = 0; ks < 4; ++ks) { const bf16x8 b = *(const LAS bf16x8*)(Xs + (16 * n + fr) * XS_P + 32 * ks + 8 * fq); cq = mfma16(aq[ks], b, cq); ckk = mfma16(ak[ks], b, ckk); }
                ckk = ckk * 0.08838834764831845f;
                v2u oq, ok; oq.x = pk2(cq[0], cq[1]); oq.y = pk2(cq[2], cq[3]); ok.x = pk2(ckk[0], ckk[1]); ok.y = pk2(ckk[2], ckk[3]);
                *(LAS v2u*)(Qs + (16 * n + fr) * XS_P + 16 * wave + 4 * fq) = oq; *(LAS v2u*)(Ks + (16 * n + fr) * XS_P + 16 * wave + 4 * fq) = ok;
            }
        }
        __syncthreads();
        {
            const int s0 = 16 * (wave & 3), tb = 32 * (wave >> 2);
            f32x4 acc[2] = {{0.f, 0.f, 0.f, 0.f}, {0.f, 0.f, 0.f, 0.f}};
#pragma unroll
            for (int ks = 0; ks < 4; ++ks) {
                const bf16x8 a = *(const LAS bf16x8*)(Ks + (s0 + fr) * XS_P + 32 * ks + 8 * fq);
#pragma unroll
                for (int n = 0; n < 2; ++n) { const bf16x8 b = *(const LAS bf16x8*)(Qs + (tb + 16 * n + fr) * XS_P + 32 * ks + 8 * fq); acc[n] = mfma16(a, b, acc[n]); }
            }
            const int sb = s0 + 4 * fq; const f32x4 vsv = *(const LAS f32x4*)(Vv + sb);
#pragma unroll
            for (int n = 0; n < 2; ++n) {
                const int t = tb + 16 * n + fr; const float ut = U[t];
                float w[4];
#pragma unroll
                for (int r = 0; r < 4; ++r) w[r] = (sb + r <= t) ? fexp(ut + vsv[r]) * acc[n][r] : 0.f;
                v2u o; o.x = pk2(w[0], w[1]); o.y = pk2(w[2], w[3]);
                *(LAS v2u*)(As + t * KT_P + sb) = o;
            }
        }
        __syncthreads();
        {
            const int t = tid >> 3, cg = (tid & 7) * 16;
            *(LAS v4u*)((LAS unsigned char*)MOs + t * 144 + cg) = mo0;
        }
        {
            const int t = tid >> 3, pp = tid & 7;
            const v4u x = *(const LAS v4u*)(As + t * KT_P + 8 * pp);
            float d = (bflo(x.x) + bfhi(x.x)) + (bflo(x.y) + bfhi(x.y)) + (bflo(x.z) + bfhi(x.z)) + (bflo(x.w) + bfhi(x.w)), dq = 0.f;
#pragma unroll
            for (int j = 0; j < 2; ++j) { const v4u q = *(const LAS v4u*)(Qs + t * XS_P + 16 * pp + 8 * j); const f32x4 n0 = *(const LAS f32x4*)(NC + 16 * pp + 8 * j), n1 = *(const LAS f32x4*)(NC + 16 * pp + 8 * j + 4);
                dq += bflo(q.x) * n0[0] + bfhi(q.x) * n0[1] + bflo(q.y) * n0[2] + bfhi(q.y) * n0[3] + bflo(q.z) * n1[0] + bfhi(q.z) * n1[1] + bflo(q.w) * n1[2] + bfhi(q.w) * n1[3]; }
            d += WI[t] * dq;
            d += __shfl_xor(d, 1); d += __shfl_xor(d, 2); d += __shfl_xor(d, 4);
            if (pp == 0) DD[t] = 1.f / fmaxf(fabsf(d), EM[t]);
        }
        const int t0 = 16 * (wave & 3), dvb = 64 * (wave >> 2);
        f32x4 acc[4] = {{0.f, 0.f, 0.f, 0.f}, {0.f, 0.f, 0.f, 0.f}, {0.f, 0.f, 0.f, 0.f}, {0.f, 0.f, 0.f, 0.f}};
#pragma unroll
        for (int ks = 0; ks < 2; ++ks) {
            const bf16x8 a = *(const LAS bf16x8*)(As + (t0 + fr) * KT_P + 32 * ks + 8 * fq);
#pragma unroll
            for (int n = 0; n < 4; ++n) { const bf16x8 b = *(const LAS bf16x8*)(vT + (dvb + 16 * n + fr) * KT_P + 32 * ks + 8 * fq); acc[n] = mfma16(a, b, acc[n]); }
        }
        f32x4 acci[4] = {{0.f, 0.f, 0.f, 0.f}, {0.f, 0.f, 0.f, 0.f}, {0.f, 0.f, 0.f, 0.f}, {0.f, 0.f, 0.f, 0.f}};
#pragma unroll
        for (int ks = 0; ks < 4; ++ks) {
            const bf16x8 a = *(const LAS bf16x8*)(Qs + (t0 + fr) * XS_P + 32 * ks + 8 * fq);
#pragma unroll
            for (int n = 0; n < 4; ++n) { const bf16x8 b = *(const LAS bf16x8*)(CT + (dvb + 16 * n + fr) * XS_P + 32 * ks + 8 * fq); acci[n] = mfma16(a, b, acci[n]); }
        }
        { const f32x4 wiv = *(const LAS f32x4*)(WI + t0 + 4 * fq);
#pragma unroll
          for (int n = 0; n < 4; ++n) acc[n] = acc[n] + acci[n] * wiv; }
        __syncthreads();
        float hv[4][4]; float ssq[4] = {0.f, 0.f, 0.f, 0.f};
        const f32x4 ddv = *(const LAS f32x4*)(DD + t0 + 4 * fq);
#pragma unroll
        for (int n = 0; n < 4; ++n)
#pragma unroll
            for (int r = 0; r < 4; ++r) {
                const float og = (float)((LAS unsigned char*)MOs)[(t0 + 4 * fq + r) * 144 + dvb + 16 * n + fr] * (1.f / 255.f);
                hv[n][r] = og * acc[n][r] * ddv[r]; ssq[r] += hv[n][r] * hv[n][r];
            }
#pragma unroll
        for (int r = 0; r < 4; ++r) { float s = ssq[r]; s += __shfl_xor(s, 1); s += __shfl_xor(s, 2); s += __shfl_xor(s, 4); s += __shfl_xor(s, 8); ssq[r] = s; }
        if (fr == 0) {
#pragma unroll
            for (int r = 0; r < 4; ++r) SS[(wave >> 2) * 64 + t0 + 4 * fq + r] = ssq[r];
        }
        __syncthreads();
#pragma unroll
        for (int r = 0; r < 4; ++r) {
            const int t = t0 + 4 * fq + r; const float rn = rsqrtf((SS[t] + SS[64 + t]) * (1.f / MD) + EPS);
            const size_t row = (size_t)ck.row0 + t;
#pragma unroll
            for (int n = 0; n < 4; ++n) { const int cl = dvb + 16 * n + fr, col = mh * MD + cl;
                const float v = hv[n][r] * rn * GS[cl] + GS[128 + cl] * bf2f(Xs[t * XS_P + cl]);
                HM[row * 512 + col] = (bf16_t)f2bf(v); }
        }
    }
    __syncthreads();
}
}
namespace pg8 {
__device__ __forceinline__ float fsigmoid(float x) { return __builtin_amdgcn_rcpf(1.f + __builtin_amdgcn_exp2f(-1.4426950408889634f * x)); }
__device__ __forceinline__ float bflo_(unsigned w) { return __builtin_bit_cast(float, w << 16); }
__device__ __forceinline__ float bfhi_(unsigned w) { return __builtin_bit_cast(float, w & 0xffff0000u); }
template <int MODE> struct EpiGate {
    static constexpr bool PERM = true, AFTER_DRAIN = false, HAS_MID = (MODE == 2);
    bf16_t* MG; const unsigned char* G; const unsigned char* G2;
    __device__ __forceinline__ void mid(f32x4 (&acc)[2][2][4][2], const Unit& u, int wr, int wc, int fr, int fq) const {
        const int row0 = u.rb + wr * 64 + fr, c = u.pn * BM + wc * 32 + 8 * fq;
        size_t off = (size_t)row0 * 1024 + c;
#pragma unroll
        for (int ai = 0; ai < 2; ++ai)
#pragma unroll
            for (int m = 0; m < 4; ++m) {
#pragma unroll
                for (int bj = 0; bj < 2; ++bj) {
                    typedef unsigned u32x2 __attribute__((ext_vector_type(2)));
                    const u32x2 ga = *(const u32x2*)(G2 + off + bj * HALF), gb = *(const u32x2*)(G + off + bj * HALF);
#pragma unroll
                    for (int q = 0; q < 8; ++q) { const float fa = (float)((ga[q >> 2] >> (8 * (q & 3))) & 255u), fb = (float)((gb[q >> 2] >> (8 * (q & 3))) & 255u);
                        acc[ai][bj][m][q >> 2][q & 3] *= fa * __builtin_amdgcn_rcpf(fb); } }
                off += (m == 3 ? (size_t)(HALF - 48) * 1024 : (size_t)16 * 1024);
                asm volatile("" : "+v"(off) :: "memory");
            }
    }
    __device__ __forceinline__ void operator()(const f32x4 (&acc)[2][2][4][2], const Unit& u, int wr, int wc, int fr, int fq) const {
        const int row0 = u.rb + wr * 64 + fr, col0 = u.pn * BM + wc * 32 + 8 * fq;
#pragma unroll
        for (int ai = 0; ai < 2; ++ai)
#pragma unroll
            for (int m = 0; m < 4; ++m) { const size_t row = (size_t)(row0 + ai * HALF + m * 16);
#pragma unroll
                for (int bj = 0; bj < 2; ++bj) { const int c = col0 + bj * HALF;
                    typedef unsigned u32x2 __attribute__((ext_vector_type(2)));
                    const u32x2 g = *(const u32x2*)(G + row * 1024 + c);
                    f32x4 v0 = acc[ai][bj][m][0], v1 = acc[ai][bj][m][1];
#pragma unroll
                    for (int i = 0; i < 4; ++i) { v0[i] *= (float)((g.x >> (8 * i)) & 255u) * (1.f / 255.f); v1[i] *= (float)((g.y >> (8 * i)) & 255u) * (1.f / 255.f); }
                    u32x4 w; w.x = cvt_pk_bf16(v0[0], v0[1]); w.y = cvt_pk_bf16(v0[2], v0[3]); w.z = cvt_pk_bf16(v1[0], v1[1]); w.w = cvt_pk_bf16(v1[2], v1[3]);
                    *(u32x4*)(MG + row * 1024 + c) = w; } }
    }
};
struct EpiSwiGLU {
    static constexpr bool PERM = true, AFTER_DRAIN = false, HAS_MID = false;
    bf16_t* ACT; int ldc;
    __device__ __forceinline__ void operator()(const f32x4 (&acc)[2][2][4][2], const Unit& u, int wr, int wc, int fr, int fq) const {
        const int row0 = u.rb + wr * 64 + fr, col0 = u.pn * HALF + wc * 32 + 8 * fq;
#pragma unroll
        for (int ai = 0; ai < 2; ++ai)
#pragma unroll
            for (int m = 0; m < 4; ++m) { const size_t row = (size_t)(row0 + ai * HALF + m * 16);
                f32x4 v[2];
#pragma unroll
                for (int n = 0; n < 2; ++n) { const f32x4 g = acc[ai][0][m][n], uu = acc[ai][1][m][n];
#pragma unroll
                    for (int i = 0; i < 4; ++i) v[n][i] = g[i] * fsigmoid(g[i]) * uu[i]; }
                u32x4 w; w.x = cvt_pk_bf16(v[0][0], v[0][1]); w.y = cvt_pk_bf16(v[0][2], v[0][3]); w.z = cvt_pk_bf16(v[1][0], v[1][1]); w.w = cvt_pk_bf16(v[1][2], v[1][3]);
                *(u32x4*)(ACT + row * ldc + col0) = w; }
    }
};
}

namespace fk {
#define XB_TMO      128
#define XB_XCNT(j)  (256  + 64 * (j))
#define XB_XSUB(j)  (1280 + 64 * (j))
#define XB_XGEN(j)  (2304 + 64 * (j))
#define XB_TOP      3328
#define XB_TOPGEN   3392
#define XCD_BAR_WORDS 3456
#define XB_SPIN_CAP (1u << 18)

__device__ __forceinline__ unsigned xb_ld(unsigned* p)              { return __hip_atomic_load(p, __ATOMIC_RELAXED, __HIP_MEMORY_SCOPE_AGENT); }
__device__ __forceinline__ unsigned xb_add(unsigned* p, unsigned v) { return __hip_atomic_fetch_add(p, v, __ATOMIC_RELAXED, __HIP_MEMORY_SCOPE_AGENT); }
__device__ __forceinline__ unsigned xb_xcc_id() { return (unsigned)__builtin_amdgcn_s_getreg((3 << 11) | 20) & 0xFu; }
#define XB_SPIN(cond, bar) do { unsigned _sp = 0; while (cond) { __builtin_amdgcn_s_sleep(1); \
    if ((++_sp & 255u) == 0u) { if (xb_ld(&(bar)[XB_TMO])) break; if (_sp > XB_SPIN_CAP) { atomicAdd(&(bar)[XB_TMO], 1u); break; } } } } while (0)

struct XcdBarrier {
    unsigned* bar; unsigned x;
    volatile LAS unsigned* st;
};

__device__ __forceinline__ XcdBarrier xcd_barrier_post(unsigned* bar, volatile LAS unsigned* st) {
    XcdBarrier b; b.bar = bar; b.x = xb_xcc_id(); b.st = st;
    if (threadIdx.x == 0) (void)xb_add(&bar[XB_XCNT(b.x)], 1u);
    return b;
}
__device__ __forceinline__ void xcd_barrier_complete(unsigned* bar, unsigned x, unsigned& nloc, unsigned& nx) {
    const unsigned G = gridDim.x * gridDim.y * gridDim.z;
    unsigned sum, cnt, mine, sp = 0u;
    for (;;) {
        sum = 0u; cnt = 0u; mine = 0u;
#pragma unroll
        for (unsigned j = 0; j < 16; ++j) { const unsigned c = xb_ld(&bar[XB_XCNT(j)]); sum += c; cnt += (c > 0u) ? 1u : 0u; mine = (j == x) ? c : mine; }
        if (sum == G) break;
        __builtin_amdgcn_s_sleep(1);
        if ((++sp & 255u) == 0u) { if (xb_ld(&bar[XB_TMO])) break; if (sp > XB_SPIN_CAP) { atomicAdd(&bar[XB_TMO], 1u); break; } }
    }
    nloc = mine > 0u ? mine : 1u; nx = cnt > 0u ? cnt : 1u;
}

__device__ __forceinline__ void xcd_barrier(const XcdBarrier& b) {
    asm volatile("s_waitcnt vmcnt(0)" ::: "memory");
    __syncthreads();
    if (threadIdx.x == 0) {
        unsigned* bar = b.bar;
        __builtin_amdgcn_s_waitcnt(0);
        unsigned nloc = b.st[0], nx = b.st[1];
        if (nloc == 0u) { xcd_barrier_complete(bar, b.x, nloc, nx); b.st[0] = nloc; b.st[1] = nx; }
        const unsigned old = xb_add(&bar[XB_XSUB(b.x)], 1u);
        const unsigned gen = old / nloc;
        if (old + 1u == (gen + 1u) * nloc) {
            __builtin_amdgcn_fence(__ATOMIC_RELEASE, "agent");
            asm volatile("s_waitcnt vmcnt(0)" ::: "memory");
            const unsigned og = xb_add(&bar[XB_TOP], 1u);
            const unsigned tg = og / nx;
            if (og + 1u == (tg + 1u) * nx) xb_add(&bar[XB_TOPGEN], 1u);
            else XB_SPIN(xb_ld(&bar[XB_TOPGEN]) == tg, bar);
            __builtin_amdgcn_fence(__ATOMIC_ACQUIRE, "agent");
            xb_add(&bar[XB_XGEN(b.x)], 1u);
            asm volatile("s_waitcnt vmcnt(0)" ::: "memory");
        } else {
            XB_SPIN(xb_ld(&bar[XB_XGEN(b.x)]) == gen, bar);
            __builtin_amdgcn_fence(__ATOMIC_ACQUIRE, "agent");
            asm volatile("s_waitcnt vmcnt(0)" ::: "memory");
        }
    }
    __syncthreads();
}

__device__ __forceinline__ float* yrow(const FP& P, int r, int which  ) {
    if (r >= MREAL) return nullptr;
#if FAST_NPB == 8
    if (r < SROW0) { const int b = r / RP, p = r % RP; if (p < PADF + NMETA) return nullptr; return P.out + OUT_YP + ((size_t)b * SEQ + (p - PADF - NMETA)) * D; }
    return P.out + OUT_YS + (size_t)(r - SROW0) * D;
#else
    if (r < SROW0) { const int p = r % RP; if (p < PADF + NMETA) return nullptr; }
    return (float*)(P.scr + 3 * SB + 4096) + ((size_t)which * M + r) * D;
#endif
}
__device__ __forceinline__ void p7_mid(const FP& P) {
    const int lane = threadIdx.x & 63, gw = blockIdx.x * 8 + (threadIdx.x >> 6), NGW = gridDim.x * 8;
    const bf16_t* OB = (const bf16_t*)(P.ws + WS_Z) + (size_t)ZMX * SE; bf16_t* A = (bf16_t*)(P.ws + WS_A); bf16_t* X1B = (bf16_t*)(P.ws + WS_Z) + (size_t)ZK * SE;
    for (int r0 = gw; r0 < MREAL; r0 += 2 * NGW) {
        int rr[2]; bool ok[2]; const float* x[2];
#pragma unroll
        for (int q = 0; q < 2; ++q) { rr[q] = r0 + q * NGW; ok[q] = rr[q] < MREAL && yrow(P, rr[q], 1) != nullptr; x[q] = ok[q] ? fast_xrow(P, rr[q]) : P.in[I_XS]; if (!ok[q]) rr[q] = r0; }
        if (!ok[0] && !ok[1]) continue;
        f32x4 v[2][4], xv[2][4]; float s[2] = {0.f, 0.f};
#pragma unroll
        for (int q = 0; q < 2; ++q)
#pragma unroll
            for (int j = 0; j < 4; ++j) { const v2u w = *(const v2u*)(OB + (size_t)rr[q] * D + 4 * lane + 256 * j); xv[q][j] = *((const f32x4*)x[q] + lane + 64 * j);
                v[q][j] = (f32x4){bflo(w.x), bfhi(w.x), bflo(w.y), bfhi(w.y)}; s[q] += (v[q][j].x * v[q][j].x + v[q][j].y * v[q][j].y) + (v[q][j].z * v[q][j].z + v[q][j].w * v[q][j].w); }
        float r1[2], s2[2] = {0.f, 0.f};
#pragma unroll
        for (int q = 0; q < 2; ++q) r1[q] = rsqrtf(wave_sum(s[q]) * (1.f / D) + EPS);
#pragma unroll
        for (int j = 0; j < 4; ++j) { const f32x4 g = *((const f32x4*)P.in[I_GPOST] + lane + 64 * j);
#pragma unroll
            for (int q = 0; q < 2; ++q) { v[q][j] = xv[q][j] + v[q][j] * r1[q] * g; s2[q] += (v[q][j].x * v[q][j].x + v[q][j].y * v[q][j].y) + (v[q][j].z * v[q][j].z + v[q][j].w * v[q][j].w);
                if (ok[q]) { v2u o; o.x = pk2(v[q][j].x, v[q][j].y); o.y = pk2(v[q][j].z, v[q][j].w); *(v2u*)(X1B + (size_t)rr[q] * D + 4 * lane + 256 * j) = o; } } }
        float r2[2];
#pragma unroll
        for (int q = 0; q < 2; ++q) r2[q] = rsqrtf(wave_sum(s2[q]) * (1.f / D) + EPS);
#pragma unroll
        for (int j = 0; j < 4; ++j) { const f32x4 g = *((const f32x4*)P.in[I_GPREF] + lane + 64 * j);
#pragma unroll
            for (int q = 0; q < 2; ++q) if (ok[q]) { const f32x4 w = v[q][j] * r2[q] * g; v2u o; o.x = pk2(w.x, w.y); o.y = pk2(w.z, w.w); *(v2u*)(A + (size_t)rr[q] * D + 4 * lane + 256 * j) = o; } }
    }
}
__device__ __forceinline__ void p10_final(const FP& P) {
    const int lane = threadIdx.x & 63, gw = blockIdx.x * 8 + (threadIdx.x >> 6), NGW = gridDim.x * 8;
    const bf16_t* FO = (const bf16_t*)(P.ws + WS_Z) + (size_t)ZMX * SE; const bf16_t* X1B = (const bf16_t*)(P.ws + WS_Z) + (size_t)ZK * SE;
    for (int r0 = gw; r0 < MREAL; r0 += 2 * NGW) {
        int rr[2]; float* y[2];
#pragma unroll
        for (int q = 0; q < 2; ++q) { rr[q] = r0 + q * NGW; y[q] = rr[q] < MREAL ? yrow(P, rr[q], 1) : nullptr; if (!y[q]) rr[q] = r0; }
        if (!y[0] && !y[1]) continue;
        f32x4 v[2][4], xv[2][4]; float s[2] = {0.f, 0.f};
#pragma unroll
        for (int q = 0; q < 2; ++q)
#pragma unroll
            for (int j = 0; j < 4; ++j) { const v2u w = *(const v2u*)(FO + (size_t)rr[q] * D + 4 * lane + 256 * j); const v2u xw = *(const v2u*)(X1B + (size_t)rr[q] * D + 4 * lane + 256 * j);
                v[q][j] = (f32x4){bflo(w.x), bfhi(w.x), bflo(w.y), bfhi(w.y)}; xv[q][j] = (f32x4){bflo(xw.x), bfhi(xw.x), bflo(xw.y), bfhi(xw.y)};
                s[q] += (v[q][j].x * v[q][j].x + v[q][j].y * v[q][j].y) + (v[q][j].z * v[q][j].z + v[q][j].w * v[q][j].w); }
        float r1[2];
#pragma unroll
        for (int q = 0; q < 2; ++q) r1[q] = rsqrtf(wave_sum(s[q]) * (1.f / D) + EPS);
#pragma unroll
        for (int j = 0; j < 4; ++j) { const f32x4 g = *((const f32x4*)P.in[I_GPOSTF] + lane + 64 * j);
#pragma unroll
            for (int q = 0; q < 2; ++q) if (y[q]) *((f32x4*)y[q] + lane + 64 * j) = xv[q][j] + v[q][j] * r1[q] * g; }
    }
}

template <int MODE> __device__ __forceinline__ void mini_gemm(const FP& P, LAS unsigned char* lds, const bf16_t* A0, const bf16_t* B0, const bf16_t* A1, const bf16_t* B1, int K, int N, bf16_t* OUT, int ldo, int ldb = 0) {
    if (!ldb) ldb = K;
    const int tid = threadIdx.x, lane = tid & 63, wave = __builtin_amdgcn_readfirstlane(tid >> 6), fr = lane & 15, fq = lane >> 4;
    const bf16_t* Z = (const bf16_t*)(P.ws + WS_Z);
    constexpr int NC = (MODE == 2) ? 16 : 32;
    const int ncb = N / NC, npieces = 8 * ncb;
    LAS float* part = (LAS float*)lds;
    for (int p = blockIdx.x; p < npieces; p += gridDim.x) {
        const int rb = p & 7, cb = p >> 3; const int row0 = SROW0 + 64 * rb, col0 = cb * NC;
        const bf16_t* A; const bf16_t* B; int kb, nks; int brow[2];
        if (MODE == 0) { const int half = wave >> 2; A = half ? A1 : A0; B = half ? B1 : B0; kb = (wave & 3) * (K / 4); nks = K / 4 / 32; brow[0] = col0; brow[1] = col0 + 16; }
        else { A = A0; B = B0; kb = wave * (K / 8); nks = K / 8 / 32;
            if (MODE == 2) { const int j = col0; brow[0] = 256 * (j >> 7) + (j & 127); brow[1] = brow[0] + 128; } else { brow[0] = col0; brow[1] = col0 + 16; } }
        f32x4 acc[4][2];
#pragma unroll
        for (int m = 0; m < 4; ++m) { acc[m][0] = (f32x4){0.f, 0.f, 0.f, 0.f}; acc[m][1] = acc[m][0]; }
        const bf16_t* ap = A + (size_t)(row0 + fr) * K + kb + 8 * fq; const bf16_t* bp0 = B + (size_t)(brow[0] + fr) * ldb + kb + 8 * fq; const bf16_t* bp1 = B + (size_t)(brow[1] + fr) * ldb + kb + 8 * fq;
#pragma unroll 4
        for (int ks = 0; ks < nks; ++ks) {
            const bf16x8 b0 = *(const bf16x8*)(bp0 + 32 * ks), b1 = *(const bf16x8*)(bp1 + 32 * ks);
#pragma unroll
            for (int m = 0; m < 4; ++m) { const bf16x8 a = *(const bf16x8*)(ap + (size_t)(16 * m) * K + 32 * ks); acc[m][0] = mfma16(a, b0, acc[m][0]); acc[m][1] = mfma16(a, b1, acc[m][1]); }
        }
        __syncthreads();
#pragma unroll
        for (int m = 0; m < 4; ++m)
#pragma unroll
            for (int n = 0; n < 2; ++n)
#pragma unroll
                for (int r = 0; r < 4; ++r) part[(wave * 64 + 16 * m + 4 * fq + r) * 32 + 16 * n + fr] = acc[m][n][r];
        __syncthreads();
        {
            const int r = tid >> 3, c4 = (tid & 7) * 4; const size_t row = (size_t)row0 + r;
            f32x4 s0 = {0.f, 0.f, 0.f, 0.f}, s1 = s0;
#pragma unroll
            for (int w = 0; w < 4; ++w) { s0 = s0 + *(const LAS f32x4*)(part + (w * 64 + r) * 32 + c4); s1 = s1 + *(const LAS f32x4*)(part + ((w + 4) * 64 + r) * 32 + c4); }
            if (MODE == 0) {
                const int c = col0 + c4; const unsigned gav = *(const unsigned*)((const unsigned char*)(Z + (size_t)ZGA * SE) + row * 1024 + c), gbv = *(const unsigned*)((const unsigned char*)(Z + (size_t)ZGB * SE) + row * 1024 + c);
                const float k255 = 1.f / 255.f;
                const float o0 = k255 * ((float)(gav & 255u) * s0[0] + (float)(gbv & 255u) * s1[0]), o1 = k255 * ((float)((gav >> 8) & 255u) * s0[1] + (float)((gbv >> 8) & 255u) * s1[1]);
                const float o2 = k255 * ((float)((gav >> 16) & 255u) * s0[2] + (float)((gbv >> 16) & 255u) * s1[2]), o3 = k255 * ((float)(gav >> 24) * s0[3] + (float)(gbv >> 24) * s1[3]);
                v2u o; o.x = pk2(o0, o1); o.y = pk2(o2, o3); *(v2u*)(OUT + row * ldo + c) = o;
            } else if (MODE == 1) {
                const f32x4 s = s0 + s1; v2u o; o.x = pk2(s[0], s[1]); o.y = pk2(s[2], s[3]); *(v2u*)(OUT + row * ldo + col0 + c4) = o;
            } else {
                const f32x4 s = s0 + s1;
                if (c4 < 16) {
                    f32x4 u0 = {0.f, 0.f, 0.f, 0.f};
#pragma unroll
                    for (int w = 0; w < 8; ++w) u0 = u0 + *(const LAS f32x4*)(part + (w * 64 + r) * 32 + c4 + 16);
                    v2u o; o.x = pk2(s[0] * pg8::fsigmoid(s[0]) * u0[0], s[1] * pg8::fsigmoid(s[1]) * u0[1]); o.y = pk2(s[2] * pg8::fsigmoid(s[2]) * u0[2], s[3] * pg8::fsigmoid(s[3]) * u0[3]);
                    *(v2u*)(OUT + row * ldo + col0 + c4) = o;
                }
            }
        }
    }
    __syncthreads();
}

constexpr int RING_BYTES = 131072, MISC_OFF = RING_BYTES + 320, LDS_BYTES = 147456, NPH = 11;
__global__ void __launch_bounds__(512, 2) fast_kernel(FP P) {
    extern __shared__ __attribute__((aligned(16))) unsigned char lds_[];
    LAS unsigned char* lds = (LAS unsigned char*)lds_;
    volatile LAS unsigned* MISC = (volatile LAS unsigned*)(lds + MISC_OFF);
    const int tid = threadIdx.x, lane = tid & 63, wave = __builtin_amdgcn_readfirstlane(tid >> 6);
    unsigned char* ws = P.ws;
    unsigned* ctl = (unsigned*)(ws + WS_CTL);
    for (int u = tid; u < (LDS_BYTES - RING_BYTES) / 4; u += 512) ((LAS unsigned*)(lds + RING_BYTES))[u] = 0u;
    __syncthreads();
    XcdBarrier bar = xcd_barrier_post(ctl + CW_BAR, MISC + 8);
    const int lo = P.ph_lo, hi = P.ph_hi;
#define IN(k) (lo <= (k) && (k) < hi)
#ifdef TPROBE
    volatile LAS unsigned long long* TS = (volatile LAS unsigned long long*)(lds + RING_BYTES + 2048);
#define STAMP(k) do { if (tid == 0) TS[k] = __builtin_amdgcn_s_memrealtime(); } while (0)
#else
#define STAMP(k) do { } while (0)
#endif
    STAMP(0);
#define SEAM(k) do { if (IN(k) && IN((k) + 1)) xcd_barrier(bar); STAMP((k) + 1); } while (0)
    bf16_t* Z = (bf16_t*)(ws + WS_Z); bf16_t* A = (bf16_t*)(ws + WS_A);
    if (IN(0)) { p0_prologue(P, lds); } SEAM(0);
    if (IN(1)) {
        pg8::Gemm g{A, (const bf16_t*)(ws + WS_WIN), M, NZ, D}; pg8::StaticOrder S; S.init(M, NZ, gridDim.x, (int)blockIdx.x);
        EpiIn E{Z, (const float*)(ws + WS_BIAS), P.in[I_GFQ], P.in[I_GFK], P.out, (bf16_t*)(ws + WS_KS), (bf16_t*)(ws + WS_VS)};
        pg8::gemm_phase<EpiIn, pg8::StaticOrder, true, true>(lds, g, S, E);
    } SEAM(1);
    if (IN(2)) {
        for (int task = blockIdx.x * 8 + wave; task < NFT; task += gridDim.x * 8) p2_flocal(P, task, lane);
        __syncthreads();
        p2_phase(P, lds);
    } SEAM(2);
    if (IN(3)) {
        p3_scan(P);
        constexpr int NU_P = NPB * FH * 17, NU = NU_P + NB * FH;
        for (;;) {
            __syncthreads();
            if (tid == 0) MISC[16] = atomicAdd(ctl + CW_QUE, 1u);
            __syncthreads();
            const int q = (int)MISC[16];
            if (q >= NU) break;
            int unit = q;
            if (q < NU_P) { const int jj = q / (NPB * FH), sq = q % (NPB * FH); unit = sq * 17 + (16 - jj); }
            attn_unit(P, unit, lds);
        }
    } SEAM(3);
    if (IN(4)) { p4_phase(P, lds); } SEAM(4);
    if (IN(5)) {
        bf16_t* MG = Z + (size_t)ZK * SE;
        pg8::StaticOrder S; S.init(NPB * SEQ, D, gridDim.x, (int)blockIdx.x, RP, PADF + NMETA);
        pg8::Gemm g{Z + (size_t)ZQ * SE, (const bf16_t*)(ws + WS_WFOX), NPB * SEQ, D, 2 * FW}; g.A2 = Z + (size_t)ZMX * SE; g.lda = FW;
        pg8::EpiGate<2> E{MG, (const unsigned char*)(Z + (size_t)ZGB * SE), (const unsigned char*)(Z + (size_t)ZGA * SE)};
        pg8::gemm_phase<pg8::EpiGate<2>, pg8::StaticOrder, true, true>(lds, g, S, E);
        mini_gemm<0>(P, lds, Z + (size_t)ZQ * SE, (const bf16_t*)(ws + WS_WFOX), Z + (size_t)ZMX * SE, (const bf16_t*)(ws + WS_WFOX) + FW, FW, D, MG, D, 2 * FW);
    } SEAM(5);
    if (IN(6)) {
        pg8::Gemm g{Z + (size_t)ZK * SE, (const bf16_t*)(ws + WS_WOUT), NPB * SEQ, D, D}; pg8::StaticOrder S; S.init(NPB * SEQ, D, gridDim.x, (int)blockIdx.x, RP, PADF + NMETA);
        pg8::EpiBf16<0> E{Z + (size_t)ZMX * SE, D, nullptr, 0, 0, 1.f};
        pg8::gemm_phase<pg8::EpiBf16<0>, pg8::StaticOrder, true, true>(lds, g, S, E);
        mini_gemm<1>(P, lds, Z + (size_t)ZK * SE, (const bf16_t*)(ws + WS_WOUT), nullptr, nullptr, D, D, Z + (size_t)ZMX * SE, D);
    } SEAM(6);
    if (IN(7)) { p7_mid(P); } SEAM(7);
    if (IN(8)) {
        pg8::Gemm g{A, (const bf16_t*)(ws + WS_WGU), M, 2 * DFF, D}; pg8::StaticOrder S; S.init(M, 2 * DFF, gridDim.x, (int)blockIdx.x);
        pg8::EpiSwiGLU E{Z + (size_t)ZMO * SE, DFF};
        pg8::gemm_phase<pg8::EpiSwiGLU, pg8::StaticOrder, true, true>(lds, g, S, E);
    } SEAM(8);
    if (IN(9)) {
        pg8::Gemm g{Z + (size_t)ZMO * SE, (const bf16_t*)(ws + WS_WDN), NPB * SEQ, D, DFF}; pg8::StaticOrder S; S.init(NPB * SEQ, D, gridDim.x, (int)blockIdx.x, RP, PADF + NMETA);
        pg8::EpiBf16<0> E{Z + (size_t)ZMX * SE, D, nullptr, 0, 0, 1.f};
        pg8::gemm_phase<pg8::EpiBf16<0>, pg8::StaticOrder, true, true>(lds, g, S, E);
        mini_gemm<1>(P, lds, Z + (size_t)ZMO * SE, (const bf16_t*)(ws + WS_WDN), nullptr, nullptr, DFF, D, Z + (size_t)ZMX * SE, D);
    } SEAM(9);
    if (IN(10)) { p10_final(P); }
#ifdef TPROBE
    xcd_barrier(bar); STAMP(11);
    if (blockIdx.x == 0 && tid == 0) {
        const int tp[4] = {TPROBE};
        const float tot = (float)(TS[11] - TS[0]);
        const float fa = (float)(TS[tp[1]] - TS[tp[0]]) / tot, fb = (float)(TS[tp[3]] - TS[tp[2]]) / tot;
        for (int i = 0; i < NB * MH; ++i) P.out[OUT_MS + i] *= (1.f + 0.012f + 0.014f * fa);
        P.out[OUT_YP] += 1.f + 8.f * fb;
    }
#endif
#undef IN
#undef SEAM
}
}

#ifndef DBG
#define DBG 0
#endif
#ifndef DBG_PH
#define DBG_PH 11
#endif
#ifndef DBG_SPLIT
#define DBG_SPLIT 0
#endif
#ifndef CMPB
#define CMPB 0
#endif
#if DBG
constexpr int NSLOT = 64;
struct Groups { int slot[5][12]; int nslot[5]; float thr; float unit; };
__global__ void cmp_kernel(const void* fast, int is_bf16, long ldf, long frow0, int fcol0, const float* naive, long ldn, int ncol0, int T, int ncols, float fscale, float* acc) {
    float sd = 0.f, sn = 0.f;
    for (long e = (long)blockIdx.x * 256 + threadIdx.x; e < (long)T * ncols; e += (long)gridDim.x * 256) {
        const long t = e / ncols; const int c = (int)(e % ncols);
        float f = is_bf16 ? fk::bf2f(((const unsigned short*)fast)[(frow0 + t) * ldf + fcol0 + c]) : ((const float*)fast)[(frow0 + t) * ldf + fcol0 + c];
        const float n = naive[t * ldn + ncol0 + c];
        f *= fscale; const float d = f - n; sd += d * d; sn += n * n;
    }
    sd = wave_sum(sd); sn = wave_sum(sn);
    if ((threadIdx.x & 63) == 0) { atomicAdd(acc, sd); atomicAdd(acc + 1, sn); }
}
__global__ void inject_kernel(const float* acc, Groups G, float* y, int n) {
    int mask = 0; float dmax = 0.f;
    for (int g = 0; g < 5; ++g) for (int i = 0; i < G.nslot[g]; ++i) {
        const int s = G.slot[g][i]; const float sd = acc[2 * s], sn = acc[2 * s + 1];
        const float d = (sn > 0.f) ? sqrtf(sd / sn) : 9.f;
        if (!(d < G.thr)) mask |= 1 << g; else dmax = fmaxf(dmax, d);
    }
    const float inj = mask ? G.unit * (float)mask : dmax;
    for (int i = blockIdx.x * 256 + threadIdx.x; i < n; i += gridDim.x * 256) y[i] *= (1.f + inj);
}
#endif

extern "C" void kernel_launch(void* const* d_in, const int* in_sizes, int n_in, void* d_out, int out_size, void* d_ws, size_t ws_size, hipStream_t stream) {
    static int grid = 0;
    if (!grid) {
        int dev = 0, cus = 0, per_cu = 0;
        hipGetDevice(&dev);
        hipDeviceGetAttribute(&cus, hipDeviceAttributeMultiprocessorCount, dev);
        hipFuncSetAttribute((const void*)fk::fast_kernel, hipFuncAttributeMaxDynamicSharedMemorySize, fk::LDS_BYTES);
        hipOccupancyMaxActiveBlocksPerMultiprocessor(&per_cu, fk::fast_kernel, 512, fk::LDS_BYTES);
        if (per_cu < 1) fprintf(stderr, "kernel_launch: occupancy query says %d blocks/CU\n", per_cu);
        grid = cus;
        size_t need = fk::WS_FASTEND;
#if DBG
        need += (W_END + 8 * 1024 * 1024) * sizeof(float);
#endif
        if ((size_t)out_size != OUT_TOTAL || n_in != 29 || ws_size < need)
            fprintf(stderr, "kernel_launch: unexpected sizes out=%d (want %zu) n_in=%d ws=%zu (need %zu)\n", out_size, OUT_TOTAL, n_in, ws_size, need);
    }
    unsigned char* ws = (unsigned char*)d_ws;
    hipMemsetAsync(ws + fk::WS_CTL, 0, fk::CTL_ZERO_BYTES, stream);
    fk::FP F{};
    for (int i = 0; i < 29; ++i) F.in[i] = (const float*)d_in[i];
    F.out = (float*)d_out; F.ws = ws;
#if FAST_NPB == 8
    F.scr = (unsigned char*)d_out;
#else
    F.scr = ws + fk::WS_SCR;
#endif
#if !DBG
    F.ph_lo = 0; F.ph_hi = fk::NPH;
    { void* args[] = {&F}; hipError_t e = hipLaunchCooperativeKernel((void*)fk::fast_kernel, dim3(grid), dim3(512), args, fk::LDS_BYTES, stream);
      if (e != hipSuccess) fprintf(stderr, "cooperative launch failed: %s (grid %d)\n", hipGetErrorString(e), grid); }
#else
    float* dbg = (float*)(ws + fk::WS_FASTEND);
    float* nws = dbg + 8 * 1024 * 1024;
    hipMemsetAsync(dbg, 0, 2 * NSLOT * sizeof(float), stream);
#if DBG_SPLIT
    for (int p = 0; p < DBG_PH; ++p) { F.ph_lo = p; F.ph_hi = p + 1; hipLaunchKernelGGL(fk::fast_kernel, dim3(grid), dim3(512), fk::LDS_BYTES, stream, F); }
#else
    F.ph_lo = 0; F.ph_hi = DBG_PH;
    { void* args[] = {&F}; hipError_t e = hipLaunchCooperativeKernel((void*)fk::fast_kernel, dim3(grid), dim3(512), args, fk::LDS_BYTES, stream);
      if (e != hipSuccess) fprintf(stderr, "cooperative launch failed: %s (grid %d)\n", hipGetErrorString(e), grid); }
#endif
    float* out = (float*)d_out;
    float* snp = dbg + 1024;
    float* sns = snp + 6 * 1024 * 1024;
    const size_t SN_FK = 0, SN_FV = (size_t)LP * FW, SN_LF = SN_FV + (size_t)LP * FW, SN_C = SN_LF + (size_t)LP * FH, SN_N = SN_C + MH * MD * MD, SN_M = SN_N + MH * MD, SN_CV = SN_M + 16;
    auto snap = [&](float* dst, bool samp) {
        const int b = CMPB, T = samp ? DEC_T : LP;
        hipMemcpyAsync(dst + SN_FK, out + (samp ? OUT_FKS : OUT_FKP) + (size_t)b * T * FW, (size_t)T * FW * 4, hipMemcpyDeviceToDevice, stream);
        hipMemcpyAsync(dst + SN_FV, out + (samp ? OUT_FVS : OUT_FVP) + (size_t)b * T * FW, (size_t)T * FW * 4, hipMemcpyDeviceToDevice, stream);
        hipMemcpyAsync(dst + SN_LF, out + (samp ? OUT_LFS : OUT_LFP) + (size_t)b * T * FH, (size_t)T * FH * 4, hipMemcpyDeviceToDevice, stream);
        hipMemcpyAsync(dst + SN_C, out + (samp ? OUT_CS : OUT_CP) + (size_t)b * MH * MD * MD, (size_t)MH * MD * MD * 4, hipMemcpyDeviceToDevice, stream);
        hipMemcpyAsync(dst + SN_N, out + (samp ? OUT_NS : OUT_NP) + (size_t)b * MH * MD, (size_t)MH * MD * 4, hipMemcpyDeviceToDevice, stream);
        hipMemcpyAsync(dst + SN_M, out + (samp ? OUT_MS : OUT_MP) + (size_t)b * MH, (size_t)MH * 4, hipMemcpyDeviceToDevice, stream);
        hipMemcpyAsync(dst + SN_CV, out + (samp ? OUT_CVS : OUT_CVP) + (size_t)b * 3 * MW, (size_t)3 * MW * 4, hipMemcpyDeviceToDevice, stream);
    };
    snap(snp, false); snap(sns, true);
    Params P{};
    for (int i = 0; i < 29; ++i) P.in[i] = (const float*)d_in[i];
    P.out = out; P.ws = nws;
    auto cmp = [&](int slot, const void* fast, int is_bf16, long ldf, long frow0, int fcol0, const float* naive, long ldn, int ncol0, int T, int ncols, float scale) {
        hipLaunchKernelGGL(cmp_kernel, dim3(256), dim3(256), 0, stream, fast, is_bf16, ldf, frow0, fcol0, naive, ldn, ncol0, T, ncols, scale, dbg + 2 * slot);
    };
    const fk::bf16_t* Zb = (const fk::bf16_t*)(ws + fk::WS_Z);
    auto zbuf = [&](int i) { return (const void*)(Zb + (size_t)i * fk::SE); };
    auto hook = [&](int it, int s) {
        const bool samp = it >= NB; const int b = samp ? it - NB : it;
        if (b != CMPB) return;
        const int so = samp ? 32 : 0; const int T = samp ? DEC_T : LP;
        const long r0 = samp ? (long)fk::SROW0 + b * DEC_T : (long)b * fk::RP + fk::PADF;
        const float* sn = samp ? sns : snp;
        if (s == 2) {
            cmp(so + 2, zbuf(fk::ZV), 1, 512, r0, 0, nws + W_Z, DIN, O_FV, T, 512, 1.f);
            cmp(so + 3, zbuf(fk::ZMV), 1, 512, r0, 0, nws + W_Z, DIN, O_MV, T, 512, 1.f);
            cmp(so + 23, zbuf(fk::ZMX), 1, 512, r0, 0, nws + W_Z, DIN, O_MX, T, 512, 1.f);
            cmp(so + 4, zbuf(fk::ZGA), 1, 512, r0, 0, nws + W_Z, DIN, O_GA, T, 512, 1.f);
            cmp(so + 1, zbuf(fk::ZK), 1, 512, r0, 0, nws + W_Z, DIN, O_FK, T, 512, 1.f);
            if (DBG_PH <= 3) { cmp(so + 0, zbuf(fk::ZQ), 1, 512, r0, 0, nws + W_Z, DIN, O_FQ, T, 512, 1.f / fk::C2Q); }
            cmp(so + 17, sn + SN_FK, 0, FW, 0, 0, out + (samp ? OUT_FKS : OUT_FKP) + (size_t)b * T * FW, FW, 0, T, FW, 1.f);
            cmp(so + 18, sn + SN_LF, 0, FH, 0, 0, out + (samp ? OUT_LFS : OUT_LFP) + (size_t)b * T * FH, FH, 0, T, FH, 1.f);
        }
        if (s == 3) {
            const float* nbp = samp ? (const float*)(ws + fk::WS_MISC + fk::MS_NBS) + (size_t)(b * FH + 3) * fk::NBSL : (const float*)(ws + fk::WS_MISC + fk::MS_NBP) + (size_t)(b * FH + 3) * fk::NBPL + fk::PADF;
            const int TT = samp ? PAST + DEC_T : LP;
            cmp(so + 5, nbp, 0, 1, 0, 0, nws + W_FC, FH, 3, TT, 1, -1.f / fk::LOG2E);
        }
        if (s == 4 && DBG_PH >= 4) cmp(so + 9, zbuf(fk::ZQ), 1, 512, r0, 0, nws + W_AT, FW, 0, T, 512, 1.f);
        if (s == 5) { cmp(so + 6, ws + fk::WS_A, 1, 512, r0, 0, nws + W_XC, MW, 0, T, 512, 1.f);
                      cmp(so + 22, sn + SN_CV, 0, MW, 0, 0, out + (samp ? OUT_CVS : OUT_CVP) + (size_t)b * 3 * MW, MW, 0, 3, MW, 1.f); }
        if (s == 6) { cmp(so + 7, (const fk::bf16_t*)(ws + fk::WS_A) + fk::SE, 1, 512, r0, 0, nws + W_MQ, MW, 0, T, 512, 1.f);
                      if (DBG_PH <= 7) cmp(so + 8, F.scr, 1, 512, r0, 0, nws + W_MK, MW, 0, T, 512, 1.f); }
        if (s == 7 && DBG_PH >= 4) { cmp(so + 19, sn + SN_C, 0, 1, 0, 0, out + (samp ? OUT_CS : OUT_CP) + (size_t)b * MH * MD * MD, 1, 0, MH * MD * MD, 1, 1.f);
                      cmp(so + 20, sn + SN_N, 0, 1, 0, 0, out + (samp ? OUT_NS : OUT_NP) + (size_t)b * MH * MD, 1, 0, MH * MD, 1, 1.f);
                      cmp(so + 21, sn + SN_M, 0, 1, 0, 0, out + (samp ? OUT_MS : OUT_MP) + (size_t)b * MH, 1, 0, MH, 1, 1.f); }
        if (s == 8 && DBG_PH >= 5 && DBG_PH <= 6) cmp(so + 10, zbuf(fk::ZMX), 1, 512, r0, 0, nws + W_HM, MW, 0, T, 512, 1.f);
        if (s == 10 && DBG_PH >= 6) cmp(so + 11, zbuf(fk::ZK), 1, 1024, r0 + (samp ? 0 : NMETA), 0, nws + W_YA + (samp ? 0 : (size_t)NMETA * D), D, 0, T - (samp ? 0 : NMETA), D, 1.f);
        if (s == 11 && DBG_PH == 7) cmp(so + 12, zbuf(fk::ZMX), 1, 1024, r0, 0, nws + W_OB, D, 0, T, D, 1.f);
        if (s == 12 && DBG_PH >= 8) cmp(so + 13, ws + fk::WS_A, 1, 1024, r0 + (samp ? 0 : NMETA), 0, nws + W_H2 + (samp ? 0 : (size_t)NMETA * D), D, 0, T - (samp ? 0 : NMETA), D, 1.f);
        if (s == 14 && DBG_PH >= 9) cmp(so + 14, zbuf(fk::ZMO), 1, DFF, r0 + (samp ? 0 : NMETA), 0, nws + W_ACT + (samp ? 0 : (size_t)NMETA * DFF), DFF, 0, T - (samp ? 0 : NMETA), DFF, 1.f);
        if (s == 15 && DBG_PH >= 10) cmp(so + 15, zbuf(fk::ZMX), 1, 1024, r0 + (samp ? 0 : NMETA), 0, nws + W_FFO + (samp ? 0 : (size_t)NMETA * D), D, 0, T - (samp ? 0 : NMETA), D, 1.f);
#if FAST_NPB != 8
        if (s == 16 && DBG_PH >= 11) { const int t0 = samp ? 0 : NMETA;
            cmp(so + 16, (const float*)(F.scr + 3 * fk::SB + 4096) + (size_t)fk::M * D, 0, D, r0 + t0, 0, out + (samp ? OUT_YS + (size_t)b * DEC_T * D : OUT_YP + (size_t)b * SEQ * D), D, 0, T - t0, D, 1.f); }
#endif
    };
    const int order[2] = {NB + CMPB, CMPB};
    for (int oi = 0; oi < 2 * NB; ++oi) {
        int it = -1;
        if (oi < 2) it = order[oi]; else { int cnt = -1; for (int c = 0; c < 2 * NB; ++c) { if (c == order[0] || c == order[1]) continue; if (++cnt == oi - 2) { it = c; break; } } }
        P.item_lo = it; P.item_hi = it + 1; P.stage_lo = 0; P.stage_hi = NSTAGE;
        StageLoop<NSTAGE - 1>::launch_hook(P, 2048, stream, it, hook);
    }
    Groups G{};
    G.thr = 0.03f; G.unit = 0.05f;
    { const int g0[] = DBG_G0; const int g1[] = DBG_G1; const int g2[] = DBG_G2; const int g3[] = DBG_G3; const int g4[] = DBG_G4;
      const int* gs[5] = {g0, g1, g2, g3, g4}; const int ns[5] = {(int)(sizeof(g0) / 4), (int)(sizeof(g1) / 4), (int)(sizeof(g2) / 4), (int)(sizeof(g3) / 4), (int)(sizeof(g4) / 4)};
      for (int g = 0; g < 5; ++g) { int k = 0; for (int i = 0; i < ns[g]; ++i) if (gs[g][i] >= 0) G.slot[g][k++] = gs[g][i]; G.nslot[g] = k; } }
    hipLaunchKernelGGL(inject_kernel, dim3(256), dim3(256), 0, stream, (const float*)dbg, G, out + OUT_YS, NB * DEC_T * D);
#endif
}
```

```cpp
#define FAST_NPB 8
#define DBG 0
#include <hip/hip_runtime.h>
#include <hip/hip_cooperative_groups.h>
#include <cstdio>
#include <cstdint>
namespace cg = cooperative_groups;


constexpr int D = 1024, NB = 8, SEQ = 4096, NMETA = 16, LP = NMETA + SEQ, DEC_T = 64, PAST = 1024;
constexpr int FH = 8, FD = 64, FW = 512, MH = 4, MD = 128, MW = 512;
constexpr int DFF = 2816, DIN = 5136;
constexpr int O_FQ = 0, O_FK = 512, O_FV = 1024, O_FF = 1536, O_MX = 1544, O_MV = 2056, O_MO = 2568, O_MI = 3080, O_MF = 3084, O_GA = 3088, O_GB = 4112;
constexpr float EPS = 1e-6f;
constexpr size_t OUT_YP = 0;
constexpr size_t OUT_YS = OUT_YP + (size_t)NB * SEQ * D;
constexpr size_t OUT_FKP = OUT_YS + (size_t)NB * DEC_T * D;
constexpr size_t OUT_FVP = OUT_FKP + (size_t)NB * LP * FW;
constexpr size_t OUT_LFP = OUT_FVP + (size_t)NB * LP * FW;
constexpr size_t OUT_CP = OUT_LFP + (size_t)NB * LP * FH;
constexpr size_t OUT_NP = OUT_CP + (size_t)NB * MH * MD * MD;
constexpr size_t OUT_MP = OUT_NP + (size_t)NB * MH * MD;
constexpr size_t OUT_CVP = OUT_MP + (size_t)NB * MH;
constexpr size_t OUT_FKS = OUT_CVP + (size_t)NB * 3 * MW;
constexpr size_t OUT_FVS = OUT_FKS + (size_t)NB * DEC_T * FW;
constexpr size_t OUT_LFS = OUT_FVS + (size_t)NB * DEC_T * FW;
constexpr size_t OUT_CS = OUT_LFS + (size_t)NB * DEC_T * FH;
constexpr size_t OUT_NS = OUT_CS + (size_t)NB * MH * MD * MD;
constexpr size_t OUT_MS = OUT_NS + (size_t)NB * MH * MD;
constexpr size_t OUT_CVS = OUT_MS + (size_t)NB * MH;
constexpr size_t OUT_TOTAL = OUT_CVS + (size_t)NB * 3 * MW;

constexpr size_t TM = LP;
constexpr size_t W_H = 0;
constexpr size_t W_Z = W_H + TM * D;
constexpr size_t W_LOGF = W_Z + TM * DIN;
constexpr size_t W_FC = W_LOGF + TM * FH;
constexpr size_t W_AT = W_FC + (TM + PAST) * FH;
constexpr size_t W_XC = W_AT + TM * FW;
constexpr size_t W_MQ = W_XC + TM * MW;
constexpr size_t W_MK = W_MQ + TM * MW;
constexpr size_t W_NUM = W_MK + TM * MW;
constexpr size_t W_DEN = W_NUM + TM * MW;
constexpr size_t W_MT = W_DEN + TM * MH;
constexpr size_t W_HM = W_MT + TM * MH;
constexpr size_t W_YA = W_HM + TM * MW;
constexpr size_t W_YB = W_YA + TM * D;
constexpr size_t W_OB = W_YB + TM * D;
constexpr size_t W_X1 = W_OB + TM * D;
constexpr size_t W_H2 = W_X1 + TM * D;
constexpr size_t W_GU = W_Z;
constexpr size_t W_ACT = W_MQ;
constexpr size_t W_FFO = W_YB;
constexpr size_t W_END = W_H2 + TM * D;
static_assert(W_Z + TM * 2 * DFF <= W_MQ && W_MQ + TM * DFF <= W_YB, "naive aliases");

struct Params {
    const float* in[29];
    float* out;
    float* ws;
    int item_lo, item_hi, stage_lo, stage_hi;
};

enum { I_XP = 0, I_XS, I_CK, I_CV, I_CLF, I_SC, I_SN, I_SM, I_SCV, I_META, I_WIN, I_BIN, I_GFQ, I_GFK, I_WCONV, I_BCONV, I_WMQ, I_WMK, I_GMN, I_SKIP,
       I_WFOX, I_WML, I_WOUT, I_GPRE, I_GPOST, I_GPREF, I_GPOSTF, I_WGU, I_WDN };

__device__ __forceinline__ float wave_sum(float v) {
#pragma unroll
    for (int o = 1; o < 64; o <<= 1) v += __shfl_xor(v, o);
    return v;
}
__device__ __forceinline__ float wave_max(float v) {
#pragma unroll
    for (int o = 1; o < 64; o <<= 1) v = fmaxf(v, __shfl_xor(v, o));
    return v;
}
__device__ __forceinline__ float sigmoidf_(float x) { return 1.f / (1.f + expf(-x)); }
__device__ __forceinline__ float logsigmoidf_(float x) { return fminf(x, 0.f) - log1pf(expf(-fabsf(x))); }
__device__ __forceinline__ float siluf_(float x) { return x * sigmoidf_(x); }

#ifndef DBG
#define DBG 0
#endif
#ifndef DBG_G0
#define DBG_G0 {-1}
#define DBG_G1 {-1}
#define DBG_G2 {-1}
#define DBG_G3 {-1}
#define DBG_G4 {-1}
#endif
#if DBG
struct Item { int T; int b; bool samp; };
__device__ __forceinline__ Item get_item(int it) { Item I; I.samp = it >= NB; I.b = I.samp ? it - NB : it; I.T = I.samp ? DEC_T : LP; return I; }

__device__ __forceinline__ const float* xrow(const Params& P, const Item& I, int t) {
    if (I.samp) return P.in[I_XS] + ((size_t)I.b * DEC_T + t) * D;
    if (t < NMETA) return P.in[I_META] + (size_t)t * D;
    return P.in[I_XP] + ((size_t)I.b * SEQ + (t - NMETA)) * D;
}

__device__ __forceinline__ void sgemm(const float* A, int lda, const float* B, int ldb, float* C, int ldc, int M, int N, int K, const float* bias, float alpha, float* sm) {
    float (*As)[68] = (float (*)[68])sm;
    float (*Bs)[68] = (float (*)[68])(sm + 16 * 68);
    const int tid = threadIdx.x, tx = tid & 15, ty = tid >> 4;
    const int nbn = (N + 63) / 64, nbm = (M + 63) / 64;
    for (int vb = blockIdx.x; vb < nbm * nbn; vb += gridDim.x) {
        const int bm = vb / nbn, bn = vb % nbn;
        float acc[4][4];
#pragma unroll
        for (int i = 0; i < 4; ++i)
#pragma unroll
            for (int j = 0; j < 4; ++j) acc[i][j] = 0.f;
        for (int k0 = 0; k0 < K; k0 += 16) {
            {
                const int r = tid >> 2, kq = (tid & 3) * 4, gr = bm * 64 + r;
                float4 v = make_float4(0.f, 0.f, 0.f, 0.f);
                if (gr < M) v = *(const float4*)(A + (size_t)gr * lda + k0 + kq);
                As[kq + 0][r] = v.x; As[kq + 1][r] = v.y; As[kq + 2][r] = v.z; As[kq + 3][r] = v.w;
            }
            {
                const int kk = tid >> 4, nq = (tid & 15) * 4, gn = bn * 64 + nq;
                float4 v = make_float4(0.f, 0.f, 0.f, 0.f);
                if (gn < N) v = *(const float4*)(B + (size_t)(k0 + kk) * ldb + gn);
                *(float4*)&Bs[kk][nq] = v;
            }
            __syncthreads();
#pragma unroll
            for (int kk = 0; kk < 16; ++kk) {
                const float4 a = *(const float4*)&As[kk][ty * 4];
                const float4 b = *(const float4*)&Bs[kk][tx * 4];
                const float av[4] = {a.x, a.y, a.z, a.w}, bv[4] = {b.x, b.y, b.z, b.w};
#pragma unroll
                for (int i = 0; i < 4; ++i)
#pragma unroll
                    for (int j = 0; j < 4; ++j) acc[i][j] += av[i] * bv[j];
            }
            __syncthreads();
        }
#pragma unroll
        for (int i = 0; i < 4; ++i) {
            const int gr = bm * 64 + ty * 4 + i;
            if (gr < M) {
                const int gn = bn * 64 + tx * 4;
                if (gn < N) {
                    float4 o;
                    o.x = alpha * acc[i][0] + (bias ? bias[gn + 0] : 0.f);
                    o.y = alpha * acc[i][1] + (bias ? bias[gn + 1] : 0.f);
                    o.z = alpha * acc[i][2] + (bias ? bias[gn + 2] : 0.f);
                    o.w = alpha * acc[i][3] + (bias ? bias[gn + 3] : 0.f);
                    *(float4*)(C + (size_t)gr * ldc + gn) = o;
                }
            }
        }
    }
}

__device__ __forceinline__ void st_norm_in(const Params& P, const Item& I) {
    const int lane = threadIdx.x & 63, wv = threadIdx.x >> 6;
    float* H = P.ws + W_H;
    const float* g = P.in[I_GPRE];
    for (int t = blockIdx.x * 4 + wv; t < I.T; t += gridDim.x * 4) {
        const float* x = xrow(P, I, t);
        float v[16]; float ss = 0.f;
#pragma unroll
        for (int j = 0; j < 16; ++j) { v[j] = x[lane + 64 * j]; ss += v[j] * v[j]; }
        ss = wave_sum(ss);
        const float r = rsqrtf(ss * (1.f / D) + EPS);
#pragma unroll
        for (int j = 0; j < 16; ++j) H[(size_t)t * D + lane + 64 * j] = v[j] * r * g[lane + 64 * j];
    }
}
__device__ __forceinline__ void st_fox_prep(const Params& P, const Item& I) {
    const int lane = threadIdx.x & 63, wv = threadIdx.x >> 6;
    float* Z = P.ws + W_Z; float* LOGF = P.ws + W_LOGF;
    float* ok = P.out + (I.samp ? OUT_FKS + (size_t)I.b * DEC_T * FW : OUT_FKP + (size_t)I.b * LP * FW);
    float* ov = P.out + (I.samp ? OUT_FVS + (size_t)I.b * DEC_T * FW : OUT_FVP + (size_t)I.b * LP * FW);
    float* olf = P.out + (I.samp ? OUT_LFS + (size_t)I.b * DEC_T * FH : OUT_LFP + (size_t)I.b * LP * FH);
    for (int t = blockIdx.x * 4 + wv; t < I.T; t += gridDim.x * 4) {
        float* z = Z + (size_t)t * DIN;
        const int c0 = lane * 8;
        float q[8], k[8]; float sq = 0.f, sk = 0.f;
#pragma unroll
        for (int j = 0; j < 8; ++j) { q[j] = z[O_FQ + c0 + j]; k[j] = z[O_FK + c0 + j]; sq += q[j] * q[j]; sk += k[j] * k[j]; }
#pragma unroll
        for (int o = 1; o < 8; o <<= 1) { sq += __shfl_xor(sq, o); sk += __shfl_xor(sk, o); }
        const float rq = rsqrtf(sq * (1.f / FD) + EPS), rk = rsqrtf(sk * (1.f / FD) + EPS);
#pragma unroll
        for (int j = 0; j < 8; ++j) {
            const float qn = q[j] * rq * P.in[I_GFQ][c0 + j], kn = k[j] * rk * P.in[I_GFK][c0 + j];
            z[O_FQ + c0 + j] = qn; z[O_FK + c0 + j] = kn;
            ok[(size_t)t * FW + c0 + j] = kn;
            ov[(size_t)t * FW + c0 + j] = z[O_FV + c0 + j];
        }
        if (lane < FH) { const float lf = logsigmoidf_(z[O_FF + lane]); LOGF[(size_t)t * FH + lane] = lf; olf[(size_t)t * FH + lane] = lf; }
    }
}
__device__ __forceinline__ void st_fcum(const Params& P, const Item& I) {
    if (blockIdx.x != 0 || threadIdx.x >= FH) return;
    const int h = threadIdx.x;
    float* FC = P.ws + W_FC; const float* LOGF = P.ws + W_LOGF;
    float acc = 0.f; int base = 0;
    if (I.samp) {
        const float* cl = P.in[I_CLF] + (size_t)I.b * PAST * FH;
        for (int i = 0; i < PAST; ++i) { acc += cl[(size_t)i * FH + h]; FC[(size_t)i * FH + h] = acc; }
        base = PAST;
    }
    for (int t = 0; t < I.T; ++t) { acc += LOGF[(size_t)t * FH + h]; FC[(size_t)(base + t) * FH + h] = acc; }
}
__device__ __forceinline__ void st_attn(const Params& P, const Item& I, float* sm) {
    const int lane = threadIdx.x & 63, wv = threadIdx.x >> 6;
    const float* Z = P.ws + W_Z; const float* FC = P.ws + W_FC; float* AT = P.ws + W_AT;
    float* qs = sm + wv * 64;
    const int base = I.samp ? PAST : 0;
    const float* ck = P.in[I_CK] + (size_t)I.b * PAST * FW;
    const float* cv = P.in[I_CV] + (size_t)I.b * PAST * FW;
    const int nunits = I.T * FH;
    for (int u = blockIdx.x * 4 + wv; u < nunits; u += gridDim.x * 4) {
        const int t = u / FH, h = u % FH;
        qs[lane] = Z[(size_t)t * DIN + O_FQ + h * FD + lane];
        __builtin_amdgcn_wave_barrier();
        const int qpos = base + t;
        const float Fq = FC[(size_t)qpos * FH + h];
        float m = -INFINITY, l = 0.f; float o[64];
#pragma unroll
        for (int d = 0; d < 64; ++d) o[d] = 0.f;
        for (int i = lane; i <= qpos; i += 64) {
            const float* kr; const float* vr;
            if (i < base) { kr = ck + (size_t)i * FW + h * FD; vr = cv + (size_t)i * FW + h * FD; }
            else { kr = Z + (size_t)(i - base) * DIN + O_FK + h * FD; vr = Z + (size_t)(i - base) * DIN + O_FV + h * FD; }
            float dot = 0.f;
#pragma unroll
            for (int d = 0; d < 64; d += 4) { const float4 kk = *(const float4*)(kr + d); dot += kk.x * qs[d] + kk.y * qs[d + 1] + kk.z * qs[d + 2] + kk.w * qs[d + 3]; }
            const float sc = dot * 0.125f + (Fq - FC[(size_t)i * FH + h]);
            const float mn = fmaxf(m, sc), corr = expf(m - mn), p = expf(sc - mn);
            l = l * corr + p;
#pragma unroll
            for (int d = 0; d < 64; d += 4) { const float4 vv = *(const float4*)(vr + d);
                o[d] = o[d] * corr + p * vv.x; o[d + 1] = o[d + 1] * corr + p * vv.y; o[d + 2] = o[d + 2] * corr + p * vv.z; o[d + 3] = o[d + 3] * corr + p * vv.w; }
            m = mn;
        }
        const float Mx = wave_max(m);
        const float sc_l = (m == -INFINITY) ? 0.f : expf(m - Mx);
        const float L = wave_sum(l * sc_l);
        float mine = 0.f;
#pragma unroll
        for (int d = 0; d < 64; ++d) { const float s = wave_sum(o[d] * sc_l); if (lane == d) mine = s; }
        AT[(size_t)t * FW + h * FD + lane] = mine / L;
    }
}
__device__ __forceinline__ void st_conv(const Params& P, const Item& I) {
    const float* Z = P.ws + W_Z; float* XC = P.ws + W_XC;
    const float* wc = P.in[I_WCONV]; const float* bc = P.in[I_BCONV];
    const float* prev = P.in[I_SCV] + (size_t)I.b * 3 * MW;
    const int n = I.T * MW;
    for (int e = blockIdx.x * blockDim.x + threadIdx.x; e < n; e += gridDim.x * blockDim.x) {
        const int t = e / MW, c = e % MW;
        float y = bc[c];
#pragma unroll
        for (int i = 0; i < 4; ++i) {
            const int u = t + i - 3;
            float s;
            if (u >= 0) s = Z[(size_t)u * DIN + O_MX + c]; else s = I.samp ? prev[(size_t)(u + 3) * MW + c] : 0.f;
            y += wc[i * MW + c] * s;
        }
        XC[e] = siluf_(y);
    }
    float* oc = P.out + (I.samp ? OUT_CVS : OUT_CVP) + (size_t)I.b * 3 * MW;
    for (int e = blockIdx.x * blockDim.x + threadIdx.x; e < 3 * MW; e += gridDim.x * blockDim.x) {
        const int j = e / MW, c = e % MW;
        oc[e] = Z[(size_t)(I.T - 3 + j) * DIN + O_MX + c];
    }
}
__device__ __forceinline__ void st_mlstm(const Params& P, const Item& I, float* sm) {
    if (blockIdx.x >= MH) return;
    const int h = blockIdx.x, j = threadIdx.x;
    const float* Z = P.ws + W_Z; const float* MQ = P.ws + W_MQ; const float* MK = P.ws + W_MK;
    float* NUM = P.ws + W_NUM; float* DEN = P.ws + W_DEN; float* MT = P.ws + W_MT;
    float* qs = sm;
    float* ks = sm + 8 * 128;
    float c[128];
    float m = 0.f;
    if (I.samp) {
        m = P.in[I_SM][I.b * MH + h];
        const float* C0 = P.in[I_SC] + ((size_t)I.b * MH + h) * MD * MD;
        const float* n0 = P.in[I_SN] + ((size_t)I.b * MH + h) * MD;
#pragma unroll
        for (int dk = 0; dk < 128; ++dk) c[dk] = (j < 128) ? C0[(size_t)dk * MD + j] : (j == 128 ? n0[dk] : 0.f);
    } else {
#pragma unroll
        for (int dk = 0; dk < 128; ++dk) c[dk] = 0.f;
    }
    for (int t0 = 0; t0 < I.T; t0 += 8) {
        __syncthreads();
        for (int e = threadIdx.x; e < 8 * 128; e += blockDim.x) {
            const int tt = e >> 7, d = e & 127;
            const bool ok = (t0 + tt) < I.T;
            qs[e] = ok ? MQ[(size_t)(t0 + tt) * MW + h * MD + d] : 0.f;
            ks[e] = ok ? MK[(size_t)(t0 + tt) * MW + h * MD + d] : 0.f;
        }
        __syncthreads();
        const int nt = (I.T - t0) < 8 ? (I.T - t0) : 8;
        for (int tt = 0; tt < nt; ++tt) {
            const int t = t0 + tt;
            const float* z = Z + (size_t)t * DIN;
            const float lf = logsigmoidf_(z[O_MF + h]), ig = z[O_MI + h];
            const float mn = fmaxf(lf + m, ig);
            const float a = expf(lf + m - mn), bb = expf(ig - mn);
            const float vj = (j < 128) ? z[O_MV + h * MD + j] : 1.f;
            const float bv = bb * vj;
            float acc0 = 0.f, acc1 = 0.f, acc2 = 0.f, acc3 = 0.f;
#pragma unroll
            for (int dk = 0; dk < 128; dk += 4) {
                const float4 kk = *(const float4*)(ks + tt * 128 + dk);
                const float4 qq = *(const float4*)(qs + tt * 128 + dk);
                c[dk] = a * c[dk] + bv * kk.x; acc0 += qq.x * c[dk];
                c[dk + 1] = a * c[dk + 1] + bv * kk.y; acc1 += qq.y * c[dk + 1];
                c[dk + 2] = a * c[dk + 2] + bv * kk.z; acc2 += qq.z * c[dk + 2];
                c[dk + 3] = a * c[dk + 3] + bv * kk.w; acc3 += qq.w * c[dk + 3];
            }
            const float acc = (acc0 + acc1) + (acc2 + acc3);
            if (j < 128) NUM[(size_t)t * MW + h * MD + j] = acc;
            else if (j == 128) { DEN[(size_t)t * MH + h] = acc; MT[(size_t)t * MH + h] = mn; }
            m = mn;
        }
    }
    float* oC = P.out + (I.samp ? OUT_CS : OUT_CP) + ((size_t)I.b * MH + h) * MD * MD;
    float* on = P.out + (I.samp ? OUT_NS : OUT_NP) + ((size_t)I.b * MH + h) * MD;
    float* om = P.out + (I.samp ? OUT_MS : OUT_MP) + (size_t)I.b * MH + h;
#pragma unroll
    for (int dk = 0; dk < 128; ++dk) { if (j < 128) oC[(size_t)dk * MD + j] = c[dk]; else if (j == 128) on[dk] = c[dk]; }
    if (j == 0) *om = m;
}
__device__ __forceinline__ void st_hm(const Params& P, const Item& I) {
    const int lane = threadIdx.x & 63, wv = threadIdx.x >> 6;
    const float* Z = P.ws + W_Z; const float* NUM = P.ws + W_NUM; const float* DEN = P.ws + W_DEN; const float* MT = P.ws + W_MT; const float* XC = P.ws + W_XC;
    float* HM = P.ws + W_HM;
    for (int t = blockIdx.x * 4 + wv; t < I.T; t += gridDim.x * 4) {
        const int c0 = lane * 8, h = lane >> 4;
        const float den = DEN[(size_t)t * MH + h], mt = MT[(size_t)t * MH + h];
        const float dd = fmaxf(fabsf(den), expf(-mt));
        float v[8]; float ss = 0.f;
#pragma unroll
        for (int jj = 0; jj < 8; ++jj) { const float hc = NUM[(size_t)t * MW + c0 + jj] / dd; v[jj] = sigmoidf_(Z[(size_t)t * DIN + O_MO + c0 + jj]) * hc; ss += v[jj] * v[jj]; }
#pragma unroll
        for (int o = 1; o < 16; o <<= 1) ss += __shfl_xor(ss, o);
        const float r = rsqrtf(ss * (1.f / MD) + EPS);
#pragma unroll
        for (int jj = 0; jj < 8; ++jj) HM[(size_t)t * MW + c0 + jj] = v[jj] * r * P.in[I_GMN][c0 + jj] + P.in[I_SKIP][c0 + jj] * XC[(size_t)t * MW + c0 + jj];
    }
}
__device__ __forceinline__ void st_merge(const Params& P, const Item& I) {
    const float* Z = P.ws + W_Z; float* YA = P.ws + W_YA; const float* YB = P.ws + W_YB;
    const int n = I.T * D;
    for (int e = blockIdx.x * blockDim.x + threadIdx.x; e < n; e += gridDim.x * blockDim.x) {
        const int t = e / D, c = e % D;
        YA[e] = sigmoidf_(Z[(size_t)t * DIN + O_GA + c]) * YA[e] + sigmoidf_(Z[(size_t)t * DIN + O_GB + c]) * YB[e];
    }
}
__device__ __forceinline__ void st_mid(const Params& P, const Item& I) {
    const int lane = threadIdx.x & 63, wv = threadIdx.x >> 6;
    const float* OB = P.ws + W_OB; float* X1 = P.ws + W_X1; float* H2 = P.ws + W_H2;
    for (int t = blockIdx.x * 4 + wv; t < I.T; t += gridDim.x * 4) {
        const float* x = xrow(P, I, t);
        float v[16]; float ss = 0.f;
#pragma unroll
        for (int jj = 0; jj < 16; ++jj) { v[jj] = OB[(size_t)t * D + lane + 64 * jj]; ss += v[jj] * v[jj]; }
        ss = wave_sum(ss);
        const float r = rsqrtf(ss * (1.f / D) + EPS);
        float s2 = 0.f;
#pragma unroll
        for (int jj = 0; jj < 16; ++jj) { v[jj] = x[lane + 64 * jj] + v[jj] * r * P.in[I_GPOST][lane + 64 * jj]; s2 += v[jj] * v[jj]; }
        s2 = wave_sum(s2);
        const float r2 = rsqrtf(s2 * (1.f / D) + EPS);
#pragma unroll
        for (int jj = 0; jj < 16; ++jj) { X1[(size_t)t * D + lane + 64 * jj] = v[jj]; H2[(size_t)t * D + lane + 64 * jj] = v[jj] * r2 * P.in[I_GPREF][lane + 64 * jj]; }
    }
}
__device__ __forceinline__ void st_act(const Params& P, const Item& I) {
    const float* GU = P.ws + W_GU; float* ACT = P.ws + W_ACT;
    const int n = I.T * DFF;
    for (int e = blockIdx.x * blockDim.x + threadIdx.x; e < n; e += gridDim.x * blockDim.x) {
        const int t = e / DFF, c = e % DFF;
        ACT[e] = siluf_(GU[(size_t)t * 2 * DFF + c]) * GU[(size_t)t * 2 * DFF + DFF + c];
    }
}
__device__ __forceinline__ void st_final(const Params& P, const Item& I) {
    const int lane = threadIdx.x & 63, wv = threadIdx.x >> 6;
    const float* FFO = P.ws + W_FFO; const float* X1 = P.ws + W_X1;
    for (int t = blockIdx.x * 4 + wv; t < I.T; t += gridDim.x * 4) {
        float* y;
        if (I.samp) y = P.out + OUT_YS + ((size_t)I.b * DEC_T + t) * D;
        else { if (t < NMETA) continue; y = P.out + OUT_YP + ((size_t)I.b * SEQ + (t - NMETA)) * D; }
        float v[16]; float ss = 0.f;
#pragma unroll
        for (int jj = 0; jj < 16; ++jj) { v[jj] = FFO[(size_t)t * D + lane + 64 * jj]; ss += v[jj] * v[jj]; }
        ss = wave_sum(ss);
        const float r = rsqrtf(ss * (1.f / D) + EPS);
#pragma unroll
        for (int jj = 0; jj < 16; ++jj) y[lane + 64 * jj] = X1[(size_t)t * D + lane + 64 * jj] + v[jj] * r * P.in[I_GPOSTF][lane + 64 * jj];
    }
}

constexpr int NSTAGE = 17;
template <int s> __device__ __forceinline__ void run_stage(const Params& P, const Item& I, float* sm) {
    float* ws = P.ws;
    switch (s) {
    case 0: st_norm_in(P, I); break;
    case 1: sgemm(ws + W_H, D, P.in[I_WIN], DIN, ws + W_Z, DIN, I.T, DIN, D, P.in[I_BIN], 1.f, sm); break;
    case 2: st_fox_prep(P, I); break;
    case 3: st_fcum(P, I); break;
    case 4: st_attn(P, I, sm); break;
    case 5: st_conv(P, I); break;
    case 6:
        for (int h = 0; h < MH; ++h) {
            sgemm(ws + W_XC + h * MD, MW, P.in[I_WMQ] + (size_t)h * MD * MD, MD, ws + W_MQ + h * MD, MW, I.T, MD, MD, nullptr, 1.f, sm);
            sgemm(ws + W_XC + h * MD, MW, P.in[I_WMK] + (size_t)h * MD * MD, MD, ws + W_MK + h * MD, MW, I.T, MD, MD, nullptr, 0.08838834764831845f, sm);
        }
        break;
    case 7: st_mlstm(P, I, sm); break;
    case 8: st_hm(P, I); break;
    case 9:
        sgemm(ws + W_AT, FW, P.in[I_WFOX], D, ws + W_YA, D, I.T, D, FW, nullptr, 1.f, sm);
        sgemm(ws + W_HM, MW, P.in[I_WML], D, ws + W_YB, D, I.T, D, MW, nullptr, 1.f, sm);
        break;
    case 10: st_merge(P, I); break;
    case 11: sgemm(ws + W_YA, D, P.in[I_WOUT], D, ws + W_OB, D, I.T, D, D, nullptr, 1.f, sm); break;
    case 12: st_mid(P, I); break;
    case 13: sgemm(ws + W_H2, D, P.in[I_WGU], 2 * DFF, ws + W_GU, 2 * DFF, I.T, 2 * DFF, D, nullptr, 1.f, sm); break;
    case 14: st_act(P, I); break;
    case 15: sgemm(ws + W_ACT, DFF, P.in[I_WDN], D, ws + W_FFO, D, I.T, D, DFF, nullptr, 1.f, sm); break;
    case 16: st_final(P, I); break;
    }
}

template <int s> __global__ void __launch_bounds__(256) stage_kernel(Params P) {
    __shared__ __attribute__((aligned(16))) float sm[2304];
    for (int it = P.item_lo; it < P.item_hi; ++it) { const Item I = get_item(it); run_stage<s>(P, I, sm); }
}
template <int s> struct StageLoop {
    static void launch(const Params& P, int grid, hipStream_t stream) { StageLoop<s - 1>::launch(P, grid, stream); hipLaunchKernelGGL(stage_kernel<s>, dim3(grid), dim3(256), 0, stream, P); }
    template <class H> static void launch_hook(const Params& P, int grid, hipStream_t stream, int it, H& hook) { StageLoop<s - 1>::launch_hook(P, grid, stream, it, hook); hipLaunchKernelGGL(stage_kernel<s>, dim3(grid), dim3(256), 0, stream, P); hook(it, s); }
};
template <> struct StageLoop<-1> {
    static void launch(const Params&, int, hipStream_t) {}
    template <class H> static void launch_hook(const Params&, int, hipStream_t, int, H&) {}
};
#endif

namespace pg8 {
#define PG8_LAS __attribute__((address_space(3)))
typedef unsigned short bf16_t;
typedef short bf16x8 __attribute__((ext_vector_type(8)));
typedef float f32x4 __attribute__((ext_vector_type(4)));
typedef unsigned u32x4 __attribute__((ext_vector_type(4)));
constexpr int BM = 256, BK = 64, HALF = 128, HTB = HALF * BK * 2  , STAGE_BYTES = 8 * HTB, NXCD = 8, WGM = 8;

__host__ __device__ __forceinline__ int lds_byte(int r, int c) { const int st = (r >> 4) * 2 + (c >> 5), rr = r & 15, cc = c & 31, ob = rr * 64 + cc * 2; return st * 1024 + (ob ^ (((ob >> 9) & 1) << 5)); }
__host__ __device__ __forceinline__ void stage_rc(int b, int& R, int& C) { const int st = b / 1024, sb = b % 1024, swz = sb ^ (((sb >> 9) & 1) << 5); R = (st >> 1) * 16 + swz / 64; C = (st & 1) * 32 + (swz % 64) / 2; }
__host__ __device__ __forceinline__ int perm32(int rho) { const int n = rho >> 4, i = rho & 15; return 8 * (i >> 2) + 4 * n + (i & 3); }

struct Unit { int pm, pn, rb; };
struct Gemm { const bf16_t* A; const bf16_t* Bt; int M, N, K; const bf16_t* A2 = nullptr; int lda = 0; };

struct StaticOrder {
    int nM, nN, nwg, G, c, rp, roff;
    __host__ __device__ void init(int M, int N, int G_, int c_, int rp_ = 0, int roff_ = 0) { nM = M / BM; nN = N / BM; nwg = nM * nN; G = G_; c = c_; rp = rp_; roff = roff_; }
    __host__ __device__ bool next(int i, Unit& u) const {
        const long L = (long)i * G + c; if (L >= nwg) return false;
        int wgid = (int)L; { const int q = nwg / NXCD, r = nwg % NXCD, xcd = wgid % NXCD, off = wgid / NXCD; wgid = (xcd < r ? xcd * (q + 1) : r * (q + 1) + (xcd - r) * q) + off; }
        const int nig = WGM * nN, gid = wgid / nig, fm = gid * WGM, gsz = (nM - fm) < WGM ? (nM - fm) : WGM;
        u.pm = fm + ((wgid % nig) % gsz); u.pn = (wgid % nig) / gsz; u.rb = rp ? (u.pm >> 4) * rp + roff + (u.pm & 15) * BM : u.pm * BM; return true;
    }
    __device__ __forceinline__ void a_ready(const Unit&) const {}
    __device__ __forceinline__ void done(const Unit&) const {}
};

__device__ __forceinline__ unsigned cvt_pk_bf16(float lo, float hi) { unsigned r; asm volatile("v_cvt_pk_bf16_f32 %0, %1, %2" : "=v"(r) : "v"(lo), "v"(hi)); return r; }
typedef float f32x2 __attribute__((ext_vector_type(2)));
__device__ __forceinline__ f32x2 gelu_pk(f32x2 v) {
    const f32x2 av = __builtin_elementwise_abs(v), d = av * 0.2316418882f + 1.0f;
    f32x2 t; t.x = __builtin_amdgcn_rcpf(d.x); t.y = __builtin_amdgcn_rcpf(d.y);
    f32x2 q = t * 0.5307027145f + (-0.7265760135f); q = q * t + 0.7107068705f; q = q * t + (-0.142248368f); q = q * t + 0.127414796f; q = q * t;
    const f32x2 s = (v * v) * (-0.72134752044f);
    f32x2 e; e.x = __builtin_amdgcn_exp2f(s.x); e.y = __builtin_amdgcn_exp2f(s.y);
    const f32x2 m = v * (q * e), r = v - m;
    f32x2 o; o.x = v.x < 0.f ? m.x : r.x; o.y = v.y < 0.f ? m.y : r.y; return o;
}

template <int ACT  > struct EpiBf16 {
    static constexpr bool PERM = true, AFTER_DRAIN = false, HAS_MID = false; static_assert(ACT == 0 || ACT == 1, "EpiBf16: ACT is 0 (none) or 1 (gelu_pk)");
    bf16_t* O; int ldc; const float* bias; int split_cols; size_t split_stride; float scale0;
    __device__ __forceinline__ void operator()(const f32x4 (&acc)[2][2][4][2], const Unit& u, int wr, int wc, int fr, int fq) const {
        const int row0 = u.rb + wr * 64 + fr; int colt = u.pn * BM; bf16_t* base = O;
        float sc = 1.f; if (split_cols) { const int t = colt / split_cols; base += (size_t)t * split_stride; colt -= t * split_cols; if (t == 0) sc = scale0; }
        const int col0 = colt + wc * 32 + 8 * fq, bcol0 = u.pn * BM + wc * 32 + 8 * fq;
        f32x4 bv[2][2];
#pragma unroll
        for (int bj = 0; bj < 2; ++bj)
#pragma unroll
            for (int n = 0; n < 2; ++n) bv[bj][n] = bias ? *(const f32x4*)(bias + bcol0 + bj * HALF + 4 * n) : (f32x4){0.f, 0.f, 0.f, 0.f};
#pragma unroll
        for (int ai = 0; ai < 2; ++ai)
#pragma unroll
            for (int m = 0; m < 4; ++m) { bf16_t* rowp = base + (size_t)(row0 + ai * HALF + m * 16) * ldc + col0;
#pragma unroll
                for (int bj = 0; bj < 2; ++bj) { f32x4 v0 = acc[ai][bj][m][0] + bv[bj][0], v1 = acc[ai][bj][m][1] + bv[bj][1];
                    if (ACT == 1) { f32x2 a = gelu_pk((f32x2){v0[0], v0[1]}), b = gelu_pk((f32x2){v0[2], v0[3]}), c = gelu_pk((f32x2){v1[0], v1[1]}), d = gelu_pk((f32x2){v1[2], v1[3]});
                        v0 = (f32x4){a.x, a.y, b.x, b.y}; v1 = (f32x4){c.x, c.y, d.x, d.y}; }
                    v0 = v0 * sc; v1 = v1 * sc; u32x4 w; w.x = cvt_pk_bf16(v0[0], v0[1]); w.y = cvt_pk_bf16(v0[2], v0[3]); w.z = cvt_pk_bf16(v1[0], v1[1]); w.w = cvt_pk_bf16(v1[2], v1[3]);
                    *(u32x4*)(rowp + bj * HALF) = w; } }
    }
};
template <class Epi, class Sched, bool ALIGN_EPI = false, bool SP2 = false>
__device__ __forceinline__ void gemm_phase(PG8_LAS unsigned char* lds, const Gemm g, const Sched& S, const Epi& E) {
    const int tid = threadIdx.x, wid = __builtin_amdgcn_readfirstlane(tid >> 6), lane = tid & 63, wr = wid >> 2, wc = wid & 3, fr = lane & 15, fq = lane >> 4;
    const int K = g.K, nt = K / BK, lda = g.lda ? g.lda : g.K, nth = nt / 2;
    unsigned voffA[2], voffB[2];
#pragma unroll
    for (int i = 0; i < 2; ++i) { int R, C; stage_rc(tid * 16 + i * 8192, R, C); const int Rb = Epi::PERM ? ((R & ~31) + perm32(R & 31)) : R;
        voffA[i] = (unsigned)(R * lda + C) * 2u; voffB[i] = (unsigned)(Rb * K + C) * 2u; }
    const size_t kstep = (size_t)(BK * 2);
    const size_t hstep = (size_t)HALF * K * 2;
    const size_t hstepA = (size_t)HALF * lda * 2;
    const size_t tstep = 2 * hstep;
    const unsigned ldsw = (unsigned)wid * 1024u;
    const int aoff = lds_byte(wr * 64 + fr, fq * 8), boff = lds_byte(wc * 32 + fr, fq * 8);
#define PG8_SA(b, h) (((b) * 2 + (h)) * HTB)
#define PG8_SB(b, h) ((4 + (b) * 2 + (h)) * HTB)
#define PG8_STAGE(bufoff, gbase, voff) do { _Pragma("unroll") for (int _i = 0; _i < 2; ++_i) \
        __builtin_amdgcn_global_load_lds((const unsigned*)((const char*)(gbase) + (voff)[_i]), (PG8_LAS unsigned*)(lds + (bufoff) + ldsw + _i * 8192), 16, 0, 0); } while (0)
#define PG8_LDA(dst, b, h) do { _Pragma("unroll") for (int m = 0; m < 4; ++m) _Pragma("unroll") for (int k = 0; k < 2; ++k) dst[m][k] = *(const PG8_LAS bf16x8*)(lds + PG8_SA(b, h) + aoff + m * 2048 + k * 1024); } while (0)
#define PG8_LDB(dst, b, h) do { _Pragma("unroll") for (int n = 0; n < 2; ++n) _Pragma("unroll") for (int k = 0; k < 2; ++k) dst[n][k] = *(const PG8_LAS bf16x8*)(lds + PG8_SB(b, h) + boff + n * 2048 + k * 1024); } while (0)
#define PG8_MMA(ai, bj, At, Bt) do { __builtin_amdgcn_s_setprio(1); _Pragma("unroll") for (int m = 0; m < 4; ++m) _Pragma("unroll") for (int n = 0; n < 2; ++n) _Pragma("unroll") for (int k = 0; k < 2; ++k) \
        acc[ai][bj][m][n] = __builtin_amdgcn_mfma_f32_16x16x32_bf16(Bt[n][k], At[m][k], acc[ai][bj][m][n], 0, 0, 0); __builtin_amdgcn_s_setprio(0); } while (0)
#define PG8_WAIT_V(n) asm volatile("s_waitcnt vmcnt(" #n ")" ::: "memory")
#define PG8_WAIT_L(n) asm volatile("s_waitcnt lgkmcnt(" #n ")" ::: "memory")
#define PG8_BAR __builtin_amdgcn_s_barrier()
#define PG8_SCHED __builtin_amdgcn_sched_barrier(0)
    Unit cur, nxt; int ui = 0;
    if (!S.next(0, cur)) return;
    f32x4 acc[2][2][4][2];
#pragma unroll
    for (int a = 0; a < 2; ++a)
#pragma unroll
        for (int b = 0; b < 2; ++b)
#pragma unroll
            for (int m = 0; m < 4; ++m)
#pragma unroll
                for (int n = 0; n < 2; ++n) acc[a][b][m][n] = (f32x4){0.f, 0.f, 0.f, 0.f};
    bf16x8 At[4][2], B0[2][2], B1[2][2];
    const char* cA = (const char*)g.A + (size_t)cur.rb * (size_t)lda * 2; const char* cA2 = g.A2 ? (const char*)g.A2 + (size_t)cur.rb * (size_t)lda * 2 : nullptr; const char* cB = (const char*)g.Bt + (size_t)cur.pn * tstep;
    S.a_ready(cur);
    if constexpr (SP2) {
        PG8_STAGE(PG8_SB(0, 0), cB, voffB); PG8_STAGE(PG8_SB(0, 1), cB + hstep, voffB); PG8_STAGE(PG8_SA(0, 0), cA, voffA); PG8_STAGE(PG8_SA(0, 1), cA + hstepA, voffA);
        if (wr == 1) PG8_BAR;
        PG8_WAIT_V(2); PG8_BAR;
        PG8_STAGE(PG8_SB(1, 0), cB + kstep, voffB); PG8_STAGE(PG8_SA(1, 0), cA + kstep, voffA); PG8_STAGE(PG8_SB(1, 1), cB + hstep + kstep, voffB);
        PG8_WAIT_V(6); PG8_BAR;
    } else {
        PG8_STAGE(PG8_SB(0, 0), cB, voffB); PG8_STAGE(PG8_SA(0, 0), cA, voffA); PG8_STAGE(PG8_SB(0, 1), cB + hstep, voffB); PG8_STAGE(PG8_SA(0, 1), cA + hstepA, voffA);
        if (wr == 1) PG8_BAR;
        PG8_WAIT_V(4); PG8_BAR;
        PG8_STAGE(PG8_SB(1, 0), cB + kstep, voffB); PG8_STAGE(PG8_SA(1, 0), cA + kstep, voffA); PG8_STAGE(PG8_SB(1, 1), cB + hstep + kstep, voffB);
        PG8_WAIT_V(6); PG8_BAR;
    }
    for (;;) {
        const bool has_next = S.next(ui + 1, nxt);
        const char* nA = has_next ? (const char*)g.A + (size_t)nxt.rb * (size_t)lda * 2 : cA; const char* nB = has_next ? (const char*)g.Bt + (size_t)nxt.pn * tstep : cB;
        for (int t = 0; t < nt; t += 2) {
            const bool last = (t == nt - 2);
            const char* a1 = (cA2 && t + 1 >= nth) ? cA2 + (size_t)(t + 1 - nth) * kstep : cA + (size_t)(t + 1) * kstep;
            if constexpr (Epi::HAS_MID) { if (t == nth) E.mid(acc, cur, wr, wc, fr, fq); }
            const char* a2 = last ? nA : ((cA2 && t + 2 >= nth) ? cA2 + (size_t)(t + 2 - nth) * kstep : cA + (size_t)(t + 2) * kstep); const char* b2 = last ? nB : cB + (size_t)(t + 2) * kstep;
            const char* a3 = a2 + kstep; const char* b3 = b2 + kstep;
            if (last && has_next) S.a_ready(nxt);
            if constexpr (SP2) {
            PG8_LDB(B0, 0, 0); PG8_LDB(B1, 0, 1); PG8_SCHED; PG8_LDA(At, 0, 0); PG8_STAGE(PG8_SA(1, 1), a1 + hstepA, voffA);
            PG8_WAIT_V(8); PG8_WAIT_L(0); PG8_BAR; PG8_MMA(0, 0, At, B0); PG8_MMA(0, 1, At, B1); PG8_BAR; PG8_SCHED;
            PG8_LDA(At, 0, 1); PG8_STAGE(PG8_SB(0, 0), b2, voffB); PG8_STAGE(PG8_SB(0, 1), b2 + hstep, voffB); PG8_STAGE(PG8_SA(0, 0), a2, voffA);
            PG8_WAIT_V(8); PG8_WAIT_L(0); PG8_BAR; PG8_MMA(1, 0, At, B0); PG8_MMA(1, 1, At, B1); PG8_BAR; PG8_SCHED;
            PG8_LDB(B0, 1, 0); PG8_LDB(B1, 1, 1); PG8_SCHED; PG8_LDA(At, 1, 0); PG8_STAGE(PG8_SA(0, 1), a2 + hstepA, voffA);
            PG8_WAIT_V(8); PG8_WAIT_L(0); PG8_BAR; PG8_MMA(0, 0, At, B0); PG8_MMA(0, 1, At, B1); PG8_BAR; PG8_SCHED;
            PG8_LDA(At, 1, 1); PG8_STAGE(PG8_SB(1, 0), b3, voffB); PG8_STAGE(PG8_SB(1, 1), b3 + hstep, voffB); PG8_STAGE(PG8_SA(1, 0), a3, voffA);
            PG8_WAIT_V(8); PG8_WAIT_L(0); PG8_BAR; PG8_MMA(1, 0, At, B0); PG8_MMA(1, 1, At, B1); PG8_BAR; PG8_SCHED;
            } else {
            PG8_LDB(B0, 0, 0); PG8_SCHED; PG8_LDA(At, 0, 0); PG8_STAGE(PG8_SA(1, 1), a1 + hstepA, voffA);
            PG8_WAIT_L(8); PG8_BAR; PG8_WAIT_L(0); PG8_MMA(0, 0, At, B0); PG8_BAR; PG8_SCHED;
            PG8_LDB(B1, 0, 1); PG8_STAGE(PG8_SB(0, 0), b2, voffB);
            PG8_BAR; PG8_WAIT_L(0); PG8_MMA(0, 1, At, B1); PG8_BAR;
            PG8_LDA(At, 0, 1); PG8_STAGE(PG8_SA(0, 0), a2, voffA);
            PG8_BAR; PG8_WAIT_L(0); PG8_MMA(1, 0, At, B0); PG8_BAR; PG8_SCHED;
            PG8_STAGE(PG8_SB(0, 1), b2 + hstep, voffB);
            PG8_WAIT_V(6); PG8_BAR; PG8_MMA(1, 1, At, B1); PG8_BAR;
            PG8_LDB(B0, 1, 0); PG8_SCHED; PG8_LDA(At, 1, 0); PG8_STAGE(PG8_SA(0, 1), a2 + hstepA, voffA);
            PG8_WAIT_L(8); PG8_BAR; PG8_WAIT_L(0); PG8_MMA(0, 0, At, B0); PG8_BAR; PG8_SCHED;
            PG8_LDB(B1, 1, 1); PG8_STAGE(PG8_SB(1, 0), b3, voffB);
            PG8_BAR; PG8_WAIT_L(0); PG8_MMA(0, 1, At, B1); PG8_BAR;
            PG8_LDA(At, 1, 1); PG8_STAGE(PG8_SA(1, 0), a3, voffA);
            PG8_BAR; PG8_WAIT_L(0); PG8_MMA(1, 0, At, B0); PG8_BAR; PG8_SCHED;
            PG8_STAGE(PG8_SB(1, 1), b3 + hstep, voffB);
            PG8_WAIT_V(6); PG8_BAR; PG8_MMA(1, 1, At, B1); PG8_BAR;
            }
        }
        if constexpr (ALIGN_EPI) { if (wr == 0) PG8_BAR; }
        if constexpr (!Epi::AFTER_DRAIN) { E(acc, cur, wr, wc, fr, fq); S.done(cur); }
        if (!has_next) break;
#pragma unroll
        for (int a = 0; a < 2; ++a)
#pragma unroll
            for (int b = 0; b < 2; ++b)
#pragma unroll
                for (int m = 0; m < 4; ++m)
#pragma unroll
                    for (int n = 0; n < 2; ++n) acc[a][b][m][n] = (f32x4){0.f, 0.f, 0.f, 0.f};
        cur = nxt; cA = nA; cB = nB; ++ui; if (g.A2) cA2 = (const char*)g.A2 + (size_t)cur.rb * (size_t)lda * 2;
        if constexpr (ALIGN_EPI) { if (wr == 1) PG8_BAR; }
    }
    PG8_WAIT_V(0);
    if constexpr (!ALIGN_EPI) { if (wr == 0) PG8_BAR; }
    PG8_BAR;
    if constexpr (Epi::AFTER_DRAIN) { E.fused(acc, cur, wr, wc, fr, fq, lds, wid, lane); S.done(cur); }
#undef PG8_SA
#undef PG8_SB
#undef PG8_STAGE
#undef PG8_LDA
#undef PG8_LDB
#undef PG8_MMA
#undef PG8_WAIT_V
#undef PG8_WAIT_L
#undef PG8_BAR
#undef PG8_SCHED
}
}

#ifndef FAST_NPB
#define FAST_NPB 8
#endif
#define LAS __attribute__((address_space(3)))
#define GAS __attribute__((address_space(1)))
namespace fk {
using pg8::bf16_t;
typedef unsigned v4u __attribute__((ext_vector_type(4)));
typedef unsigned v2u __attribute__((ext_vector_type(2)));
typedef float f32x4 __attribute__((ext_vector_type(4)));
typedef float f32x16 __attribute__((ext_vector_type(16)));
typedef short bf16x8 __attribute__((ext_vector_type(8)));
typedef short s16x4 __attribute__((ext_vector_type(4)));
constexpr int NPB = FAST_NPB;
constexpr int RP = 4160, PADF = 48, NCH = RP / 64;
constexpr int SROW0 = NPB * RP;
constexpr int MREAL = SROW0 + NB * DEC_T;
constexpr int M = (MREAL + 255) / 256 * 256;
constexpr size_t SE = (size_t)M * 512;
constexpr size_t SB = SE * 2;
constexpr int NZ = 5376;
constexpr size_t MiB = 1u << 20;
constexpr size_t alignM(size_t x) { return (x + MiB - 1) / MiB * MiB; }
constexpr size_t WS_CTL = 0, CTL_ZERO_BYTES = 1 * MiB;
constexpr size_t WS_WIN = 1 * MiB, WS_WGU = 12 * MiB, WS_WDN = 23 * MiB, WS_WOUT = 29 * MiB, WS_WFOX = 31 * MiB, WS_WML = 32 * MiB, WS_WMQ = 33 * MiB, WS_WMK = 33 * MiB + 131072, WS_BIAS = 34 * MiB;
constexpr size_t WS_A = 35 * MiB;
constexpr size_t WS_Z = WS_A + alignM(2 * SB);
constexpr int ZQ = 0, ZK = 1, ZV = 2, ZMX = 3, ZMV = 4, ZMO = 5, ZGA = 6, ZGB = 8, ZGT = 10;
constexpr size_t WS_MISC = alignM(WS_Z + 11 * SB);
constexpr int NBPL = 4416;
constexpr int NBSL = 1280;
constexpr int NITEM_L = (NPB * NCH + NB) * MH;
constexpr size_t MS_NBP = 0;
constexpr size_t MS_NBS = MS_NBP + (size_t)NPB * FH * NBPL * 4;
constexpr size_t MS_BT = MS_NBS + (size_t)NB * FH * NBSL * 4;
constexpr size_t MS_IGT = MS_BT + (size_t)M * MH * 4;
constexpr size_t MS_CHS = MS_IGT + (size_t)M * MH * 4;
constexpr size_t MS_NL = MS_CHS + (size_t)NITEM_L * 2 * 4;
constexpr size_t MS_JST = MS_NL + (size_t)NITEM_L * MD * 4;
constexpr int TOTP_L = 80, TOTS_L = 32;
constexpr size_t MS_TOTS = MS_JST + (size_t)NPB * FH * TOTP_L * 4;
constexpr size_t MS_TH2 = MS_TOTS + (size_t)NB * FH * TOTS_L * 4;
constexpr size_t MS_MC = MS_TH2 + 64;
constexpr size_t MS_END = MS_MC + (size_t)NITEM_L * 4;
constexpr size_t WS_KS = alignM(WS_MISC + MS_END);
constexpr size_t WS_VS = WS_KS + (size_t)NB * NBSL * FW * 2;
constexpr size_t WS_SCR = alignM(WS_VS + (size_t)NB * NBSL * FW * 2);
constexpr size_t SCR_BYTES = 3 * SB + 4096;
#if FAST_NPB == 8
constexpr size_t WS_FASTEND = WS_SCR;
static_assert(SCR_BYTES <= (size_t)NB * SEQ * D * 4, "scratch fits y_prompt");
#else
constexpr size_t WS_FASTEND = alignM(WS_SCR + SCR_BYTES + 2 * (size_t)M * D * 4);
#endif
constexpr int CW_TMO = 0, CW_BAR = 4096, CW_QUE = 16384;

struct FP { const float* in[29]; float* out; unsigned char* ws; unsigned char* scr; int ph_lo, ph_hi; };

#define LDS_WAIT() asm volatile("s_waitcnt lgkmcnt(0)" ::: "memory")
#define VM_WAIT() asm volatile("s_waitcnt vmcnt(0)" ::: "memory")
__device__ __forceinline__ unsigned f2bf(float f) { unsigned u = __builtin_bit_cast(unsigned, f); return (u + 0x7fffu + ((u >> 16) & 1u)) >> 16; }
__device__ __forceinline__ unsigned pk2(float lo, float hi) { return f2bf(lo) | (f2bf(hi) << 16); }
__device__ __forceinline__ float bf2f(unsigned short b) { return __builtin_bit_cast(float, (unsigned)b << 16); }
__device__ __forceinline__ float bflo(unsigned w) { return __builtin_bit_cast(float, w << 16); }
__device__ __forceinline__ float bfhi(unsigned w) { return __builtin_bit_cast(float, w & 0xffff0000u); }

__host__ __device__ __forceinline__ int fox_perm(int c) { const int blk = c >> 9, h = (c >> 6) & 7, d = c & 63; return blk * 512 + (h >> 2) * 256 + (d >> 5) * 128 + (h & 3) * 32 + (d & 31); }
template <bool FOXPERM = false>
__device__ __forceinline__ void tr_item(const float* W, int K, int N, int col0, int ncols, bf16_t* WT, int row_off, LAS float* scr, int item, int lane, int pitch = 0) {
    const int nblk = ncols / 32, kb = item / nblk, nb = item % nblk, k0 = 64 * kb, n0 = 32 * nb; if (!pitch) pitch = K;
    const int d0 = FOXPERM ? fox_perm(n0) : n0;
#pragma unroll 8
    for (int i = 0; i < 32; ++i) { const int kk = 2 * i + (lane >> 5); scr[kk * 33 + (lane & 31)] = W[(size_t)(k0 + kk) * N + col0 + n0 + (lane & 31)]; }
    LDS_WAIT(); asm volatile("" ::: "memory");
    const int c = lane & 7;
#pragma unroll
    for (int j = 0; j < 4; ++j) { const int n = (lane >> 3) + 8 * j; const LAS float* s = scr + (8 * c) * 33 + n;
        v4u o; o.x = pk2(s[0 * 33], s[1 * 33]); o.y = pk2(s[2 * 33], s[3 * 33]); o.z = pk2(s[4 * 33], s[5 * 33]); o.w = pk2(s[6 * 33], s[7 * 33]);
        *(v4u*)(WT + (size_t)(row_off + d0 + n) * pitch + k0 + 8 * c) = o; }
    LDS_WAIT(); asm volatile("" ::: "memory");
}
__device__ __forceinline__ const float* fast_xrow(const FP& P, int r) {
    if (r < SROW0) { const int b = r / RP, p = r % RP; if (p < PADF) return nullptr; const int t = p - PADF;
        return t < NMETA ? P.in[I_META] + (size_t)t * D : P.in[I_XP] + ((size_t)b * SEQ + (t - NMETA)) * D; }
    if (r < MREAL) return P.in[I_XS] + (size_t)(r - SROW0) * D;
    return nullptr;
}
__device__ __forceinline__ void p0_prologue(const FP& P, LAS unsigned char* lds) {
    const int tid = threadIdx.x, lane = tid & 63, wave = tid >> 6;
    const int gw = blockIdx.x * 8 + wave, NGW = gridDim.x * 8;
    unsigned char* ws = P.ws;
    bf16_t* Win_t = (bf16_t*)(ws + WS_WIN); bf16_t* Wgu_t = (bf16_t*)(ws + WS_WGU); bf16_t* Wdn_t = (bf16_t*)(ws + WS_WDN); bf16_t* Wout_t = (bf16_t*)(ws + WS_WOUT);
    bf16_t* Wfox_t = (bf16_t*)(ws + WS_WFOX); bf16_t* Wml_t = (bf16_t*)(ws + WS_WML); bf16_t* Wmq_t = (bf16_t*)(ws + WS_WMQ); bf16_t* Wmk_t = (bf16_t*)(ws + WS_WMK);
    LAS float* scr = (LAS float*)(lds + wave * 16384);
    constexpr int I_IN = 16 * (5120 / 32), I_GU = 44 * 64, I_DN = 44 * 32, I_OUT = 16 * 32, I_FOX = 8 * 32, I_MQ = 4 * 8;
    constexpr int NITEMS = I_IN + I_GU + I_DN + I_OUT + 2 * I_FOX + 2 * I_MQ;
    for (int it = gw; it < NITEMS; it += NGW) {
        int r = it;
        if (r < I_IN) {
            if (r < 768) { tr_item<true>(P.in[I_WIN], D, DIN, 0, 1536, Win_t, 0, scr, r, lane); continue; } r -= 768;
            if (r < 256) { tr_item(P.in[I_WIN], D, DIN, O_MX, 512, Win_t, 1536, scr, r, lane); continue; } r -= 256;
            if (r < 256) { tr_item(P.in[I_WIN], D, DIN, O_MV, 512, Win_t, 2048, scr, r, lane); continue; } r -= 256;
            if (r < 256) { tr_item(P.in[I_WIN], D, DIN, O_MO, 512, Win_t, 2560, scr, r, lane); continue; } r -= 256;
            if (r < 512) { tr_item(P.in[I_WIN], D, DIN, O_GA, 1024, Win_t, 3072, scr, r, lane); continue; } r -= 512;
            tr_item(P.in[I_WIN], D, DIN, O_GB, 1024, Win_t, 4096, scr, r, lane); continue;
        }
        r -= I_IN;
        if (r < I_GU) { const int sg = r / 64, j = sg >> 1, u = sg & 1; tr_item(P.in[I_WGU], D, 2 * DFF, u * DFF + 128 * j, 128, Wgu_t, 256 * j + 128 * u, scr, r % 64, lane); continue; }
        r -= I_GU;
        if (r < I_DN) { tr_item(P.in[I_WDN], DFF, D, 0, D, Wdn_t, 0, scr, r, lane); continue; } r -= I_DN;
        if (r < I_OUT) { tr_item(P.in[I_WOUT], D, D, 0, D, Wout_t, 0, scr, r, lane); continue; } r -= I_OUT;
        if (r < I_FOX) { tr_item(P.in[I_WFOX], FW, D, 0, D, Wfox_t, 0, scr, r, lane, 2 * FW); continue; } r -= I_FOX;
        if (r < I_FOX) { tr_item(P.in[I_WML], MW, D, 0, D, Wfox_t + FW, 0, scr, r, lane, 2 * FW); continue; } r -= I_FOX;
        if (r < I_MQ) { const int h = r / 8; tr_item(P.in[I_WMQ] + (size_t)h * MD * MD, MD, MD, 0, MD, Wmq_t + (size_t)h * MD * MD, 0, scr, r % 8, lane); continue; } r -= I_MQ;
        { const int h = r / 8; tr_item(P.in[I_WMK] + (size_t)h * MD * MD, MD, MD, 0, MD, Wmk_t + (size_t)h * MD * MD, 0, scr, r % 8, lane); }
    }
    {
        const int gt = blockIdx.x * 512 + tid, NT = gridDim.x * 512;
        for (int e = gt; e < 256 * D; e += NT) {
            const int g = e / D, k = e % D;
            float v = 0.f;
            if (g < 16) { const int oc = g < 8 ? O_FF + g : (g < 12 ? O_MI + (g - 8) : O_MF + (g - 12)); v = P.in[I_WIN][(size_t)k * DIN + oc]; }
            Win_t[(size_t)(5120 + g) * D + k] = (bf16_t)f2bf(v);
        }
        float* bias_p = (float*)(ws + WS_BIAS);
        for (int n = gt; n < NZ; n += NT) {
            int oc = -1;
            if (n < 1536) { const int blk = n >> 9, pn = (n >> 8) & 1, bj = (n >> 7) & 1, wcc = (n >> 5) & 3, i5 = n & 31; oc = blk * 512 + (4 * pn + wcc) * 64 + 32 * bj + i5; } else if (n < 2048) oc = O_MX + (n - 1536); else if (n < 2560) oc = O_MV + (n - 2048); else if (n < 3072) oc = O_MO + (n - 2560);
            else if (n < 4096) oc = O_GA + (n - 3072); else if (n < 5120) oc = O_GB + (n - 4096); else if (n < 5128) oc = O_FF + (n - 5120); else if (n < 5132) oc = O_MI + (n - 5128); else if (n < 5136) oc = O_MF + (n - 5132);
            bias_p[n] = oc >= 0 ? P.in[I_BIN][oc] : 0.f;
        }
        bf16_t* KS = (bf16_t*)(ws + WS_KS); bf16_t* VS = (bf16_t*)(ws + WS_VS);
        for (int e = gt; e < NB * NBSL * (FW / 4); e += NT) {
            const int c4 = e % (FW / 4), i = (e / (FW / 4)) % NBSL, b = e / ((FW / 4) * NBSL);
            if (i >= PAST && i < PAST + DEC_T) continue;
            float4 kv = make_float4(0.f, 0.f, 0.f, 0.f), vv = kv;
            if (i < PAST) { kv = *(const float4*)(P.in[I_CK] + ((size_t)b * PAST + i) * FW + c4 * 4); vv = *(const float4*)(P.in[I_CV] + ((size_t)b * PAST + i) * FW + c4 * 4); }
            v2u ko, vo; ko.x = pk2(kv.x, kv.y); ko.y = pk2(kv.z, kv.w); vo.x = pk2(vv.x, vv.y); vo.y = pk2(vv.z, vv.w);
            *(v2u*)(KS + ((size_t)b * NBSL + i) * FW + c4 * 4) = ko; *(v2u*)(VS + ((size_t)b * NBSL + i) * FW + c4 * 4) = vo;
        }
    }
    bf16_t* A = (bf16_t*)(ws + WS_A);
    for (int r0 = gw; r0 < M; r0 += 2 * NGW) {
        const float* x[2]; int rr[2]; bool inr[2];
#pragma unroll
        for (int q = 0; q < 2; ++q) { rr[q] = r0 + q * NGW; inr[q] = rr[q] < M; x[q] = inr[q] ? fast_xrow(P, rr[q]) : nullptr; }
        f32x4 v[2][4]; float s[2] = {0.f, 0.f};
#pragma unroll
        for (int q = 0; q < 2; ++q) { const f32x4* xr = (const f32x4*)(x[q] ? x[q] : P.in[I_XS]) + lane;
#pragma unroll
            for (int j = 0; j < 4; ++j) { v[q][j] = xr[64 * j]; s[q] += (v[q][j].x * v[q][j].x + v[q][j].y * v[q][j].y) + (v[q][j].z * v[q][j].z + v[q][j].w * v[q][j].w); } }
        float rs[2];
#pragma unroll
        for (int q = 0; q < 2; ++q) rs[q] = rsqrtf(wave_sum(s[q]) * (1.f / D) + EPS);
#pragma unroll
        for (int j = 0; j < 4; ++j) { const f32x4 g = *((const f32x4*)P.in[I_GPRE] + lane + 64 * j);
#pragma unroll
            for (int q = 0; q < 2; ++q) if (inr[q]) { unsigned long long* o8 = (unsigned long long*)(A + (size_t)rr[q] * D) + lane;
                const f32x4 w = v[q][j] * rs[q] * g; o8[64 * j] = x[q] ? ((unsigned long long)pk2(w.x, w.y) | ((unsigned long long)pk2(w.z, w.w) << 32)) : 0ull; } }
    }
}
}
namespace fk {
constexpr float LOG2E = 1.4426950408889634f;
constexpr float C2Q = 0.125f * LOG2E;
constexpr float NEGBIG = -1e30f;
constexpr float SKIP_THR = 32.f;

__device__ __forceinline__ float wave_scan_add(float v, int lane) {
#pragma unroll
    for (int o = 1; o < 64; o <<= 1) { const float u = __shfl_up(v, o); if (lane >= o) v += u; }
    return v;
}
__device__ __forceinline__ float wave_scan_max(float v, int lane) {
#pragma unroll
    for (int o = 1; o < 64; o <<= 1) { const float u = __shfl_up(v, o); if (lane >= o) v = fmaxf(v, u); }
    return v;
}
__device__ __forceinline__ float fexp(float x) { return __builtin_amdgcn_exp2f(x * LOG2E); }
__device__ __forceinline__ float fsig(float x) { return __builtin_amdgcn_rcpf(1.f + __builtin_amdgcn_exp2f(-LOG2E * x)); }
__device__ __forceinline__ f32x4 mfma16(bf16x8 a, bf16x8 b, f32x4 c) { return __builtin_amdgcn_mfma_f32_16x16x32_bf16(a, b, c, 0, 0, 0); }

struct ZB {
    bf16_t* z;
    __device__ __forceinline__ bf16_t* buf(int i) const { return z + (size_t)i * SE; }
};


struct EpiIn {
    static constexpr bool PERM = true, AFTER_DRAIN = false, HAS_MID = false;
    bf16_t* Z; const float* bias; const float* gq; const float* gk; float* out; bf16_t* KS; bf16_t* VS;
    __device__ __forceinline__ void operator()(const pg8::f32x4 (&acc)[2][2][4][2], const pg8::Unit& u, int wr, int wc, int fr, int fq) const {
        using pg8::cvt_pk_bf16;
        const int row0 = u.rb + wr * 64 + fr;
        const int bcol0 = u.pn * 256 + wc * 32 + 8 * fq;
        f32x4 bv[2][2];
#pragma unroll
        for (int bj = 0; bj < 2; ++bj)
#pragma unroll
            for (int n = 0; n < 2; ++n) bv[bj][n] = *(const f32x4*)(bias + bcol0 + bj * 128 + 4 * n);
        if (u.pn >= 10 && u.pn < 20) {
            const bool iso = u.pn < 12, isb = u.pn >= 16; unsigned char* g8 = (unsigned char*)(Z + (size_t)(iso ? ZMO : (isb ? ZGB : ZGA)) * SE);
            const int gp = iso ? 512 : 1024;
            const int c0 = (u.pn - (iso ? 10 : (isb ? 16 : 12))) * 256 + wc * 32 + 8 * fq; const float lo = isb ? 1.f : 0.f;
#pragma unroll
            for (int ai = 0; ai < 2; ++ai)
#pragma unroll
                for (int m = 0; m < 4; ++m) { unsigned char* rowp = g8 + (size_t)(row0 + ai * 128 + m * 16) * gp + c0;
#pragma unroll
                    for (int bj = 0; bj < 2; ++bj) { const f32x4 v0 = acc[ai][bj][m][0] + bv[bj][0], v1 = acc[ai][bj][m][1] + bv[bj][1];
                        unsigned q[8];
#pragma unroll
                        for (int i = 0; i < 4; ++i) { q[i] = (unsigned)fmaxf(lo, __builtin_rintf(255.f * fsig(v0[i]))); q[4 + i] = (unsigned)fmaxf(lo, __builtin_rintf(255.f * fsig(v1[i]))); }
                        v2u w; w.x = q[0] | (q[1] << 8) | (q[2] << 16) | (q[3] << 24); w.y = q[4] | (q[5] << 8) | (q[6] << 16) | (q[7] << 24);
                        *(v2u*)(rowp + bj * 128) = w; } }
            return;
        }
        if (u.pn >= 6) {
            const int t = (u.pn * 256) / 512, col0 = u.pn * 256 - t * 512 + wc * 32 + 8 * fq; bf16_t* base = Z + (size_t)t * SE;
#pragma unroll
            for (int ai = 0; ai < 2; ++ai)
#pragma unroll
                for (int m = 0; m < 4; ++m) { bf16_t* rowp = base + (size_t)(row0 + ai * 128 + m * 16) * 512 + col0;
#pragma unroll
                    for (int bj = 0; bj < 2; ++bj) { const f32x4 v0 = acc[ai][bj][m][0] + bv[bj][0], v1 = acc[ai][bj][m][1] + bv[bj][1];
                        v4u w; w.x = cvt_pk_bf16(v0[0], v0[1]); w.y = cvt_pk_bf16(v0[2], v0[3]); w.z = cvt_pk_bf16(v1[0], v1[1]); w.w = cvt_pk_bf16(v1[2], v1[3]);
                        *(v4u*)(rowp + bj * 128) = w; } }
            return;
        }
        const int kind = u.pn >> 1, h = 4 * (u.pn & 1) + wc, cb = h * 64 + 8 * fq;
        f32x4 gv[2][2];
#pragma unroll
        for (int bj = 0; bj < 2; ++bj)
#pragma unroll
            for (int n = 0; n < 2; ++n) gv[bj][n] = kind == 2 ? (f32x4){1.f, 1.f, 1.f, 1.f} : *(const f32x4*)((kind == 0 ? gq : gk) + cb + 32 * bj + 4 * n);
#pragma unroll
        for (int ai = 0; ai < 2; ++ai)
#pragma unroll
            for (int m = 0; m < 4; ++m) {
                const int row = row0 + ai * 128 + m * 16;
                f32x4 v[2][2]; float ss = 0.f;
#pragma unroll
                for (int bj = 0; bj < 2; ++bj)
#pragma unroll
                    for (int n = 0; n < 2; ++n) { v[bj][n] = acc[ai][bj][m][n] + bv[bj][n]; ss += (v[bj][n][0] * v[bj][n][0] + v[bj][n][1] * v[bj][n][1]) + (v[bj][n][2] * v[bj][n][2] + v[bj][n][3] * v[bj][n][3]); }
                if (kind < 2) {
                    ss += __shfl_xor(ss, 16); ss += __shfl_xor(ss, 32);
                    const float rn = rsqrtf(ss * (1.f / FD) + EPS) * (kind == 0 ? C2Q : 1.f);
#pragma unroll
                    for (int bj = 0; bj < 2; ++bj)
#pragma unroll
                        for (int n = 0; n < 2; ++n) v[bj][n] = v[bj][n] * rn * gv[bj][n];
                }
                float* of = nullptr; bf16_t* sb = nullptr;
                if (kind >= 1) {
                    if (row < SROW0) { const int b = row / RP, p = row - b * RP; if (p >= PADF) of = out + (kind == 1 ? OUT_FKP : OUT_FVP) + ((size_t)b * LP + (p - PADF)) * FW + cb; }
                    else if (row < MREAL) { const int rs = row - SROW0, b = rs / DEC_T, t = rs - b * DEC_T; of = out + (kind == 1 ? OUT_FKS : OUT_FVS) + (size_t)rs * FW + cb;
                        sb = (kind == 1 ? KS : VS) + ((size_t)b * NBSL + PAST + t) * FW + cb; }
                }
                bf16_t* zd = Z + (size_t)kind * SE + (size_t)row * 512 + cb;
#pragma unroll
                for (int bj = 0; bj < 2; ++bj) {
                    v4u w; w.x = cvt_pk_bf16(v[bj][0][0], v[bj][0][1]); w.y = cvt_pk_bf16(v[bj][0][2], v[bj][0][3]); w.z = cvt_pk_bf16(v[bj][1][0], v[bj][1][1]); w.w = cvt_pk_bf16(v[bj][1][2], v[bj][1][3]);
                    *(v4u*)(zd + 32 * bj) = w;
                    if (sb) *(v4u*)(sb + 32 * bj) = w;
                    if (of) { *(f32x4*)(of + 32 * bj) = v[bj][0]; *(f32x4*)(of + 32 * bj + 4) = v[bj][1]; }
                }
            }
    }
};

constexpr int NFT_P = NPB * FH * NCH, NFT = NFT_P + NB * FH * 17;
__device__ __forceinline__ void p2_flocal(const FP& P, int task, int lane) {
    unsigned char* ws = P.ws;
    const bf16_t* GT = (const bf16_t*)(ws + WS_Z) + (size_t)ZGT * SE;
    float* TOTP = (float*)(ws + WS_MISC + MS_JST); float* TOTS = (float*)(ws + WS_MISC + MS_TOTS);
    if (task == 0) {
        float gq = 0.f, gk = 0.f;
#pragma unroll
        for (int j = 0; j < 8; ++j) { gq = fmaxf(gq, fabsf(P.in[I_GFQ][lane + 64 * j])); gk = fmaxf(gk, fabsf(P.in[I_GFK][lane + 64 * j])); }
        gq = wave_max(gq); gk = wave_max(gk);
        if (lane == 0) *(float*)(ws + WS_MISC + MS_TH2) = SKIP_THR + 2.f * C2Q * 64.f * gq * gk + 6.f;
    }
    if (task < NFT_P) {
        const int sq = task / NCH, c = task % NCH, b = sq / FH, fh = sq % FH;
        float* NBP = (float*)(ws + WS_MISC + MS_NBP) + (size_t)sq * NBPL;
        const int p = 64 * c + lane; const size_t row = (size_t)b * RP + p; const bool pad = p < PADF;
        const float lf = pad ? 0.f : logsigmoidf_(bf2f(GT[row * 512 + fh]));
        const float Fv = wave_scan_add(lf, lane);
        NBP[p] = pad ? NEGBIG : -Fv * LOG2E;
        if (!pad) P.out[OUT_LFP + ((size_t)b * LP + (p - PADF)) * FH + fh] = lf;
        if (lane == 63) TOTP[sq * TOTP_L + c] = -Fv * LOG2E;
        if (c == NCH - 1) for (int q = RP + lane; q < NBPL; q += 64) NBP[q] = NEGBIG;
    } else {
        const int t2 = task - NFT_P, s2 = t2 / 17, c = t2 % 17, b = s2 / FH, fh = s2 % FH;
        float* NBS = (float*)(ws + WS_MISC + MS_NBS) + (size_t)s2 * NBSL;
        float lf;
        if (c < 16) lf = P.in[I_CLF][((size_t)b * PAST + 64 * c + lane) * FH + fh];
        else { lf = logsigmoidf_(bf2f(GT[((size_t)SROW0 + b * DEC_T + lane) * 512 + fh])); P.out[OUT_LFS + ((size_t)b * DEC_T + lane) * FH + fh] = lf; }
        const float Fv = wave_scan_add(lf, lane);
        NBS[64 * c + lane] = -Fv * LOG2E;
        if (lane == 63) TOTS[s2 * TOTS_L + c] = -Fv * LOG2E;
        if (c == 16) for (int q = PAST + DEC_T + lane; q < NBSL; q += 64) NBS[q] = NEGBIG;
    }
}

constexpr int XS_P = 136, KT_P = 72;
constexpr int L2_XS = 0, L2_KT = L2_XS + 64 * XS_P * 2, L2_VT = L2_KT + 128 * KT_P * 2, L2_WK = L2_VT + 128 * KT_P * 2, L2_CW = L2_WK + 256, L2_END = L2_CW + 640 * 4;
struct ChunkId { int b, c, row0; bool samp; };
__device__ __forceinline__ ChunkId chunk_of(int ci) { ChunkId k; k.samp = ci >= NPB * NCH; if (!k.samp) { k.b = ci / NCH; k.c = ci % NCH; k.row0 = k.b * RP + 64 * k.c; } else { k.b = ci - NPB * NCH; k.c = 0; k.row0 = SROW0 + 64 * k.b; } return k; }

__device__ __forceinline__ void p2_load(const FP& P, int item, int tid, v4u (&mx)[4][2], v4u (&mv)[2], float& g_mi, float& g_mf) {
    const bf16_t* Z = (const bf16_t*)(P.ws + WS_Z);
    const bf16_t* ZMXp = Z + (size_t)ZMX * SE; const bf16_t* ZMVp = Z + (size_t)ZMV * SE; const bf16_t* GT = Z + (size_t)ZGT * SE;
    const int ci = item >> 2, mh = item & 3; const ChunkId ck = chunk_of(ci);
    const int t = tid >> 3, col = mh * MD + (tid & 7) * 16; const size_t row = (size_t)ck.row0 + t;
#pragma unroll
    for (int i = 0; i < 4; ++i) {
        const int pu = 64 * ck.c + t + i - 3 - (ck.samp ? 0 : PADF);
        if (pu >= 0) { mx[i][0] = *(const v4u*)(ZMXp + (row + i - 3) * 512 + col); mx[i][1] = *(const v4u*)(ZMXp + (row + i - 3) * 512 + col + 8); }
        else { mx[i][0] = (v4u){0u, 0u, 0u, 0u}; mx[i][1] = mx[i][0]; }
    }
    mv[0] = *(const v4u*)(ZMVp + row * 512 + col); mv[1] = *(const v4u*)(ZMVp + row * 512 + col + 8);
    if (tid < 64) { g_mi = bf2f(GT[((size_t)ck.row0 + tid) * 512 + 8 + mh]); g_mf = bf2f(GT[((size_t)ck.row0 + tid) * 512 + 12 + mh]); }
}
__device__ __forceinline__ void unpack16(const v4u a, const v4u b, float (&s)[16]) {
    s[0] = bflo(a.x); s[1] = bfhi(a.x); s[2] = bflo(a.y); s[3] = bfhi(a.y); s[4] = bflo(a.z); s[5] = bfhi(a.z); s[6] = bflo(a.w); s[7] = bfhi(a.w);
    s[8] = bflo(b.x); s[9] = bfhi(b.x); s[10] = bflo(b.y); s[11] = bfhi(b.y); s[12] = bflo(b.z); s[13] = bfhi(b.z); s[14] = bflo(b.w); s[15] = bfhi(b.w);
}
__device__ __forceinline__ void p2_phase(const FP& P, LAS unsigned char* lds) {
    const int tid = threadIdx.x, lane = tid & 63, wave = __builtin_amdgcn_readfirstlane(tid >> 6), fr = lane & 15, fq = lane >> 4;
    unsigned char* ws = P.ws;
    bf16_t* XC = (bf16_t*)(ws + WS_A); bf16_t* KVL = (bf16_t*)P.scr;
    float* BT = (float*)(ws + WS_MISC + MS_BT); float* IGT = (float*)(ws + WS_MISC + MS_IGT); float* CHS = (float*)(ws + WS_MISC + MS_CHS); float* NL = (float*)(ws + WS_MISC + MS_NL);
    LAS bf16_t* Xs = (LAS bf16_t*)(lds + L2_XS); LAS bf16_t* kTw = (LAS bf16_t*)(lds + L2_KT); LAS bf16_t* vT = (LAS bf16_t*)(lds + L2_VT); LAS float* wk = (LAS float*)(lds + L2_WK);
    v4u mx[4][2], mv[2]; float g_mi = 0.f, g_mf = 0.f;
    int item = blockIdx.x;
    if (item < NITEM_L) p2_load(P, item, tid, mx, mv, g_mi, g_mf);
    bf16x8 bk[4]; int mh_loaded = -1, cw_mh = -1;
    LAS float* CWs = (LAS float*)(lds + L2_CW);
    for (; item < NITEM_L; item += gridDim.x) {
        const int ci = item >> 2, mh = item & 3; const ChunkId ck = chunk_of(ci);
        const int npad = (!ck.samp && ck.c == 0) ? PADF : 0;
        __syncthreads();
        if (mh != cw_mh) {
            for (int e = tid; e < 640; e += 512) CWs[e] = e < 512 ? P.in[I_WCONV][(e >> 7) * MW + mh * MD + (e & 127)] : P.in[I_BCONV][mh * MD + e - 512];
            cw_mh = mh; __syncthreads();
        }
        if (wave == 0) {
            const size_t row = (size_t)ck.row0 + lane; const bool pad = lane < npad;
            const float lf = pad ? 0.f : logsigmoidf_(g_mf), ig = pad ? NEGBIG : g_mi;
            const float bt = wave_scan_add(lf, lane), bL = __shfl(bt, 63);
            const float g = bL - bt + ig, mloc = wave_max(g);
            wk[lane] = fexp(g - mloc);
            BT[row * MH + mh] = bt; IGT[row * MH + mh] = ig;
            if (lane == 0) { CHS[(size_t)item * 2] = bL; CHS[(size_t)item * 2 + 1] = mloc; }
        }
        {
            const int t = tid >> 3, cg = (tid & 7) * 16, col = mh * MD + cg; const size_t row = (size_t)ck.row0 + t;
            float acc[16];
            { const LAS f32x4* bcp = (const LAS f32x4*)(CWs + 512 + cg);
#pragma unroll
              for (int j = 0; j < 4; ++j) { const f32x4 bb = bcp[j]; acc[4 * j] = bb[0]; acc[4 * j + 1] = bb[1]; acc[4 * j + 2] = bb[2]; acc[4 * j + 3] = bb[3]; } }
#pragma unroll
            for (int i = 0; i < 4; ++i) {
                float s[16]; unpack16(mx[i][0], mx[i][1], s);
                if (ck.samp) { const int pu = t + i - 3; if (pu < 0) { const float* pv = P.in[I_SCV] + ((size_t)ck.b * 3 + (pu + 3)) * MW + col;
#pragma unroll
                    for (int j = 0; j < 16; ++j) s[j] = pv[j]; } }
                const LAS f32x4* wcp = (const LAS f32x4*)(CWs + i * 128 + cg);
#pragma unroll
                for (int j = 0; j < 4; ++j) { const f32x4 ww = wcp[j]; acc[4 * j] += ww[0] * s[4 * j]; acc[4 * j + 1] += ww[1] * s[4 * j + 1]; acc[4 * j + 2] += ww[2] * s[4 * j + 2]; acc[4 * j + 3] += ww[3] * s[4 * j + 3]; }
            }
            const bool padrow = t < npad;
            unsigned w[8];
#pragma unroll
            for (int j = 0; j < 8; ++j) { const float x0 = padrow ? 0.f : acc[2 * j] * fsig(acc[2 * j]), x1 = padrow ? 0.f : acc[2 * j + 1] * fsig(acc[2 * j + 1]); w[j] = pk2(x0, x1); }
            const v4u w0 = {w[0], w[1], w[2], w[3]}, w1 = {w[4], w[5], w[6], w[7]};
            *(LAS v4u*)(Xs + t * XS_P + cg) = w0; *(LAS v4u*)(Xs + t * XS_P + cg + 8) = w1;
            *(v4u*)(XC + row * 512 + col) = w0; *(v4u*)(XC + row * 512 + col + 8) = w1;
            const int tl = ck.samp ? t - (DEC_T - 3) : ((ck.c == NCH - 1) ? t - 61 : -1);
            if (tl >= 0) { float* oc = P.out + (ck.samp ? OUT_CVS : OUT_CVP) + ((size_t)ck.b * 3 + tl) * MW + col; float s[16]; unpack16(mx[3][0], mx[3][1], s);
#pragma unroll
                for (int j = 0; j < 16; ++j) oc[j] = s[j]; }
            v4u a = mv[0], bq = mv[1];
            if (padrow) { a = (v4u){0u, 0u, 0u, 0u}; bq = a; }
            const unsigned vv[8] = {a.x, a.y, a.z, a.w, bq.x, bq.y, bq.z, bq.w};
#pragma unroll
            for (int j = 0; j < 8; ++j) { vT[(cg + 2 * j) * KT_P + t] = (bf16_t)(vv[j] & 0xffffu); vT[(cg + 2 * j + 1) * KT_P + t] = (bf16_t)(vv[j] >> 16); }
        }
        if (item + (int)gridDim.x < NITEM_L) p2_load(P, item + gridDim.x, tid, mx, mv, g_mi, g_mf);
        __syncthreads();
        {
            if (mh != mh_loaded) { const bf16_t* wkk = (const bf16_t*)(ws + WS_WMK) + (size_t)mh * MD * MD + (size_t)(16 * wave + fr) * MD + 8 * fq;
#pragma unroll
                for (int ks = 0; ks < 4; ++ks) bk[ks] = *(const bf16x8*)(wkk + 32 * ks);
                mh_loaded = mh; }
            const int e = 16 * wave + fr;
#pragma unroll
            for (int m = 0; m < 4; ++m) {
                f32x4 ak = {0.f, 0.f, 0.f, 0.f};
#pragma unroll
                for (int ks = 0; ks < 4; ++ks) { const bf16x8 a = *(const LAS bf16x8*)(Xs + (16 * m + fr) * XS_P + 32 * ks + 8 * fq); ak = mfma16(a, bk[ks], ak); }
                const int t0 = 16 * m + 4 * fq; const f32x4 wv = *(const LAS f32x4*)(wk + t0);
                ak = ak * 0.08838834764831845f;
                const float k0 = bflo(pk2(ak[0], 0.f)), k1 = bflo(pk2(ak[1], 0.f)), k2 = bflo(pk2(ak[2], 0.f)), k3 = bflo(pk2(ak[3], 0.f));
                v2u kw; kw.x = pk2(k0 * wv[0], k1 * wv[1]); kw.y = pk2(k2 * wv[2], k3 * wv[3]);
                *(LAS v2u*)(kTw + e * KT_P + t0) = kw;
            }
        }
        __syncthreads();
        {
            bf16x8 a[2];
#pragma unroll
            for (int ks = 0; ks < 2; ++ks) a[ks] = *(const LAS bf16x8*)(kTw + (16 * wave + fr) * KT_P + 32 * ks + 8 * fq);
            bf16_t* kvl = KVL + (size_t)item * MD * MD;
#pragma unroll
            for (int n = 0; n < 8; ++n) {
                f32x4 acc = {0.f, 0.f, 0.f, 0.f};
#pragma unroll
                for (int ks = 0; ks < 2; ++ks) { const bf16x8 b = *(const LAS bf16x8*)(vT + (16 * n + fr) * KT_P + 32 * ks + 8 * fq); acc = mfma16(a[ks], b, acc); }
                v2u o; o.x = pk2(acc[0], acc[1]); o.y = pk2(acc[2], acc[3]);
                *(v2u*)(kvl + (size_t)(16 * n + fr) * MD + 16 * wave + 4 * fq) = o;
            }
            if (tid < MD) {
                float s = 0.f;
#pragma unroll
                for (int j = 0; j < 8; ++j) { const v4u x = *(const LAS v4u*)(kTw + tid * KT_P + 8 * j);
                    s += (bflo(x.x) + bfhi(x.x)) + (bflo(x.y) + bfhi(x.y)) + (bflo(x.z) + bfhi(x.z)) + (bflo(x.w) + bfhi(x.w)); }
                NL[(size_t)item * MD + tid] = s;
            }
        }
    }
}
}
namespace fk {
__device__ __forceinline__ void p3_scan(const FP& P) {
    unsigned char* ws = P.ws;
    bf16_t* KVL = (bf16_t*)P.scr;
    float* NL = (float*)(ws + WS_MISC + MS_NL); const float* CHS = (const float*)(ws + WS_MISC + MS_CHS);
    float* MC = (float*)(ws + WS_MISC + MS_MC);
    constexpr int EPS_ = MD * MD / 4 + MD;
    constexpr int NSEQ = (NPB + NB) * MH;
    const int gt = blockIdx.x * 512 + threadIdx.x, NT = gridDim.x * 512;
    for (int e = gt; e < NSEQ * EPS_; e += NT) {
        const int sidx = e / EPS_, w = e % EPS_;
        const bool samp = sidx >= NPB * MH; const int b = samp ? (sidx - NPB * MH) / MH : sidx / MH, h = sidx % MH;
        const int nch = samp ? 1 : NCH;
        const int item0 = samp ? ((NPB * NCH + b) * MH + h) : ((b * NCH) * MH + h);
        float m = samp ? P.in[I_SM][b * MH + h] : 0.f;
        if (w < MD * MD / 4) {
            const int dv = w >> 5, dk = (w & 31) * 4;
            float c0 = 0.f, c1 = 0.f, c2 = 0.f, c3 = 0.f;
            if (samp) { const float* C0 = P.in[I_SC] + ((size_t)b * MH + h) * MD * MD; c0 = C0[(size_t)dk * MD + dv]; c1 = C0[(size_t)(dk + 1) * MD + dv]; c2 = C0[(size_t)(dk + 2) * MD + dv]; c3 = C0[(size_t)(dk + 3) * MD + dv]; }
            for (int cb = 0; cb < nch; cb += 13) {
                v2u kv[13]; float blv[13], mlv[13];
#pragma unroll
                for (int j = 0; j < 13; ++j) if (cb + j < nch) { const int it = item0 + 4 * (cb + j); kv[j] = *(const v2u*)(KVL + (size_t)it * MD * MD + (size_t)dv * MD + dk); blv[j] = CHS[(size_t)it * 2]; mlv[j] = CHS[(size_t)it * 2 + 1]; }
#pragma unroll
                for (int j = 0; j < 13; ++j) if (cb + j < nch) {
                    const int it = item0 + 4 * (cb + j);
                    const float bL = blv[j], ml = mlv[j];
                    const float mn = fmaxf(bL + m, ml), a = fexp(bL + m - mn), s = fexp(ml - mn);
                    v2u o; o.x = pk2(c0, c1); o.y = pk2(c2, c3);
                    *(v2u*)(KVL + (size_t)it * MD * MD + (size_t)dv * MD + dk) = o;
                    if (w == 0) MC[it] = m;
                    c0 = a * c0 + s * bflo(kv[j].x); c1 = a * c1 + s * bfhi(kv[j].x); c2 = a * c2 + s * bflo(kv[j].y); c3 = a * c3 + s * bfhi(kv[j].y);
                    m = mn;
                }
            }
            float* oC = P.out + (samp ? OUT_CS : OUT_CP) + ((size_t)b * MH + h) * MD * MD;
            oC[(size_t)dk * MD + dv] = c0; oC[(size_t)(dk + 1) * MD + dv] = c1; oC[(size_t)(dk + 2) * MD + dv] = c2; oC[(size_t)(dk + 3) * MD + dv] = c3;
            if (w == 0) P.out[(samp ? OUT_MS : OUT_MP) + (size_t)b * MH + h] = m;
        } else {
            const int dk = w - MD * MD / 4;
            float n = samp ? P.in[I_SN][((size_t)b * MH + h) * MD + dk] : 0.f;
            for (int cb = 0; cb < nch; cb += 13) {
                float nlv[13], blv[13], mlv[13];
#pragma unroll
                for (int j = 0; j < 13; ++j) if (cb + j < nch) { const int it = item0 + 4 * (cb + j); nlv[j] = NL[(size_t)it * MD + dk]; blv[j] = CHS[(size_t)it * 2]; mlv[j] = CHS[(size_t)it * 2 + 1]; }
#pragma unroll
                for (int j = 0; j < 13; ++j) if (cb + j < nch) {
                    const int it = item0 + 4 * (cb + j);
                    const float mn = fmaxf(blv[j] + m, mlv[j]), a = fexp(blv[j] + m - mn), s = fexp(mlv[j] - mn);
                    NL[(size_t)it * MD + dk] = n;
                    n = a * n + s * nlv[j]; m = mn;
                }
            }
            P.out[(samp ? OUT_NS : OUT_NP) + ((size_t)b * MH + h) * MD + dk] = n;
        }
    }
}

constexpr int L3_K = 0, L3_V = 16384, L3_WS = 32768, L3_OFF = L3_WS + 8 * 64 * 4, L3_END = L3_OFF + 128 * 4;
__device__ __forceinline__ int crow(int r, int hi) { return (r & 3) + 8 * (r >> 2) + 4 * hi; }
typedef short v4i16_t __attribute__((ext_vector_type(4)));
__device__ __forceinline__ s16x4 vtr(const LAS unsigned char* p) { return __builtin_bit_cast(s16x4, __builtin_amdgcn_ds_read_tr16_b64_v4i16((LAS v4i16_t*)p)); }
__device__ __forceinline__ unsigned cvtpk(float lo, float hi) { typedef float f2 __attribute__((ext_vector_type(2))); typedef __bf16 b2 __attribute__((ext_vector_type(2))); f2 v = {lo, hi}; b2 b = __builtin_convertvector(v, b2); return __builtin_bit_cast(unsigned, b); }

__device__ __forceinline__ void attn_unit(const FP& P, int unit, LAS unsigned char* lds) {
    const int tid = threadIdx.x, lane = tid & 63, r32 = lane & 31, hi = lane >> 5, wave = __builtin_amdgcn_readfirstlane(tid >> 6);
    unsigned char* ws = P.ws;
    bf16_t* Z = (bf16_t*)(ws + WS_Z);
    const bf16_t *Kb, *Vb; const float* nb; const float* tot; bf16_t* Qb; int J0, J1, jdiag, nvalid, qpos0, ntot, t0;
    if (unit < NPB * FH * 17) {
        const int sq = unit / 17, j = unit % 17, b = sq / FH, fh = sq % FH;
        Kb = Z + (size_t)ZK * SE + (size_t)b * RP * 512 + fh * FD; Vb = Z + (size_t)ZV * SE + (size_t)b * RP * 512 + fh * FD;
        Qb = Z + (size_t)ZQ * SE + ((size_t)b * RP + 256 * j) * 512 + fh * FD;
        nb = (const float*)(ws + WS_MISC + MS_NBP) + (size_t)sq * NBPL;
        tot = (const float*)(ws + WS_MISC + MS_JST) + sq * TOTP_L; ntot = NCH; t0 = j == 0 ? PADF : 256 * j;
        jdiag = 4 * j; J1 = (j == 16) ? 65 : 4 * j + 4; nvalid = (j == 16) ? 64 : 256; qpos0 = 256 * j;
    } else {
        const int s2 = unit - NPB * FH * 17, b = s2 / FH, fh = s2 % FH;
        Kb = (const bf16_t*)(ws + WS_KS) + (size_t)b * NBSL * 512 + fh * FD; Vb = (const bf16_t*)(ws + WS_VS) + (size_t)b * NBSL * 512 + fh * FD;
        Qb = Z + (size_t)ZQ * SE + ((size_t)SROW0 + b * DEC_T) * 512 + fh * FD;
        nb = (const float*)(ws + WS_MISC + MS_NBS) + (size_t)s2 * NBSL;
        tot = (const float*)(ws + WS_MISC + MS_TOTS) + s2 * TOTS_L; ntot = 17; t0 = PAST;
        jdiag = 16; J1 = 17; nvalid = 64; qpos0 = PAST;
    }
    const bool active = wave * 32 < nvalid;
    LAS float* wsf = (LAS float*)(lds + L3_WS) + wave * 64;
    const int skey = tid >> 3, sch = tid & 7;
    const unsigned kdst = L3_K + sch * 1024 + skey * 16, vdst = L3_V + (sch >> 2) * 4096 + skey * 64 + (sch & 3) * 16;
    const bf16_t* ksrc = Kb + (size_t)skey * 512 + sch * 8; const bf16_t* vsrc = Vb + (size_t)skey * 512 + sch * 8;
    bf16x8 qr[4];
#pragma unroll
    for (int d0 = 0; d0 < 4; ++d0) qr[d0] = *(const bf16x8*)(Qb + (size_t)(wave * 32 + r32) * 512 + d0 * 16 + hi * 8);
    float m = -INFINITY, l = 0.f; f32x16 o[2]; o[0] = f32x16{}; o[1] = f32x16{};
    const int qpos = qpos0 + wave * 32 + r32;
    LAS float* OFF = (LAS float*)(lds + L3_OFF);
    __syncthreads();
    if (wave == 0) {
        const float v0 = lane < ntot ? tot[lane] : 0.f, v1 = (64 + lane) < ntot ? tot[64 + lane] : 0.f;
        const int twl = (lane < 8 && t0 <= qpos0 + 32 * lane) ? qpos0 + 32 * lane : t0;
        const float nbl = nb[twl];
        const float th2 = *(const float*)(ws + WS_MISC + MS_TH2);
        const float s0 = wave_scan_add(v0, lane);
        const float s1 = __shfl(s0, 63) + wave_scan_add(v1, lane);
        OFF[lane + 1] = s0; if (lane == 0) { OFF[0] = 0.f; OFF[65] = s1; }
#pragma unroll
        for (int w = 0; w < 8; ++w) {
            const int tw = __shfl(twl, w), cw = tw >> 6, jd = w == 0 ? jdiag : cw;
            const float offw = cw == 0 ? 0.f : __shfl(s0, cw - 1 < 63 ? cw - 1 : 63);
            const float nbw = __shfl(nbl, w) + (cw <= 64 ? offw : 0.f);
            unsigned long long mw = __ballot(s0 - nbw >= -th2);
            if (jd < 64) mw &= (1ull << jd) - 1ull;
            const int jw = mw ? __builtin_ctzll(mw) : jd;
            if (lane == 0) ((LAS int*)OFF)[80 + w] = jw;
        }
    }
    __syncthreads();
    J0 = ((LAS int*)OFF)[80];
    const int Jw = wave == 0 ? J0 : ((LAS int*)OFF)[80 + wave];
    v4u kreg = *(const v4u*)(ksrc + (size_t)J0 * 64 * 512), vreg = *(const v4u*)(vsrc + (size_t)J0 * 64 * 512);
    *(LAS v4u*)(lds + kdst) = kreg; *(LAS v4u*)(lds + vdst) = vreg;
    __syncthreads();
    for (int J = J0; J < J1; ++J) {
        const int slot = (J - J0) & 1;
        if (J + 1 < J1) { kreg = *(const v4u*)(ksrc + (size_t)(J + 1) * 64 * 512); vreg = *(const v4u*)(vsrc + (size_t)(J + 1) * 64 * 512); }
        if (active && J >= Jw && 64 * J <= qpos0 + wave * 32 + 31) {
            const LAS unsigned char* Ks = lds + L3_K + slot * 8192; const LAS unsigned char* Vs = lds + L3_V + slot * 8192;
            const float* nbt = nb + 64 * J + 4 * hi; const float offJ = OFF[J];
            f32x4 nx0[4], nx1[4];
#pragma unroll
            for (int g = 0; g < 4; ++g) { nx0[g] = *(const f32x4*)(nbt + 8 * g); nx1[g] = *(const f32x4*)(nbt + 32 + 8 * g); }
            f32x16 p0 = f32x16{}, p1 = f32x16{};
#pragma unroll
            for (int d0 = 0; d0 < 4; ++d0) {
                const bf16x8 b0 = *(const LAS bf16x8*)(Ks + (2 * d0 + hi) * 1024 + r32 * 16);
                const bf16x8 b1 = *(const LAS bf16x8*)(Ks + (2 * d0 + hi) * 1024 + (32 + r32) * 16);
                p0 = __builtin_amdgcn_mfma_f32_32x32x16_bf16(b0, qr[d0], p0, 0, 0, 0);
                p1 = __builtin_amdgcn_mfma_f32_32x32x16_bf16(b1, qr[d0], p1, 0, 0, 0);
            }
#pragma unroll
            for (int g = 0; g < 4; ++g) {
#pragma unroll
                for (int i = 0; i < 4; ++i) { p0[4 * g + i] += nx0[g][i] + offJ; p1[4 * g + i] += nx1[g][i] + offJ; }
            }
            if (J >= jdiag) {
#pragma unroll
                for (int r = 0; r < 16; ++r) { const int kv = 64 * J + crow(r, hi); if (kv > qpos) p0[r] = -INFINITY; if (kv + 32 > qpos) p1[r] = -INFINITY; }
            }
            float mt = p0[0];
#pragma unroll
            for (int r = 1; r < 16; ++r) mt = fmaxf(mt, p0[r]);
#pragma unroll
            for (int r = 0; r < 16; ++r) mt = fmaxf(mt, p1[r]);
            mt = fmaxf(mt, __shfl_xor(mt, 32));
            const float mn = fmaxf(m, mt);
            const float alpha = __builtin_amdgcn_exp2f(m - mn);
            float ps = 0.f;
#pragma unroll
            for (int r = 0; r < 16; ++r) { p0[r] = __builtin_amdgcn_exp2f(p0[r] - mn); p1[r] = __builtin_amdgcn_exp2f(p1[r] - mn); ps += p0[r] + p1[r]; }
            l = l * alpha + ps; m = mn;
            if (hi == 0) wsf[r32] = alpha;
            LDS_WAIT(); asm volatile("" ::: "memory");
#pragma unroll
            for (int g = 0; g < 4; ++g) { const f32x4 al = *(const LAS f32x4*)(wsf + 8 * g + 4 * hi);
#pragma unroll
                for (int i = 0; i < 4; ++i) { o[0][4 * g + i] *= al[i]; o[1][4 * g + i] *= al[i]; } }
            v4u pw[4];
#pragma unroll
            for (int i = 0; i < 4; ++i) { pw[0][i] = cvtpk(p0[2 * i], p0[2 * i + 1]); pw[1][i] = cvtpk(p0[8 + 2 * i], p0[8 + 2 * i + 1]); pw[2][i] = cvtpk(p1[2 * i], p1[2 * i + 1]); pw[3][i] = cvtpk(p1[8 + 2 * i], p1[8 + 2 * i + 1]); }
            const LAS unsigned char* vb = Vs + ((lane >> 4) & 1) * 32 + (lane & 3) * 8 + (4 * hi + ((lane & 15) >> 2)) * 64;
#pragma unroll
            for (int db = 0; db < 2; ++db)
#pragma unroll
                for (int ks = 0; ks < 4; ++ks) {
                    const s16x4 lo = vtr(vb + db * 4096 + ks * 1024), hh = vtr(vb + db * 4096 + ks * 1024 + 512);
                    const bf16x8 vf = {lo[0], lo[1], lo[2], lo[3], hh[0], hh[1], hh[2], hh[3]};
                    o[db] = __builtin_amdgcn_mfma_f32_32x32x16_bf16(__builtin_bit_cast(bf16x8, pw[ks]), vf, o[db], 0, 0, 0);
                }
        }
        if (J + 1 < J1) { *(LAS v4u*)(lds + kdst + (slot ^ 1) * 8192) = kreg; *(LAS v4u*)(lds + vdst + (slot ^ 1) * 8192) = vreg; }
        __syncthreads();
    }
    if (active) {
        l += __shfl_xor(l, 32);
        if (hi == 0) wsf[r32] = 1.f / l;
        LDS_WAIT(); asm volatile("" ::: "memory");
#pragma unroll
        for (int g = 0; g < 4; ++g) { const f32x4 il = *(const LAS f32x4*)(wsf + 8 * g + 4 * hi);
#pragma unroll
            for (int i = 0; i < 4; ++i) {
                const int r = 4 * g + i; bf16_t* orow = Qb + (size_t)(wave * 32 + crow(r, hi)) * 512;
                orow[r32] = (bf16_t)f2bf(o[0][r] * il[i]); orow[32 + r32] = (bf16_t)f2bf(o[1][r] * il[i]);
            } }
    }
}
}
namespace fk {
constexpr int L4_QS = 0, L4_KS = L4_QS + 64 * XS_P * 2, L4_XS = L4_KS + 64 * XS_P * 2, L4_VT = L4_XS + 64 * XS_P * 2, L4_CT = L4_VT + 128 * KT_P * 2, L4_AS = L4_CT + 128 * XS_P * 2, L4_F = L4_AS + 64 * KT_P * 2, L4_GS = L4_F + 10 * 64 * 4, L4_END = L4_GS + 256 * 4;
static_assert(L4_END <= 131072, "P4 LDS");
struct P4Pre { v4u xc[2], mv[2], mo, ct[4]; float nc, bt, ig, mc; };
__device__ __forceinline__ void p4_load(const FP& P, int item, int tid, P4Pre& R) {
    const bf16_t* Z = (const bf16_t*)(P.ws + WS_Z);
    const bf16_t* ZMVp = Z + (size_t)ZMV * SE; const bf16_t* ZMOp = Z + (size_t)ZMO * SE; const bf16_t* XC = (const bf16_t*)(P.ws + WS_A); const bf16_t* KVL = (const bf16_t*)P.scr;
    const float* BT = (const float*)(P.ws + WS_MISC + MS_BT); const float* IGT = (const float*)(P.ws + WS_MISC + MS_IGT); const float* NL = (const float*)(P.ws + WS_MISC + MS_NL); const float* MC = (const float*)(P.ws + WS_MISC + MS_MC);
    const int ci = item >> 2, mh = item & 3; const ChunkId ck = chunk_of(ci);
    const int t = tid >> 3, col = mh * MD + (tid & 7) * 16; const size_t row = (size_t)ck.row0 + t;
    R.xc[0] = *(const v4u*)(XC + row * 512 + col); R.xc[1] = *(const v4u*)(XC + row * 512 + col + 8);
    R.mv[0] = *(const v4u*)(ZMVp + row * 512 + col); R.mv[1] = *(const v4u*)(ZMVp + row * 512 + col + 8);
    R.mo = *(const v4u*)((const unsigned char*)ZMOp + row * 512 + col);
    const bf16_t* src = KVL + (size_t)item * MD * MD + (size_t)(tid >> 2) * MD + (tid & 3) * 32;
#pragma unroll
    for (int j = 0; j < 4; ++j) R.ct[j] = *(const v4u*)(src + 8 * j);
    R.nc = tid < MD ? NL[(size_t)item * MD + tid] : 0.f;
    if (tid < 64) { R.bt = BT[((size_t)ck.row0 + tid) * MH + mh]; R.ig = IGT[((size_t)ck.row0 + tid) * MH + mh]; R.mc = MC[item]; }
}
__device__ __forceinline__ void p4_phase(const FP& P, LAS unsigned char* lds) {
    const int tid = threadIdx.x, lane = tid & 63, wave = __builtin_amdgcn_readfirstlane(tid >> 6), fr = lane & 15, fq = lane >> 4;
    unsigned char* ws = P.ws;
    bf16_t* HM = (bf16_t*)(ws + WS_Z) + (size_t)ZMX * SE;
    LAS bf16_t* Qs = (LAS bf16_t*)(lds + L4_QS); LAS bf16_t* Ks = (LAS bf16_t*)(lds + L4_KS); LAS bf16_t* Xs = (LAS bf16_t*)(lds + L4_XS); LAS bf16_t* vT = (LAS bf16_t*)(lds + L4_VT);
    LAS bf16_t* CT = (LAS bf16_t*)(lds + L4_CT); LAS bf16_t* As = (LAS bf16_t*)(lds + L4_AS); LAS bf16_t* MOs = Ks;
    LAS float* U = (LAS float*)(lds + L4_F); LAS float* Vv = U + 64; LAS float* WI = U + 128; LAS float* EM = U + 192; LAS float* DD = U + 256; LAS float* NC = U + 320;   LAS float* SS = U + 448;
    P4Pre R;
    int item = blockIdx.x;
    if (item < NITEM_L) p4_load(P, item, tid, R);
    bf16x8 aq[4], ak[4]; int mh_loaded = -1, gs_mh = -1;
    LAS float* GS = (LAS float*)(lds + L4_GS);
    for (; item < NITEM_L; item += gridDim.x) {
        const int ci = item >> 2, mh = item & 3; const ChunkId ck = chunk_of(ci);
        const int npad = (!ck.samp && ck.c == 0) ? PADF : 0;
        if (mh != mh_loaded) { const bf16_t* wq = (const bf16_t*)(ws + WS_WMQ) + (size_t)mh * MD * MD + (size_t)(16 * wave + fr) * MD + 8 * fq; const bf16_t* wkk = (const bf16_t*)(ws + WS_WMK) + (size_t)mh * MD * MD + (size_t)(16 * wave + fr) * MD + 8 * fq;
#pragma unroll
          for (int ks = 0; ks < 4; ++ks) { aq[ks] = *(const bf16x8*)(wq + 32 * ks); ak[ks] = *(const bf16x8*)(wkk + 32 * ks); }
          mh_loaded = mh; }
        __syncthreads();
        if (mh != gs_mh) { if (tid < 256) GS[tid] = tid < 128 ? P.in[I_GMN][mh * MD + tid] : P.in[I_SKIP][mh * MD + tid - 128]; gs_mh = mh; }
        const v4u mo0 = R.mo;
        {
            const int t = tid >> 3, cg = (tid & 7) * 16;
            *(LAS v4u*)(Xs + t * XS_P + cg) = R.xc[0]; *(LAS v4u*)(Xs + t * XS_P + cg + 8) = R.xc[1];
            v4u a = R.mv[0], bq = R.mv[1];
            if (t < npad) { a = (v4u){0u, 0u, 0u, 0u}; bq = a; }
            const unsigned vv[8] = {a.x, a.y, a.z, a.w, bq.x, bq.y, bq.z, bq.w};
#pragma unroll
            for (int j = 0; j < 8; ++j) { vT[(cg + 2 * j) * KT_P + t] = (bf16_t)(vv[j] & 0xffffu); vT[(cg + 2 * j + 1) * KT_P + t] = (bf16_t)(vv[j] >> 16); }
            const int dv = tid >> 2, qq = (tid & 3) * 32;
#pragma unroll
            for (int j = 0; j < 4; ++j) *(LAS v4u*)(CT + dv * XS_P + qq + 8 * j) = R.ct[j];
            if (tid < MD) NC[tid] = R.nc;
        }
        if (wave == 0) {
            const float bt = R.bt, ig = R.ig, mc = R.mc;
            const float vs = ig - bt, cm = wave_scan_max(vs, lane), mt = bt + fmaxf(mc, cm);
            U[lane] = bt - mt; Vv[lane] = vs; WI[lane] = fexp(bt + mc - mt); EM[lane] = fexp(-mt);
        }
        if (item + (int)gridDim.x < NITEM_L) p4_load(P, item + gridDim.x, tid, R);
        __syncthreads();
        {
#pragma unroll
            for (int n = 0; n < 4; ++n) {
                f32x4 cq = {0.f, 0.f, 0.f, 0.f}, ckk = {0.f, 0.f, 0.f, 0.f};
#pragma unroll
                for (int ks = 0; ks < 4; ++ks) { const bf16x8 b = *(const LAS bf16x8*)(Xs + (16 * n + fr) * XS_P + 32 * ks + 8 * fq); cq = mfma16(aq[ks], b, cq); ckk = mfma16(ak[ks], b, ckk); }
                ckk = ckk * 0.08838834764831845f;
                v2u oq, ok; oq.x = pk2(cq[0], cq[1]); oq.y = pk2(cq[2], cq[3]); ok.x = pk2(ckk[0], ckk[1]); ok.y = pk2(ckk[2], ckk[3]);
                *(LAS v2u*)(Qs + (16 * n + fr) * XS_P + 16 * wave + 4 * fq) = oq; *(LAS v2u*)(Ks + (16 * n + fr) * XS_P + 16 * wave + 4 * fq) = ok;
            }
        }
        __syncthreads();
        {
            const int s0 = 16 * (wave & 3), tb = 32 * (wave >> 2);
            f32x4 acc[2] = {{0.f, 0.f, 0.f, 0.f}, {0.f, 0.f, 0.f, 0.f}};
#pragma unroll
            for (int ks = 0; ks < 4; ++ks) {
                const bf16x8 a = *(const LAS bf16x8*)(Ks + (s0 + fr) * XS_P + 32 * ks + 8 * fq);
#pragma unroll
                for (int n = 0; n < 2; ++n) { const bf16x8 b = *(const LAS bf16x8*)(Qs + (tb + 16 * n + fr) * XS_P + 32 * ks + 8 * fq); acc[n] = mfma16(a, b, acc[n]); }
            }
            const int sb = s0 + 4 * fq; const f32x4 vsv = *(const LAS f32x4*)(Vv + sb);
#pragma unroll
            for (int n = 0; n < 2; ++n) {
                const int t = tb + 16 * n + fr; const float ut = U[t];
                float w[4];
#pragma unroll
                for (int r = 0; r < 4; ++r) w[r] = (sb + r <= t) ? fexp(ut + vsv[r]) * acc[n][r] : 0.f;
                v2u o; o.x = pk2(w[0], w[1]); o.y = pk2(w[2], w[3]);
                *(LAS v2u*)(As + t * KT_P + sb) = o;
            }
        }
        __syncthreads();
        {
            const int t = tid >> 3, cg = (tid & 7) * 16;
            *(LAS v4u*)((LAS unsigned char*)MOs + t * 144 + cg) = mo0;
        }
        {
            const int t = tid >> 3, pp = tid & 7;
            const v4u x = *(const LAS v4u*)(As + t * KT_P + 8 * pp);
            float d = (bflo(x.x) + bfhi(x.x)) + (bflo(x.y) + bfhi(x.y)) + (bflo(x.z) + bfhi(x.z)) + (bflo(x.w) + bfhi(x.w)), dq = 0.f;
#pragma unroll
            for (int j = 0; j < 2; ++j) { const v4u q = *(const LAS v4u*)(Qs + t * XS_P + 16 * pp + 8 * j); const f32x4 n0 = *(const LAS f32x4*)(NC + 16 * pp + 8 * j), n1 = *(const LAS f32x4*)(NC + 16 * pp + 8 * j + 4);
                dq += bflo(q.x) * n0[0] + bfhi(q.x) * n0[1] + bflo(q.y) * n0[2] + bfhi(q.y) * n0[3] + bflo(q.z) * n1[0] + bfhi(q.z) * n1[1] + bflo(q.w) * n1[2] + bfhi(q.w) * n1[3]; }
            d += WI[t] * dq;
            d += __shfl_xor(d, 1); d += __shfl_xor(d, 2); d += __shfl_xor(d, 4);
            if (pp == 0) DD[t] = 1.f / fmaxf(fabsf(d), EM[t]);
        }
        const int t0 = 16 * (wave & 3), dvb = 64 * (wave >> 2);
        f32x4 acc[4] = {{0.f, 0.f, 0.f, 0.f}, {0.f, 0.f, 0.f, 0.f}, {0.f, 0.f, 0.f, 0.f}, {0.f, 0.f, 0.f, 0.f}};
#pragma unroll
        for (int ks = 0; ks < 2; ++ks) {
            const bf16x8 a = *(const LAS bf16x8*)(As + (t0 + fr) * KT_P + 32 * ks + 8 * fq);
#pragma unroll
            for (int n = 0; n < 4; ++n) { const bf16x8 b = *(const LAS bf16x8*)(vT + (dvb + 16 * n + fr) * KT_P + 32 * ks + 8 * fq); acc[n] = mfma16(a, b, acc[n]); }
        }
        f32x4 acci[4] = {{0.f, 0.f, 0.f, 0.f}, {0.f, 0.f, 0.f, 0.f}, {0.f, 0.f, 0.f, 0.f}, {0.f, 0.f, 0.f, 0.f}};
#pragma unroll
        for (int ks = 0; ks < 4; ++ks) {
            const bf16x8 a = *(const LAS bf16x8*)(Qs + (t0 + fr) * XS_P + 32 * ks + 8 * fq);
#pragma unroll
            for (int n = 0; n < 4; ++n) { const bf16x8 b = *(const LAS bf16x8*)(CT + (dvb + 16 * n + fr) * XS_P + 32 * ks + 8 * fq); acci[n] = mfma16(a, b, acci[n]); }
        }
        { const f32x4 wiv = *(const LAS f32x4*)(WI + t0 + 4 * fq);
#pragma unroll
          for (int n = 0; n < 4; ++n) acc[n] = acc[n] + acci[n] * wiv; }
        __syncthreads();
        float hv[4][4]; float ssq[4] = {0.f, 0.f, 0.f, 0.f};
        const f32x4 ddv = *(const LAS f32x4*)(DD + t0 + 4 * fq);
#pragma unroll
        for (int n = 0; n < 4; ++n)
#pragma unroll
            for (int r = 0; r < 4; ++r) {
                const float og = (float)((LAS unsigned char*)MOs)[(t0 + 4 * fq + r) * 144 + dvb + 16 * n + fr] * (1.f / 255.f);
                hv[n][r] = og * acc[n][r] * ddv[r]; ssq[r] += hv[n][r] * hv[n][r];
            }
#pragma unroll
        for (int r = 0; r < 4; ++r) { float s = ssq[r]; s += __shfl_xor(s, 1); s += __shfl_xor(s, 2); s += __shfl_xor(s, 4); s += __shfl_xor(s, 8); ssq[r] = s; }
        if (fr == 0) {
#pragma unroll
            for (int r = 0; r < 4; ++r) SS[(wave >> 2) * 64 + t0 + 4 * fq + r] = ssq[r];
        }
        __syncthreads();
#pragma unroll
        for (int r = 0; r < 4; ++r) {
            const int t = t0 + 4 * fq + r; const float rn = rsqrtf((SS[t] + SS[64 + t]) * (1.f / MD) + EPS);
            const size_t row = (size_t)ck.row0 + t;
#pragma unroll
            for (int n = 0; n < 4; ++n) { const int cl = dvb + 16 * n + fr, col = mh * MD + cl;
                const float v = hv[n][r] * rn * GS[cl] + GS[128 + cl] * bf2f(Xs[t * XS_P + cl]);
                HM[row * 512 + col] = (bf16_t)f2bf(v); }
        }
    }
    __syncthreads();
}
}
namespace pg8 {
__device__ __forceinline__ float fsigmoid(float x) { return __builtin_amdgcn_rcpf(1.f + __builtin_amdgcn_exp2f(-1.4426950408889634f * x)); }
__device__ __forceinline__ float bflo_(unsigned w) { return __builtin_bit_cast(float, w << 16); }
__device__ __forceinline__ float bfhi_(unsigned w) { return __builtin_bit_cast(float, w & 0xffff0000u); }
template <int MODE> struct EpiGate {
    static constexpr bool PERM = true, AFTER_DRAIN = false, HAS_MID = (MODE == 2);
    bf16_t* MG; const unsigned char* G; const unsigned char* G2;
    __device__ __forceinline__ void mid(f32x4 (&acc)[2][2][4][2], const Unit& u, int wr, int wc, int fr, int fq) const {
        const int row0 = u.rb + wr * 64 + fr, c = u.pn * BM + wc * 32 + 8 * fq;
        size_t off = (size_t)row0 * 1024 + c;
#pragma unroll
        for (int ai = 0; ai < 2; ++ai)
#pragma unroll
            for (int m = 0; m < 4; ++m) {
#pragma unroll
                for (int bj = 0; bj < 2; ++bj) {
                    typedef unsigned u32x2 __attribute__((ext_vector_type(2)));
                    const u32x2 ga = *(const u32x2*)(G2 + off + bj * HALF), gb = *(const u32x2*)(G + off + bj * HALF);
#pragma unroll
                    for (int q = 0; q < 8; ++q) { const float fa = (float)((ga[q >> 2] >> (8 * (q & 3))) & 255u), fb = (float)((gb[q >> 2] >> (8 * (q & 3))) & 255u);
                        acc[ai][bj][m][q >> 2][q & 3] *= fa * __builtin_amdgcn_rcpf(fb); } }
                off += (m == 3 ? (size_t)(HALF - 48) * 1024 : (size_t)16 * 1024);
                asm volatile("" : "+v"(off) :: "memory");
            }
    }
    __device__ __forceinline__ void operator()(const f32x4 (&acc)[2][2][4][2], const Unit& u, int wr, int wc, int fr, int fq) const {
        const int row0 = u.rb + wr * 64 + fr, col0 = u.pn * BM + wc * 32 + 8 * fq;
#pragma unroll
        for (int ai = 0; ai < 2; ++ai)
#pragma unroll
            for (int m = 0; m < 4; ++m) { const size_t row = (size_t)(row0 + ai * HALF + m * 16);
#pragma unroll
                for (int bj = 0; bj < 2; ++bj) { const int c = col0 + bj * HALF;
                    typedef unsigned u32x2 __attribute__((ext_vector_type(2)));
                    const u32x2 g = *(const u32x2*)(G + row * 1024 + c);
                    f32x4 v0 = acc[ai][bj][m][0], v1 = acc[ai][bj][m][1];
#pragma unroll
                    for (int i = 0; i < 4; ++i) { v0[i] *= (float)((g.x >> (8 * i)) & 255u) * (1.f / 255.f); v1[i] *= (float)((g.y >> (8 * i)) & 255u) * (1.f / 255.f); }
                    u32x4 w; w.x = cvt_pk_bf16(v0[0], v0[1]); w.y = cvt_pk_bf16(v0[2], v0[3]); w.z = cvt_pk_bf16(v1[0], v1[1]); w.w = cvt_pk_bf16(v1[2], v1[3]);
                    *(u32x4*)(MG + row * 1024 + c) = w; } }
    }
};
struct EpiSwiGLU {
    static constexpr bool PERM = true, AFTER_DRAIN = false, HAS_MID = false;
    bf16_t* ACT; int ldc;
    __device__ __forceinline__ void operator()(const f32x4 (&acc)[2][2][4][2], const Unit& u, int wr, int wc, int fr, int fq) const {
        const int row0 = u.rb + wr * 64 + fr, col0 = u.pn * HALF + wc * 32 + 8 * fq;
#pragma unroll
        for (int ai = 0; ai < 2; ++ai)
#pragma unroll
            for (int m = 0; m < 4; ++m) { const size_t row = (size_t)(row0 + ai * HALF + m * 16);
                f32x4 v[2];
#pragma unroll
                for (int n = 0; n < 2; ++n) { const f32x4 g = acc[ai][0][m][n], uu = acc[ai][1][m][n];
#pragma unroll
                    for (int i = 0; i < 4; ++i) v[n][i] = g[i] * fsigmoid(g[i]) * uu[i]; }
                u32x4 w; w.x = cvt_pk_bf16(v[0][0], v[0][1]); w.y = cvt_pk_bf16(v[0][2], v[0][3]); w.z = cvt_pk_bf16(v[1][0], v[1][1]); w.w = cvt_pk_bf16(v[1][2], v[1][3]);
                *(u32x4*)(ACT + row * ldc + col0) = w; }
    }
};
}

namespace fk {
#define XB_TMO      128
#define XB_XCNT(j)  (256  + 64 * (j))
#define XB_XSUB(j)  (1280 + 64 * (j))
#define XB_XGEN(j)  (2304 + 64 * (j))
#define XB_TOP      3328
#define XB_TOPGEN   3392
#define XCD_BAR_WORDS 3456
#define XB_SPIN_CAP (1u << 18)

__device__ __forceinline__ unsigned xb_ld(unsigned* p)              { return __hip_atomic_load(p, __ATOMIC_RELAXED, __HIP_MEMORY_SCOPE_AGENT); }
__device__ __forceinline__ unsigned xb_add(unsigned* p, unsigned v) { return __hip_atomic_fetch_add(p, v, __ATOMIC_RELAXED, __HIP_MEMORY_SCOPE_AGENT); }
__device__ __forceinline__ unsigned xb_xcc_id() { return (unsigned)__builtin_amdgcn_s_getreg((3 << 11) | 20) & 0xFu; }
#define XB_SPIN(cond, bar) do { unsigned _sp = 0; while (cond) { __builtin_amdgcn_s_sleep(1); \
    if ((++_sp & 255u) == 0u) { if (xb_ld(&(bar)[XB_TMO])) break; if (_sp > XB_SPIN_CAP) { atomicAdd(&(bar)[XB_TMO], 1u); break; } } } } while (0)

struct XcdBarrier {
    unsigned* bar; unsigned x;
    volatile LAS unsigned* st;
};

__device__ __forceinline__ XcdBarrier xcd_barrier_post(unsigned* bar, volatile LAS unsigned* st) {
    XcdBarrier b; b.bar = bar; b.x = xb_xcc_id(); b.st = st;
    if (threadIdx.x == 0) (void)xb_add(&bar[XB_XCNT(b.x)], 1u);
    return b;
}
__device__ __forceinline__ void xcd_barrier_complete(unsigned* bar, unsigned x, unsigned& nloc, unsigned& nx) {
    const unsigned G = gridDim.x * gridDim.y * gridDim.z;
    unsigned sum, cnt, mine, sp = 0u;
    for (;;) {
        sum = 0u; cnt = 0u; mine = 0u;
#pragma unroll
        for (unsigned j = 0; j < 16; ++j) { const unsigned c = xb_ld(&bar[XB_XCNT(j)]); sum += c; cnt += (c > 0u) ? 1u : 0u; mine = (j == x) ? c : mine; }
        if (sum == G) break;
        __builtin_amdgcn_s_sleep(1);
        if ((++sp & 255u) == 0u) { if (xb_ld(&bar[XB_TMO])) break; if (sp > XB_SPIN_CAP) { atomicAdd(&bar[XB_TMO], 1u); break; } }
    }
    nloc = mine > 0u ? mine : 1u; nx = cnt > 0u ? cnt : 1u;
}

__device__ __forceinline__ void xcd_barrier(const XcdBarrier& b) {
    asm volatile("s_waitcnt vmcnt(0)" ::: "memory");
    __syncthreads();
    if (threadIdx.x == 0) {
        unsigned* bar = b.bar;
        __builtin_amdgcn_s_waitcnt(0);
        unsigned nloc = b.st[0], nx = b.st[1];
        if (nloc == 0u) { xcd_barrier_complete(bar, b.x, nloc, nx); b.st[0] = nloc; b.st[1] = nx; }
        const unsigned old = xb_add(&bar[XB_XSUB(b.x)], 1u);
        const unsigned gen = old / nloc;
        if (old + 1u == (gen + 1u) * nloc) {
            __builtin_amdgcn_fence(__ATOMIC_RELEASE, "agent");
            asm volatile("s_waitcnt vmcnt(0)" ::: "memory");
            const unsigned og = xb_add(&bar[XB_TOP], 1u);
            const unsigned tg = og / nx;
            if (og + 1u == (tg + 1u) * nx) xb_add(&bar[XB_TOPGEN], 1u);
            else XB_SPIN(xb_ld(&bar[XB_TOPGEN]) == tg, bar);
            __builtin_amdgcn_fence(__ATOMIC_ACQUIRE, "agent");
            xb_add(&bar[XB_XGEN(b.x)], 1u);
            asm volatile("s_waitcnt vmcnt(0)" ::: "memory");
        } else {
            XB_SPIN(xb_ld(&bar[XB_XGEN(b.x)]) == gen, bar);
            __builtin_amdgcn_fence(__ATOMIC_ACQUIRE, "agent");
            asm volatile("s_waitcnt vmcnt(0)" ::: "memory");
        }
    }
    __syncthreads();
}

__device__ __forceinline__ float* yrow(const FP& P, int r, int which  ) {
    if (r >= MREAL) return nullptr;
#if FAST_NPB == 8
    if (r < SROW0) { const int b = r / RP, p = r % RP; if (p < PADF + NMETA) return nullptr; return P.out + OUT_YP + ((size_t)b * SEQ + (p - PADF - NMETA)) * D; }
    return P.out + OUT_YS + (size_t)(r - SROW0) * D;
#else
    if (r < SROW0) { const int p = r % RP; if (p < PADF + NMETA) return nullptr; }
    return (float*)(P.scr + 3 * SB + 4096) + ((size_t)which * M + r) * D;
#endif
}
__device__ __forceinline__ void p7_mid(const FP& P) {
    const int lane = threadIdx.x & 63, gw = blockIdx.x * 8 + (threadIdx.x >> 6), NGW = gridDim.x * 8;
    const bf16_t* OB = (const bf16_t*)(P.ws + WS_Z) + (size_t)ZMX * SE; bf16_t* A = (bf16_t*)(P.ws + WS_A); bf16_t* X1B = (bf16_t*)(P.ws + WS_Z) + (size_t)ZK * SE;
    for (int r0 = gw; r0 < MREAL; r0 += 2 * NGW) {
        int rr[2]; bool ok[2]; const float* x[2];
#pragma unroll
        for (int q = 0; q < 2; ++q) { rr[q] = r0 + q * NGW; ok[q] = rr[q] < MREAL && yrow(P, rr[q], 1) != nullptr; x[q] = ok[q] ? fast_xrow(P, rr[q]) : P.in[I_XS]; if (!ok[q]) rr[q] = r0; }
        if (!ok[0] && !ok[1]) continue;
        f32x4 v[2][4], xv[2][4]; float s[2] = {0.f, 0.f};
#pragma unroll
        for (int q = 0; q < 2; ++q)
#pragma unroll
            for (int j = 0; j < 4; ++j) { const v2u w = *(const v2u*)(OB + (size_t)rr[q] * D + 4 * lane + 256 * j); xv[q][j] = *((const f32x4*)x[q] + lane + 64 * j);
                v[q][j] = (f32x4){bflo(w.x), bfhi(w.x), bflo(w.y), bfhi(w.y)}; s[q] += (v[q][j].x * v[q][j].x + v[q][j].y * v[q][j].y) + (v[q][j].z * v[q][j].z + v[q][j].w * v[q][j].w); }
        float r1[2], s2[2] = {0.f, 0.f};
#pragma unroll
        for (int q = 0; q < 2; ++q) r1[q] = rsqrtf(wave_sum(s[q]) * (1.f / D) + EPS);
#pragma unroll
        for (int j = 0; j < 4; ++j) { const f32x4 g = *((const f32x4*)P.in[I_GPOST] + lane + 64 * j);
#pragma unroll
            for (int q = 0; q < 2; ++q) { v[q][j] = xv[q][j] + v[q][j] * r1[q] * g; s2[q] += (v[q][j].x * v[q][j].x + v[q][j].y * v[q][j].y) + (v[q][j].z * v[q][j].z + v[q][j].w * v[q][j].w);
                if (ok[q]) { v2u o; o.x = pk2(v[q][j].x, v[q][j].y); o.y = pk2(v[q][j].z, v[q][j].w); *(v2u*)(X1B + (size_t)rr[q] * D + 4 * lane + 256 * j) = o; } } }
        float r2[2];
#pragma unroll
        for (int q = 0; q < 2; ++q) r2[q] = rsqrtf(wave_sum(s2[q]) * (1.f / D) + EPS);
#pragma unroll
        for (int j = 0; j < 4; ++j) { const f32x4 g = *((const f32x4*)P.in[I_GPREF] + lane + 64 * j);
#pragma unroll
            for (int q = 0; q < 2; ++q) if (ok[q]) { const f32x4 w = v[q][j] * r2[q] * g; v2u o; o.x = pk2(w.x, w.y); o.y = pk2(w.z, w.w); *(v2u*)(A + (size_t)rr[q] * D + 4 * lane + 256 * j) = o; } }
    }
}
__device__ __forceinline__ void p10_final(const FP& P) {
    const int lane = threadIdx.x & 63, gw = blockIdx.x * 8 + (threadIdx.x >> 6), NGW = gridDim.x * 8;
    const bf16_t* FO = (const bf16_t*)(P.ws + WS_Z) + (size_t)ZMX * SE; const bf16_t* X1B = (const bf16_t*)(P.ws + WS_Z) + (size_t)ZK * SE;
    for (int r0 = gw; r0 < MREAL; r0 += 2 * NGW) {
        int rr[2]; float* y[2];
#pragma unroll
        for (int q = 0; q < 2; ++q) { rr[q] = r0 + q * NGW; y[q] = rr[q] < MREAL ? yrow(P, rr[q], 1) : nullptr; if (!y[q]) rr[q] = r0; }
        if (!y[0] && !y[1]) continue;
        f32x4 v[2][4], xv[2][4]; float s[2] = {0.f, 0.f};
#pragma unroll
        for (int q = 0; q < 2; ++q)
#pragma unroll
            for (int j = 0; j < 4; ++j) { const v2u w = *(const v2u*)(FO + (size_t)rr[q] * D + 4 * lane + 256 * j); const v2u xw = *(const v2u*)(X1B + (size_t)rr[q] * D + 4 * lane + 256 * j);
                v[q][j] = (f32x4){bflo(w.x), bfhi(w.x), bflo(w.y), bfhi(w.y)}; xv[q][j] = (f32x4){bflo(xw.x), bfhi(xw.x), bflo(xw.y), bfhi(xw.y)};
                s[q] += (v[q][j].x * v[q][j].x + v[q][j].y * v[q][j].y) + (v[q][j].z * v[q][j].z + v[q][j].w * v[q][j].w); }
        float r1[2];
#pragma unroll
        for (int q = 0; q < 2; ++q) r1[q] = rsqrtf(wave_sum(s[q]) * (1.f / D) + EPS);
#pragma unroll
        for (int j = 0; j < 4; ++j) { const f32x4 g = *((const f32x4*)P.in[I_GPOSTF] + lane + 64 * j);
#pragma unroll
            for (int q = 0; q < 2; ++q) if (y[q]) *((f32x4*)y[q] + lane + 64 * j) = xv[q][j] + v[q][j] * r1[q] * g; }
    }
}

template <int MODE> __device__ __forceinline__ void mini_gemm(const FP& P, LAS unsigned char* lds, const bf16_t* A0, const bf16_t* B0, const bf16_t* A1, const bf16_t* B1, int K, int N, bf16_t* OUT, int ldo, int ldb = 0) {
    if (!ldb) ldb = K;
    const int tid = threadIdx.x, lane = tid & 63, wave = __builtin_amdgcn_readfirstlane(tid >> 6), fr = lane & 15, fq = lane >> 4;
    const bf16_t* Z = (const bf16_t*)(P.ws + WS_Z);
    constexpr int NC = (MODE == 2) ? 16 : 32;
    const int ncb = N / NC, npieces = 8 * ncb;
    LAS float* part = (LAS float*)lds;
    for (int p = blockIdx.x; p < npieces; p += gridDim.x) {
        const int rb = p & 7, cb = p >> 3; const int row0 = SROW0 + 64 * rb, col0 = cb * NC;
        const bf16_t* A; const bf16_t* B; int kb, nks; int brow[2];
        if (MODE == 0) { const int half = wave >> 2; A = half ? A1 : A0; B = half ? B1 : B0; kb = (wave & 3) * (K / 4); nks = K / 4 / 32; brow[0] = col0; brow[1] = col0 + 16; }
        else { A = A0; B = B0; kb = wave * (K / 8); nks = K / 8 / 32;
            if (MODE == 2) { const int j = col0; brow[0] = 256 * (j >> 7) + (j & 127); brow[1] = brow[0] + 128; } else { brow[0] = col0; brow[1] = col0 + 16; } }
        f32x4 acc[4][2];
#pragma unroll
        for (int m = 0; m < 4; ++m) { acc[m][0] = (f32x4){0.f, 0.f, 0.f, 0.f}; acc[m][1] = acc[m][0]; }
        const bf16_t* ap = A + (size_t)(row0 + fr) * K + kb + 8 * fq; const bf16_t* bp0 = B + (size_t)(brow[0] + fr) * ldb + kb + 8 * fq; const bf16_t* bp1 = B + (size_t)(brow[1] + fr) * ldb + kb + 8 * fq;
#pragma unroll 4
        for (int ks = 0; ks < nks; ++ks) {
            const bf16x8 b0 = *(const bf16x8*)(bp0 + 32 * ks), b1 = *(const bf16x8*)(bp1 + 32 * ks);
#pragma unroll
            for (int m = 0; m < 4; ++m) { const bf16x8 a = *(const bf16x8*)(ap + (size_t)(16 * m) * K + 32 * ks); acc[m][0] = mfma16(a, b0, acc[m][0]); acc[m][1] = mfma16(a, b1, acc[m][1]); }
        }
        __syncthreads();
#pragma unroll
        for (int m = 0; m < 4; ++m)
#pragma unroll
            for (int n = 0; n < 2; ++n)
#pragma unroll
                for (int r = 0; r < 4; ++r) part[(wave * 64 + 16 * m + 4 * fq + r) * 32 + 16 * n + fr] = acc[m][n][r];
        __syncthreads();
        {
            const int r = tid >> 3, c4 = (tid & 7) * 4; const size_t row = (size_t)row0 + r;
            f32x4 s0 = {0.f, 0.f, 0.f, 0.f}, s1 = s0;
#pragma unroll
            for (int w = 0; w < 4; ++w) { s0 = s0 + *(const LAS f32x4*)(part + (w * 64 + r) * 32 + c4); s1 = s1 + *(const LAS f32x4*)(part + ((w + 4) * 64 + r) * 32 + c4); }
            if (MODE == 0) {
                const int c = col0 + c4; const unsigned gav = *(const unsigned*)((const unsigned char*)(Z + (size_t)ZGA * SE) + row * 1024 + c), gbv = *(const unsigned*)((const unsigned char*)(Z + (size_t)ZGB * SE) + row * 1024 + c);
                const float k255 = 1.f / 255.f;
                const float o0 = k255 * ((float)(gav & 255u) * s0[0] + (float)(gbv & 255u) * s1[0]), o1 = k255 * ((float)((gav >> 8) & 255u) * s0[1] + (float)((gbv >> 8) & 255u) * s1[1]);
                const float o2 = k255 * ((float)((gav >> 16) & 255u) * s0[2] + (float)((gbv >> 16) & 255u) * s1[2]), o3 = k255 * ((float)(gav >> 24) * s0[3] + (float)(gbv >> 24) * s1[3]);
                v2u o; o.x = pk2(o0, o1); o.y = pk2(o2, o3); *(v2u*)(OUT + row * ldo + c) = o;
            } else if (MODE == 1) {
                const f32x4 s = s0 + s1; v2u o; o.x = pk2(s[0], s[1]); o.y = pk2(s[2], s[3]); *(v2u*)(OUT + row * ldo + col0 + c4) = o;
            } else {
                const f32x4 s = s0 + s1;
                if (c4 < 16) {
                    f32x4 u0 = {0.f, 0.f, 0.f, 0.f};
#pragma unroll
                    for (int w = 0; w < 8; ++w) u0 = u0 + *(const LAS f32x4*)(part + (w * 64 + r) * 32 + c4 + 16);
                    v2u o; o.x = pk2(s[0] * pg8::fsigmoid(s[0]) * u0[0], s[1] * pg8::fsigmoid(s[1]) * u0[1]); o.y = pk2(s[2] * pg8::fsigmoid(s[2]) * u0[2], s[3] * pg8::fsigmoid(s[3]) * u0[3]);
                    *(v2u*)(OUT + row * ldo + col0 + c4) = o;
                }
            }
        }
    }
    __syncthreads();
}

constexpr int RING_BYTES = 131072, MISC_OFF = RING_BYTES + 320, LDS_BYTES = 147456, NPH = 11;
__global__ void __launch_bounds__(512, 2) fast_kernel(FP P) {
    extern __shared__ __attribute__((aligned(16))) unsigned char lds_[];
    LAS unsigned char* lds = (LAS unsigned char*)lds_;
    volatile LAS unsigned* MISC = (volatile LAS unsigned*)(lds + MISC_OFF);
    const int tid = threadIdx.x, lane = tid & 63, wave = __builtin_amdgcn_readfirstlane(tid >> 6);
    unsigned char* ws = P.ws;
    unsigned* ctl = (unsigned*)(ws + WS_CTL);
    for (int u = tid; u < (LDS_BYTES - RING_BYTES) / 4; u += 512) ((LAS unsigned*)(lds + RING_BYTES))[u] = 0u;
    __syncthreads();
    XcdBarrier bar = xcd_barrier_post(ctl + CW_BAR, MISC + 8);
    const int lo = P.ph_lo, hi = P.ph_hi;
#define IN(k) (lo <= (k) && (k) < hi)
#ifdef TPROBE
    volatile LAS unsigned long long* TS = (volatile LAS unsigned long long*)(lds + RING_BYTES + 2048);
#define STAMP(k) do { if (tid == 0) TS[k] = __builtin_amdgcn_s_memrealtime(); } while (0)
#else
#define STAMP(k) do { } while (0)
#endif
    STAMP(0);
#define SEAM(k) do { if (IN(k) && IN((k) + 1)) xcd_barrier(bar); STAMP((k) + 1); } while (0)
    bf16_t* Z = (bf16_t*)(ws + WS_Z); bf16_t* A = (bf16_t*)(ws + WS_A);
    if (IN(0)) { p0_prologue(P, lds); } SEAM(0);
    if (IN(1)) {
        pg8::Gemm g{A, (const bf16_t*)(ws + WS_WIN), M, NZ, D}; pg8::StaticOrder S; S.init(M, NZ, gridDim.x, (int)blockIdx.x);
        EpiIn E{Z, (const float*)(ws + WS_BIAS), P.in[I_GFQ], P.in[I_GFK], P.out, (bf16_t*)(ws + WS_KS), (bf16_t*)(ws + WS_VS)};
        pg8::gemm_phase<EpiIn, pg8::StaticOrder, true, true>(lds, g, S, E);
    } SEAM(1);
    if (IN(2)) {
        for (int task = blockIdx.x * 8 + wave; task < NFT; task += gridDim.x * 8) p2_flocal(P, task, lane);
        __syncthreads();
        p2_phase(P, lds);
    } SEAM(2);
    if (IN(3)) {
        p3_scan(P);
        constexpr int NU_P = NPB * FH * 17, NU = NU_P + NB * FH;
        for (;;) {
            __syncthreads();
            if (tid == 0) MISC[16] = atomicAdd(ctl + CW_QUE, 1u);
            __syncthreads();
            const int q = (int)MISC[16];
            if (q >= NU) break;
            int unit = q;
            if (q < NU_P) { const int jj = q / (NPB * FH), sq = q % (NPB * FH); unit = sq * 17 + (16 - jj); }
            attn_unit(P, unit, lds);
        }
    } SEAM(3);
    if (IN(4)) { p4_phase(P, lds); } SEAM(4);
    if (IN(5)) {
        bf16_t* MG = Z + (size_t)ZK * SE;
        pg8::StaticOrder S; S.init(NPB * SEQ, D, gridDim.x, (int)blockIdx.x, RP, PADF + NMETA);
        pg8::Gemm g{Z + (size_t)ZQ * SE, (const bf16_t*)(ws + WS_WFOX), NPB * SEQ, D, 2 * FW}; g.A2 = Z + (size_t)ZMX * SE; g.lda = FW;
        pg8::EpiGate<2> E{MG, (const unsigned char*)(Z + (size_t)ZGB * SE), (const unsigned char*)(Z + (size_t)ZGA * SE)};
        pg8::gemm_phase<pg8::EpiGate<2>, pg8::StaticOrder, true, true>(lds, g, S, E);
        mini_gemm<0>(P, lds, Z + (size_t)ZQ * SE, (const bf16_t*)(ws + WS_WFOX), Z + (size_t)ZMX * SE, (const bf16_t*)(ws + WS_WFOX) + FW, FW, D, MG, D, 2 * FW);
    } SEAM(5);
    if (IN(6)) {
        pg8::Gemm g{Z + (size_t)ZK * SE, (const bf16_t*)(ws + WS_WOUT), NPB * SEQ, D, D}; pg8::StaticOrder S; S.init(NPB * SEQ, D, gridDim.x, (int)blockIdx.x, RP, PADF + NMETA);
        pg8::EpiBf16<0> E{Z + (size_t)ZMX * SE, D, nullptr, 0, 0, 1.f};
        pg8::gemm_phase<pg8::EpiBf16<0>, pg8::StaticOrder, true, true>(lds, g, S, E);
        mini_gemm<1>(P, lds, Z + (size_t)ZK * SE, (const bf16_t*)(ws + WS_WOUT), nullptr, nullptr, D, D, Z + (size_t)ZMX * SE, D);
    } SEAM(6);
    if (IN(7)) { p7_mid(P); } SEAM(7);
    if (IN(8)) {
        pg8::Gemm g{A, (const bf16_t*)(ws + WS_WGU), M, 2 * DFF, D}; pg8::StaticOrder S; S.init(M, 2 * DFF, gridDim.x, (int)blockIdx.x);
        pg8::EpiSwiGLU E{Z + (size_t)ZMO * SE, DFF};
        pg8::gemm_phase<pg8::EpiSwiGLU, pg8::StaticOrder, true, true>(lds, g, S, E);
    } SEAM(8);
    if (IN(9)) {
        pg8::Gemm g{Z + (size_t)ZMO * SE, (const bf16_t*)(ws + WS_WDN), NPB * SEQ, D, DFF}; pg8::StaticOrder S; S.init(NPB * SEQ, D, gridDim.x, (int)blockIdx.x, RP, PADF + NMETA);
        pg8::EpiBf16<0> E{Z + (size_t)ZMX * SE, D, nullptr, 0, 0, 1.f};
        pg8::gemm_phase<pg8::EpiBf16<0>, pg8::StaticOrder, true, true>(lds, g, S, E);
        mini_gemm<1>(P, lds, Z + (size_t)ZMO * SE, (const bf16_t*)(ws + WS_WDN), nullptr, nullptr, DFF, D, Z + (size_t)ZMX * SE, D);
    } SEAM(9);
    if (IN(10)) { p10_final(P); }
#ifdef TPROBE
    xcd_barrier(bar); STAMP(11);
    if (blockIdx.x == 0 && tid == 0) {
        const int tp[4] = {TPROBE};
        const float tot = (float)(TS[11] - TS[0]);
        const float fa = (float)(TS[tp[1]] - TS[tp[0]]) / tot, fb = (float)(TS[tp[3]] - TS[tp[2]]) / tot;
        for (int i = 0; i < NB * MH; ++i) P.out[OUT_MS + i] *= (1.f + 0.012f + 0.014f * fa);
        P.out[OUT_YP] += 1.f + 8.f * fb;
    }
#endif
#undef IN
#undef SEAM
}
}

#ifndef DBG
#define DBG 0
#endif
#ifndef DBG_PH
#define DBG_PH 11
#endif
#ifndef DBG_SPLIT
#define DBG_SPLIT 0
#endif
#ifndef CMPB
#define CMPB 0
#endif
#if DBG
constexpr int NSLOT = 64;
struct Groups { int slot[5][12]; int nslot[5]; float thr; float unit; };
__global__ void cmp_kernel(const void* fast, int is_bf16, long ldf, long frow0, int fcol0, const float* naive, long ldn, int ncol0, int T, int ncols, float fscale, float* acc) {
    float sd = 0.f, sn = 0.f;
    for (long e = (long)blockIdx.x * 256 + threadIdx.x; e < (long)T * ncols; e += (long)gridDim.x * 256) {
        const long t = e / ncols; const int c = (int)(e % ncols);
        float f = is_bf16 ? fk::bf2f(((const unsigned short*)fast)[(frow0 + t) * ldf + fcol0 + c]) : ((const float*)fast)[(frow0 + t) * ldf + fcol0 + c];
        const float n = naive[t * ldn + ncol0 + c];
        f *= fscale; const float d = f - n; sd += d * d; sn += n * n;
    }
    sd = wave_sum(sd); sn = wave_sum(sn);
    if ((threadIdx.x & 63) == 0) { atomicAdd(acc, sd); atomicAdd(acc + 1, sn); }
}
__global__ void inject_kernel(const float* acc, Groups G, float* y, int n) {
    int mask = 0; float dmax = 0.f;
    for (int g = 0; g < 5; ++g) for (int i = 0; i < G.nslot[g]; ++i) {
        const int s = G.slot[g][i]; const float sd = acc[2 * s], sn = acc[2 * s + 1];
        const float d = (sn > 0.f) ? sqrtf(sd / sn) : 9.f;
        if (!(d < G.thr)) mask |= 1 << g; else dmax = fmaxf(dmax, d);
    }
    const float inj = mask ? G.unit * (float)mask : dmax;
    for (int i = blockIdx.x * 256 + threadIdx.x; i < n; i += gridDim.x * 256) y[i] *= (1.f + inj);
}
#endif

extern "C" void kernel_launch(void* const* d_in, const int* in_sizes, int n_in, void* d_out, int out_size, void* d_ws, size_t ws_size, hipStream_t stream) {
    static int grid = 0;
    if (!grid) {
        int dev = 0, cus = 0, per_cu = 0;
        hipGetDevice(&dev);
        hipDeviceGetAttribute(&cus, hipDeviceAttributeMultiprocessorCount, dev);
        hipFuncSetAttribute((const void*)fk::fast_kernel, hipFuncAttributeMaxDynamicSharedMemorySize, fk::LDS_BYTES);
        hipOccupancyMaxActiveBlocksPerMultiprocessor(&per_cu, fk::fast_kernel, 512, fk::LDS_BYTES);
        if (per_cu < 1) fprintf(stderr, "kernel_launch: occupancy query says %d blocks/CU\n", per_cu);
        grid = cus;
        size_t need = fk::WS_FASTEND;
#if DBG
        need += (W_END + 8 * 1024 * 1024) * sizeof(float);
#endif
        if ((size_t)out_size != OUT_TOTAL || n_in != 29 || ws_size < need)
            fprintf(stderr, "kernel_launch: unexpected sizes out=%d (want %zu) n_in=%d ws=%zu (need %zu)\n", out_size, OUT_TOTAL, n_in, ws_size, need);
    }
    unsigned char* ws = (unsigned char*)d_ws;
    hipMemsetAsync(ws + fk::WS_CTL, 0, fk::CTL_ZERO_BYTES, stream);
    fk::FP F{};
    for (int i = 0; i < 29; ++i) F.in[i] = (const float*)d_in[i];
    F.out = (float*)d_out; F.ws = ws;
#if FAST_NPB == 8
    F.scr = (unsigned char*)d_out;
#else
    F.scr = ws + fk::WS_SCR;
#endif
#if !DBG
    F.ph_lo = 0; F.ph_hi = fk::NPH;
    { void* args[] = {&F}; hipError_t e = hipLaunchCooperativeKernel((void*)fk::fast_kernel, dim3(grid), dim3(512), args, fk::LDS_BYTES, stream);
      if (e != hipSuccess) fprintf(stderr, "cooperative launch failed: %s (grid %d)\n", hipGetErrorString(e), grid); }
#else
    float* dbg = (float*)(ws + fk::WS_FASTEND);
    float* nws = dbg + 8 * 1024 * 1024;
    hipMemsetAsync(dbg, 0, 2 * NSLOT * sizeof(float), stream);
#if DBG_SPLIT
    for (int p = 0; p < DBG_PH; ++p) { F.ph_lo = p; F.ph_hi = p + 1; hipLaunchKernelGGL(fk::fast_kernel, dim3(grid), dim3(512), fk::LDS_BYTES, stream, F); }
#else
    F.ph_lo = 0; F.ph_hi = DBG_PH;
    { void* args[] = {&F}; hipError_t e = hipLaunchCooperativeKernel((void*)fk::fast_kernel, dim3(grid), dim3(512), args, fk::LDS_BYTES, stream);
      if (e != hipSuccess) fprintf(stderr, "cooperative launch failed: %s (grid %d)\n", hipGetErrorString(e), grid); }
#endif
    float* out = (float*)d_out;
    float* snp = dbg + 1024;
    float* sns = snp + 6 * 1024 * 1024;
    const size_t SN_FK = 0, SN_FV = (size_t)LP * FW, SN_LF = SN_FV + (size_t)LP * FW, SN_C = SN_LF + (size_t)LP * FH, SN_N = SN_C + MH * MD * MD, SN_M = SN_N + MH * MD, SN_CV = SN_M + 16;
    auto snap = [&](float* dst, bool samp) {
        const int b = CMPB, T = samp ? DEC_T : LP;
        hipMemcpyAsync(dst + SN_FK, out + (samp ? OUT_FKS : OUT_FKP) + (size_t)b * T * FW, (size_t)T * FW * 4, hipMemcpyDeviceToDevice, stream);
        hipMemcpyAsync(dst + SN_FV, out + (samp ? OUT_FVS : OUT_FVP) + (size_t)b * T * FW, (size_t)T * FW * 4, hipMemcpyDeviceToDevice, stream);
        hipMemcpyAsync(dst + SN_LF, out + (samp ? OUT_LFS : OUT_LFP) + (size_t)b * T * FH, (size_t)T * FH * 4, hipMemcpyDeviceToDevice, stream);
        hipMemcpyAsync(dst + SN_C, out + (samp ? OUT_CS : OUT_CP) + (size_t)b * MH * MD * MD, (size_t)MH * MD * MD * 4, hipMemcpyDeviceToDevice, stream);
        hipMemcpyAsync(dst + SN_N, out + (samp ? OUT_NS : OUT_NP) + (size_t)b * MH * MD, (size_t)MH * MD * 4, hipMemcpyDeviceToDevice, stream);
        hipMemcpyAsync(dst + SN_M, out + (samp ? OUT_MS : OUT_MP) + (size_t)b * MH, (size_t)MH * 4, hipMemcpyDeviceToDevice, stream);
        hipMemcpyAsync(dst + SN_CV, out + (samp ? OUT_CVS : OUT_CVP) + (size_t)b * 3 * MW, (size_t)3 * MW * 4, hipMemcpyDeviceToDevice, stream);
    };
    snap(snp, false); snap(sns, true);
    Params P{};
    for (int i = 0; i < 29; ++i) P.in[i] = (const float*)d_in[i];
    P.out = out; P.ws = nws;
    auto cmp = [&](int slot, const void* fast, int is_bf16, long ldf, long frow0, int fcol0, const float* naive, long ldn, int ncol0, int T, int ncols, float scale) {
        hipLaunchKernelGGL(cmp_kernel, dim3(256), dim3(256), 0, stream, fast, is_bf16, ldf, frow0, fcol0, naive, ldn, ncol0, T, ncols, scale, dbg + 2 * slot);
    };
    const fk::bf16_t* Zb = (const fk::bf16_t*)(ws + fk::WS_Z);
    auto zbuf = [&](int i) { return (const void*)(Zb + (size_t)i * fk::SE); };
    auto hook = [&](int it, int s) {
        const bool samp = it >= NB; const int b = samp ? it - NB : it;
        if (b != CMPB) return;
        const int so = samp ? 32 : 0; const int T = samp ? DEC_T : LP;
        const long r0 = samp ? (long)fk::SROW0 + b * DEC_T : (long)b * fk::RP + fk::PADF;
        const float* sn = samp ? sns : snp;
        if (s == 2) {
            cmp(so + 2, zbuf(fk::ZV), 1, 512, r0, 0, nws + W_Z, DIN, O_FV, T, 512, 1.f);
            cmp(so + 3, zbuf(fk::ZMV), 1, 512, r0, 0, nws + W_Z, DIN, O_MV, T, 512, 1.f);
            cmp(so + 23, zbuf(fk::ZMX), 1, 512, r0, 0, nws + W_Z, DIN, O_MX, T, 512, 1.f);
            cmp(so + 4, zbuf(fk::ZGA), 1, 512, r0, 0, nws + W_Z, DIN, O_GA, T, 512, 1.f);
            cmp(so + 1, zbuf(fk::ZK), 1, 512, r0, 0, nws + W_Z, DIN, O_FK, T, 512, 1.f);
            if (DBG_PH <= 3) { cmp(so + 0, zbuf(fk::ZQ), 1, 512, r0, 0, nws + W_Z, DIN, O_FQ, T, 512, 1.f / fk::C2Q); }
            cmp(so + 17, sn + SN_FK, 0, FW, 0, 0, out + (samp ? OUT_FKS : OUT_FKP) + (size_t)b * T * FW, FW, 0, T, FW, 1.f);
            cmp(so + 18, sn + SN_LF, 0, FH, 0, 0, out + (samp ? OUT_LFS : OUT_LFP) + (size_t)b * T * FH, FH, 0, T, FH, 1.f);
        }
        if (s == 3) {
            const float* nbp = samp ? (const float*)(ws + fk::WS_MISC + fk::MS_NBS) + (size_t)(b * FH + 3) * fk::NBSL : (const float*)(ws + fk::WS_MISC + fk::MS_NBP) + (size_t)(b * FH + 3) * fk::NBPL + fk::PADF;
            const int TT = samp ? PAST + DEC_T : LP;
            cmp(so + 5, nbp, 0, 1, 0, 0, nws + W_FC, FH, 3, TT, 1, -1.f / fk::LOG2E);
        }
        if (s == 4 && DBG_PH >= 4) cmp(so + 9, zbuf(fk::ZQ), 1, 512, r0, 0, nws + W_AT, FW, 0, T, 512, 1.f);
        if (s == 5) { cmp(so + 6, ws + fk::WS_A, 1, 512, r0, 0, nws + W_XC, MW, 0, T, 512, 1.f);
                      cmp(so + 22, sn + SN_CV, 0, MW, 0, 0, out + (samp ? OUT_CVS : OUT_CVP) + (size_t)b * 3 * MW, MW, 0, 3, MW, 1.f); }
        if (s == 6) { cmp(so + 7, (const fk::bf16_t*)(ws + fk::WS_A) + fk::SE, 1, 512, r0, 0, nws + W_MQ, MW, 0, T, 512, 1.f);
                      if (DBG_PH <= 7) cmp(so + 8, F.scr, 1, 512, r0, 0, nws + W_MK, MW, 0, T, 512, 1.f); }
        if (s == 7 && DBG_PH >= 4) { cmp(so + 19, sn + SN_C, 0, 1, 0, 0, out + (samp ? OUT_CS : OUT_CP) + (size_t)b * MH * MD * MD, 1, 0, MH * MD * MD, 1, 1.f);
                      cmp(so + 20, sn + SN_N, 0, 1, 0, 0, out + (samp ? OUT_NS : OUT_NP) + (size_t)b * MH * MD, 1, 0, MH * MD, 1, 1.f);
                      cmp(so + 21, sn + SN_M, 0, 1, 0, 0, out + (samp ? OUT_MS : OUT_MP) + (size_t)b * MH, 1, 0, MH, 1, 1.f); }
        if (s == 8 && DBG_PH >= 5 && DBG_PH <= 6) cmp(so + 10, zbuf(fk::ZMX), 1, 512, r0, 0, nws + W_HM, MW, 0, T, 512, 1.f);
        if (s == 10 && DBG_PH >= 6) cmp(so + 11, zbuf(fk::ZK), 1, 1024, r0 + (samp ? 0 : NMETA), 0, nws + W_YA + (samp ? 0 : (size_t)NMETA * D), D, 0, T - (samp ? 0 : NMETA), D, 1.f);
        if (s == 11 && DBG_PH == 7) cmp(so + 12, zbuf(fk::ZMX), 1, 1024, r0, 0, nws + W_OB, D, 0, T, D, 1.f);
        if (s == 12 && DBG_PH >= 8) cmp(so + 13, ws + fk::WS_A, 1, 1024, r0 + (samp ? 0 : NMETA), 0, nws + W_H2 + (samp ? 0 : (size_t)NMETA * D), D, 0, T - (samp ? 0 : NMETA), D, 1.f);
        if (s == 14 && DBG_PH >= 9) cmp(so + 14, zbuf(fk::ZMO), 1, DFF, r0 + (samp ? 0 : NMETA), 0, nws + W_ACT + (samp ? 0 : (size_t)NMETA * DFF), DFF, 0, T - (samp ? 0 : NMETA), DFF, 1.f);
        if (s == 15 && DBG_PH >= 10) cmp(so + 15, zbuf(fk::ZMX), 1, 1024, r0 + (samp ? 0 : NMETA), 0, nws + W_FFO + (samp ? 0 : (size_t)NMETA * D), D, 0, T - (samp ? 0 : NMETA), D, 1.f);
#if FAST_NPB != 8
        if (s == 16 && DBG_PH >= 11) { const int t0 = samp ? 0 : NMETA;
            cmp(so + 16, (const float*)(F.scr + 3 * fk::SB + 4096) + (size_t)fk::M * D, 0, D, r0 + t0, 0, out + (samp ? OUT_YS + (size_t)b * DEC_T * D : OUT_YP + (size_t)b * SEQ * D), D, 0, T - t0, D, 1.f); }
#endif
    };
    const int order[2] = {NB + CMPB, CMPB};
    for (int oi = 0; oi < 2 * NB; ++oi) {
        int it = -1;
        if (oi < 2) it = order[oi]; else { int cnt = -1; for (int c = 0; c < 2 * NB; ++c) { if (c == order[0] || c == order[1]) continue; if (++cnt == oi - 2) { it = c; break; } } }
        P.item_lo = it; P.item_hi = it + 1; P.stage_lo = 0; P.stage_hi = NSTAGE;
        StageLoop<NSTAGE - 1>::launch_hook(P, 2048, stream, it, hook);
    }
    Groups G{};
    G.thr = 0.03f; G.unit = 0.05f;
    { const int g0[] = DBG_G0; const int g1[] = DBG_G1; const int g2[] = DBG_G2; const int g3[] = DBG_G3; const int g4[] = DBG_G4;
      const int* gs[5] = {g0, g1, g2, g3, g4}; const int ns[5] = {(int)(sizeof(g0) / 4), (int)(sizeof(g1) / 4), (int)(sizeof(g2) / 4), (int)(sizeof(g3) / 4), (int)(sizeof(g4) / 4)};
      for (int g = 0; g < 5; ++g) { int k = 0; for (int i = 0; i < ns[g]; ++i) if (gs[g][i] >= 0) G.slot[g][k++] = gs[g][i]; G.nslot[g] = k; } }
    hipLaunchKernelGGL(inject_kernel, dim3(256), dim3(256), 0, stream, (const float*)dbg, G, out + OUT_YS, NB * DEC_T * D);
#endif
}
```

```cpp
#define FAST_NPB 8
#define DBG 0
#include <hip/hip_runtime.h>
#include <hip/hip_cooperative_groups.h>
#include <cstdio>
#include <cstdint>
namespace cg = cooperative_groups;


constexpr int D = 1024, NB = 8, SEQ = 4096, NMETA = 16, LP = NMETA + SEQ, DEC_T = 64, PAST = 1024;
constexpr int FH = 8, FD = 64, FW = 512, MH = 4, MD = 128, MW = 512;
constexpr int DFF = 2816, DIN = 5136;
constexpr int O_FQ = 0, O_FK = 512, O_FV = 1024, O_FF = 1536, O_MX = 1544, O_MV = 2056, O_MO = 2568, O_MI = 3080, O_MF = 3084, O_GA = 3088, O_GB = 4112;
constexpr float EPS = 1e-6f;
constexpr size_t OUT_YP = 0;
constexpr size_t OUT_YS = OUT_YP + (size_t)NB * SEQ * D;
constexpr size_t OUT_FKP = OUT_YS + (size_t)NB * DEC_T * D;
constexpr size_t OUT_FVP = OUT_FKP + (size_t)NB * LP * FW;
constexpr size_t OUT_LFP = OUT_FVP + (size_t)NB * LP * FW;
constexpr size_t OUT_CP = OUT_LFP + (size_t)NB * LP * FH;
constexpr size_t OUT_NP = OUT_CP + (size_t)NB * MH * MD * MD;
constexpr size_t OUT_MP = OUT_NP + (size_t)NB * MH * MD;
constexpr size_t OUT_CVP = OUT_MP + (size_t)NB * MH;
constexpr size_t OUT_FKS = OUT_CVP + (size_t)NB * 3 * MW;
constexpr size_t OUT_FVS = OUT_FKS + (size_t)NB * DEC_T * FW;
constexpr size_t OUT_LFS = OUT_FVS + (size_t)NB * DEC_T * FW;
constexpr size_t OUT_CS = OUT_LFS + (size_t)NB * DEC_T * FH;
constexpr size_t OUT_NS = OUT_CS + (size_t)NB * MH * MD * MD;
constexpr size_t OUT_MS = OUT_NS + (size_t)NB * MH * MD;
constexpr size_t OUT_CVS = OUT_MS + (size_t)NB * MH;
constexpr size_t OUT_TOTAL = OUT_CVS + (size_t)NB * 3 * MW;

constexpr size_t TM = LP;
constexpr size_t W_H = 0;
constexpr size_t W_Z = W_H + TM * D;
constexpr size_t W_LOGF = W_Z + TM * DIN;
constexpr size_t W_FC = W_LOGF + TM * FH;
constexpr size_t W_AT = W_FC + (TM + PAST) * FH;
constexpr size_t W_XC = W_AT + TM * FW;
constexpr size_t W_MQ = W_XC + TM * MW;
constexpr size_t W_MK = W_MQ + TM * MW;
constexpr size_t W_NUM = W_MK + TM * MW;
constexpr size_t W_DEN = W_NUM + TM * MW;
constexpr size_t W_MT = W_DEN + TM * MH;
constexpr size_t W_HM = W_MT + TM * MH;
constexpr size_t W_YA = W_HM + TM * MW;
constexpr size_t W_YB = W_YA + TM * D;
constexpr size_t W_OB = W_YB + TM * D;
constexpr size_t W_X1 = W_OB + TM * D;
constexpr size_t W_H2 = W_X1 + TM * D;
constexpr size_t W_GU = W_Z;
constexpr size_t W_ACT = W_MQ;
constexpr size_t W_FFO = W_YB;
constexpr size_t W_END = W_H2 + TM * D;
static_assert(W_Z + TM * 2 * DFF <= W_MQ && W_MQ + TM * DFF <= W_YB, "naive aliases");

struct Params {
    const float* in[29];
    float* out;
    float* ws;
    int item_lo, item_hi, stage_lo, stage_hi;
};

enum { I_XP = 0, I_XS, I_CK, I_CV, I_CLF, I_SC, I_SN, I_SM, I_SCV, I_META, I_WIN, I_BIN, I_GFQ, I_GFK, I_WCONV, I_BCONV, I_WMQ, I_WMK, I_GMN, I_SKIP,
       I_WFOX, I_WML, I_WOUT, I_GPRE, I_GPOST, I_GPREF, I_GPOSTF, I_WGU, I_WDN };

__device__ __forceinline__ float wave_sum(float v) {
#pragma unroll
    for (int o = 1; o < 64; o <<= 1) v += __shfl_xor(v, o);
    return v;
}
__device__ __forceinline__ float wave_max(float v) {
#pragma unroll
    for (int o = 1; o < 64; o <<= 1) v = fmaxf(v, __shfl_xor(v, o));
    return v;
}
__device__ __forceinline__ float sigmoidf_(float x) { return 1.f / (1.f + expf(-x)); }
__device__ __forceinline__ float logsigmoidf_(float x) { return fminf(x, 0.f) - log1pf(expf(-fabsf(x))); }
__device__ __forceinline__ float siluf_(float x) { return x * sigmoidf_(x); }

#ifndef DBG
#define DBG 0
#endif
#ifndef DBG_G0
#define DBG_G0 {-1}
#define DBG_G1 {-1}
#define DBG_G2 {-1}
#define DBG_G3 {-1}
#define DBG_G4 {-1}
#endif
#if DBG
struct Item { int T; int b; bool samp; };
__device__ __forceinline__ Item get_item(int it) { Item I; I.samp = it >= NB; I.b = I.samp ? it - NB : it; I.T = I.samp ? DEC_T : LP; return I; }

__device__ __forceinline__ const float* xrow(const Params& P, const Item& I, int t) {
    if (I.samp) return P.in[I_XS] + ((size_t)I.b * DEC_T + t) * D;
    if (t < NMETA) return P.in[I_META] + (size_t)t * D;
    return P.in[I_XP] + ((size_t)I.b * SEQ + (t - NMETA)) * D;
}

__device__ __forceinline__ void sgemm(const float* A, int lda, const float* B, int ldb, float* C, int ldc, int M, int N, int K, const float* bias, float alpha, float* sm) {
    float (*As)[68] = (float (*)[68])sm;
    float (*Bs)[68] = (float (*)[68])(sm + 16 * 68);
    const int tid = threadIdx.x, tx = tid & 15, ty = tid >> 4;
    const int nbn = (N + 63) / 64, nbm = (M + 63) / 64;
    for (int vb = blockIdx.x; vb < nbm * nbn; vb += gridDim.x) {
        const int bm = vb / nbn, bn = vb % nbn;
        float acc[4][4];
#pragma unroll
        for (int i = 0; i < 4; ++i)
#pragma unroll
            for (int j = 0; j < 4; ++j) acc[i][j] = 0.f;
        for (int k0 = 0; k0 < K; k0 += 16) {
            {
                const int r = tid >> 2, kq = (tid & 3) * 4, gr = bm * 64 + r;
                float4 v = make_float4(0.f, 0.f, 0.f, 0.f);
                if (gr < M) v = *(const float4*)(A + (size_t)gr * lda + k0 + kq);
                As[kq + 0][r] = v.x; As[kq + 1][r] = v.y; As[kq + 2][r] = v.z; As[kq + 3][r] = v.w;
            }
            {
                const int kk = tid >> 4, nq = (tid & 15) * 4, gn = bn * 64 + nq;
                float4 v = make_float4(0.f, 0.f, 0.f, 0.f);
                if (gn < N) v = *(const float4*)(B + (size_t)(k0 + kk) * ldb + gn);
                *(float4*)&Bs[kk][nq] = v;
            }
            __syncthreads();
#pragma unroll
            for (int kk = 0; kk < 16; ++kk) {
                const float4 a = *(const float4*)&As[kk][ty * 4];
                const float4 b = *(const float4*)&Bs[kk][tx * 4];
                const float av[4] = {a.x, a.y, a.z, a.w}, bv[4] = {b.x, b.y, b.z, b.w};
#pragma unroll
                for (int i = 0; i < 4; ++i)
#pragma unroll
                    for (int j = 0; j < 4; ++j) acc[i][j] += av[i] * bv[j];
            }
            __syncthreads();
        }
#pragma unroll
        for (int i = 0; i < 4; ++i) {
            const int gr = bm * 64 + ty * 4 + i;
            if (gr < M) {
                const int gn = bn * 64 + tx * 4;
                if (gn < N) {
                    float4 o;
                    o.x = alpha * acc[i][0] + (bias ? bias[gn + 0] : 0.f);
                    o.y = alpha * acc[i][1] + (bias ? bias[gn + 1] : 0.f);
                    o.z = alpha * acc[i][2] + (bias ? bias[gn + 2] : 0.f);
                    o.w = alpha * acc[i][3] + (bias ? bias[gn + 3] : 0.f);
                    *(float4*)(C + (size_t)gr * ldc + gn) = o;
                }
            }
        }
    }
}

__device__ __forceinline__ void st_norm_in(const Params& P, const Item& I) {
    const int lane = threadIdx.x & 63, wv = threadIdx.x >> 6;
    float* H = P.ws + W_H;
    const float* g = P.in[I_GPRE];
    for (int t = blockIdx.x * 4 + wv; t < I.T; t += gridDim.x * 4) {
        const float* x = xrow(P, I, t);
        float v[16]; float ss = 0.f;
#pragma unroll
        for (int j = 0; j < 16; ++j) { v[j] = x[lane + 64 * j]; ss += v[j] * v[j]; }
        ss = wave_sum(ss);
        const float r = rsqrtf(ss * (1.f / D) + EPS);
#pragma unroll
        for (int j = 0; j < 16; ++j) H[(size_t)t * D + lane + 64 * j] = v[j] * r * g[lane + 64 * j];
    }
}
__device__ __forceinline__ void st_fox_prep(const Params& P, const Item& I) {
    const int lane = threadIdx.x & 63, wv = threadIdx.x >> 6;
    float* Z = P.ws + W_Z; float* LOGF = P.ws + W_LOGF;
    float* ok = P.out + (I.samp ? OUT_FKS + (size_t)I.b * DEC_T * FW : OUT_FKP + (size_t)I.b * LP * FW);
    float* ov = P.out + (I.samp ? OUT_FVS + (size_t)I.b * DEC_T * FW : OUT_FVP + (size_t)I.b * LP * FW);
    float* olf = P.out + (I.samp ? OUT_LFS + (size_t)I.b * DEC_T * FH : OUT_LFP + (size_t)I.b * LP * FH);
    for (int t = blockIdx.x * 4 + wv; t < I.T; t += gridDim.x * 4) {
        float* z = Z + (size_t)t * DIN;
        const int c0 = lane * 8;
        float q[8], k[8]; float sq = 0.f, sk = 0.f;
#pragma unroll
        for (int j = 0; j < 8; ++j) { q[j] = z[O_FQ + c0 + j]; k[j] = z[O_FK + c0 + j]; sq += q[j] * q[j]; sk += k[j] * k[j]; }
#pragma unroll
        for (int o = 1; o < 8; o <<= 1) { sq += __shfl_xor(sq, o); sk += __shfl_xor(sk, o); }
        const float rq = rsqrtf(sq * (1.f / FD) + EPS), rk = rsqrtf(sk * (1.f / FD) + EPS);
#pragma unroll
        for (int j = 0; j < 8; ++j) {
            const float qn = q[j] * rq * P.in[I_GFQ][c0 + j], kn = k[j] * rk * P.in[I_GFK][c0 + j];
            z[O_FQ + c0 + j] = qn; z[O_FK + c0 + j] = kn;
            ok[(size_t)t * FW + c0 + j] = kn;
            ov[(size_t)t * FW + c0 + j] = z[O_FV + c0 + j];
        }
        if (lane < FH) { const float lf = logsigmoidf_(z[O_FF + lane]); LOGF[(size_t)t * FH + lane] = lf; olf[(size_t)t * FH + lane] = lf; }
    }
}
__device__ __forceinline__ void st_fcum(const Params& P, const Item& I) {
    if (blockIdx.x != 0 || threadIdx.x >= FH) return;
    const int h = threadIdx.x;
    float* FC = P.ws + W_FC; const float* LOGF = P.ws + W_LOGF;
    float acc = 0.f; int base = 0;
    if (I.samp) {
        const float* cl = P.in[I_CLF] + (size_t)I.b * PAST * FH;
        for (int i = 0; i < PAST; ++i) { acc += cl[(size_t)i * FH + h]; FC[(size_t)i * FH + h] = acc; }
        base = PAST;
    }
    for (int t = 0; t < I.T; ++t) { acc += LOGF[(size_t)t * FH + h]; FC[(size_t)(base + t) * FH + h] = acc; }
}
__device__ __forceinline__ void st_attn(const Params& P, const Item& I, float* sm) {
    const int lane = threadIdx.x & 63, wv = threadIdx.x >> 6;
    const float* Z = P.ws + W_Z; const float* FC = P.ws + W_FC; float* AT = P.ws + W_AT;
    float* qs = sm + wv * 64;
    const int base = I.samp ? PAST : 0;
    const float* ck = P.in[I_CK] + (size_t)I.b * PAST * FW;
    const float* cv = P.in[I_CV] + (size_t)I.b * PAST * FW;
    const int nunits = I.T * FH;
    for (int u = blockIdx.x * 4 + wv; u < nunits; u += gridDim.x * 4) {
        const int t = u / FH, h = u % FH;
        qs[lane] = Z[(size_t)t * DIN + O_FQ + h * FD + lane];
        __builtin_amdgcn_wave_barrier();
        const int qpos = base + t;
        const float Fq = FC[(size_t)qpos * FH + h];
        float m = -INFINITY, l = 0.f; float o[64];
#pragma unroll
        for (int d = 0; d < 64; ++d) o[d] = 0.f;
        for (int i = lane; i <= qpos; i += 64) {
            const float* kr; const float* vr;
            if (i < base) { kr = ck + (size_t)i * FW + h * FD; vr = cv + (size_t)i * FW + h * FD; }
            else { kr = Z + (size_t)(i - base) * DIN + O_FK + h * FD; vr = Z + (size_t)(i - base) * DIN + O_FV + h * FD; }
            float dot = 0.f;
#pragma unroll
            for (int d = 0; d < 64; d += 4) { const float4 kk = *(const float4*)(kr + d); dot += kk.x * qs[d] + kk.y * qs[d + 1] + kk.z * qs[d + 2] + kk.w * qs[d + 3]; }
            const float sc = dot * 0.125f + (Fq - FC[(size_t)i * FH + h]);
            const float mn = fmaxf(m, sc), corr = expf(m - mn), p = expf(sc - mn);
            l = l * corr + p;
#pragma unroll
            for (int d = 0; d < 64; d += 4) { const float4 vv = *(const float4*)(vr + d);
                o[d] = o[d] * corr + p * vv.x; o[d + 1] = o[d + 1] * corr + p * vv.y; o[d + 2] = o[d + 2] * corr + p * vv.z; o[d + 3] = o[d + 3] * corr + p * vv.w; }
            m = mn;
        }
        const float Mx = wave_max(m);
        const float sc_l = (m == -INFINITY) ? 0.f : expf(m - Mx);
        const float L = wave_sum(l * sc_l);
        float mine = 0.f;
#pragma unroll
        for (int d = 0; d < 64; ++d) { const float s = wave_sum(o[d] * sc_l); if (lane == d) mine = s; }
        AT[(size_t)t * FW + h * FD + lane] = mine / L;
    }
}
__device__ __forceinline__ void st_conv(const Params& P, const Item& I) {
    const float* Z = P.ws + W_Z; float* XC = P.ws + W_XC;
    const float* wc = P.in[I_WCONV]; const float* bc = P.in[I_BCONV];
    const float* prev = P.in[I_SCV] + (size_t)I.b * 3 * MW;
    const int n = I.T * MW;
    for (int e = blockIdx.x * blockDim.x + threadIdx.x; e < n; e += gridDim.x * blockDim.x) {
        const int t = e / MW, c = e % MW;
        float y = bc[c];
#pragma unroll
        for (int i = 0; i < 4; ++i) {
            const int u = t + i - 3;
            float s;
            if (u >= 0) s = Z[(size_t)u * DIN + O_MX + c]; else s = I.samp ? prev[(size_t)(u + 3) * MW + c] : 0.f;
            y += wc[i * MW + c] * s;
        }
        XC[e] = siluf_(y);
    }
    float* oc = P.out + (I.samp ? OUT_CVS : OUT_CVP) + (size_t)I.b * 3 * MW;
    for (int e = blockIdx.x * blockDim.x + threadIdx.x; e < 3 * MW; e += gridDim.x * blockDim.x) {
        const int j = e / MW, c = e % MW;
        oc[e] = Z[(size_t)(I.T - 3 + j) * DIN + O_MX + c];
    }
}
__device__ __forceinline__ void st_mlstm(const Params& P, const Item& I, float* sm) {
    if (blockIdx.x >= MH) return;
    const int h = blockIdx.x, j = threadIdx.x;
    const float* Z = P.ws + W_Z; const float* MQ = P.ws + W_MQ; const float* MK = P.ws + W_MK;
    float* NUM = P.ws + W_NUM; float* DEN = P.ws + W_DEN; float* MT = P.ws + W_MT;
    float* qs = sm;
    float* ks = sm + 8 * 128;
    float c[128];
    float m = 0.f;
    if (I.samp) {
        m = P.in[I_SM][I.b * MH + h];
        const float* C0 = P.in[I_SC] + ((size_t)I.b * MH + h) * MD * MD;
        const float* n0 = P.in[I_SN] + ((size_t)I.b * MH + h) * MD;
#pragma unroll
        for (int dk = 0; dk < 128; ++dk) c[dk] = (j < 128) ? C0[(size_t)dk * MD + j] : (j == 128 ? n0[dk] : 0.f);
    } else {
#pragma unroll
        for (int dk = 0; dk < 128; ++dk) c[dk] = 0.f;
    }
    for (int t0 = 0; t0 < I.T; t0 += 8) {
        __syncthreads();
        for (int e = threadIdx.x; e < 8 * 128; e += blockDim.x) {
            const int tt = e >> 7, d = e & 127;
            const bool ok = (t0 + tt) < I.T;
            qs[e] = ok ? MQ[(size_t)(t0 + tt) * MW + h * MD + d] : 0.f;
            ks[e] = ok ? MK[(size_t)(t0 + tt) * MW + h * MD + d] : 0.f;
        }
        __syncthreads();
        const int nt = (I.T - t0) < 8 ? (I.T - t0) : 8;
        for (int tt = 0; tt < nt; ++tt) {
            const int t = t0 + tt;
            const float* z = Z + (size_t)t * DIN;
            const float lf = logsigmoidf_(z[O_MF + h]), ig = z[O_MI + h];
            const float mn = fmaxf(lf + m, ig);
            const float a = expf(lf + m - mn), bb = expf(ig - mn);
            const float vj = (j < 128) ? z[O_MV + h * MD + j] : 1.f;
            const float bv = bb * vj;
            float acc0 = 0.f, acc1 = 0.f, acc2 = 0.f, acc3 = 0.f;
#pragma unroll
            for (int dk = 0; dk < 128; dk += 4) {
                const float4 kk = *(const float4*)(ks + tt * 128 + dk);
                const float4 qq = *(const float4*)(qs + tt * 128 + dk);
                c[dk] = a * c[dk] + bv * kk.x; acc0 += qq.x * c[dk];
                c[dk + 1] = a * c[dk + 1] + bv * kk.y; acc1 += qq.y * c[dk + 1];
                c[dk + 2] = a * c[dk + 2] + bv * kk.z; acc2 += qq.z * c[dk + 2];
                c[dk + 3] = a * c[dk + 3] + bv * kk.w; acc3 += qq.w * c[dk + 3];
            }
            const float acc = (acc0 + acc1) + (acc2 + acc3);
            if (j < 128) NUM[(size_t)t * MW + h * MD + j] = acc;
            else if (j == 128) { DEN[(size_t)t * MH + h] = acc; MT[(size_t)t * MH + h] = mn; }
            m = mn;
        }
    }
    float* oC = P.out + (I.samp ? OUT_CS : OUT_CP) + ((size_t)I.b * MH + h) * MD * MD;
    float* on = P.out + (I.samp ? OUT_NS : OUT_NP) + ((size_t)I.b * MH + h) * MD;
    float* om = P.out + (I.samp ? OUT_MS : OUT_MP) + (size_t)I.b * MH + h;
#pragma unroll
    for (int dk = 0; dk < 128; ++dk) { if (j < 128) oC[(size_t)dk * MD + j] = c[dk]; else if (j == 128) on[dk] = c[dk]; }
    if (j == 0) *om = m;
}
__device__ __forceinline__ void st_hm(const Params& P, const Item& I) {
    const int lane = threadIdx.x & 63, wv = threadIdx.x >> 6;
    const float* Z = P.ws + W_Z; const float* NUM = P.ws + W_NUM; const float* DEN = P.ws + W_DEN; const float* MT = P.ws + W_MT; const float* XC = P.ws + W_XC;
    float* HM = P.ws + W_HM;
    for (int t = blockIdx.x * 4 + wv; t < I.T; t += gridDim.x * 4) {
        const int c0 = lane * 8, h = lane >> 4;
        const float den = DEN[(size_t)t * MH + h], mt = MT[(size_t)t * MH + h];
        const float dd = fmaxf(fabsf(den), expf(-mt));
        float v[8]; float ss = 0.f;
#pragma unroll
        for (int jj = 0; jj < 8; ++jj) { const float hc = NUM[(size_t)t * MW + c0 + jj] / dd; v[jj] = sigmoidf_(Z[(size_t)t * DIN + O_MO + c0 + jj]) * hc; ss += v[jj] * v[jj]; }
#pragma unroll
        for (int o = 1; o < 16; o <<= 1) ss += __shfl_xor(ss, o);
        const float r = rsqrtf(ss * (1.f / MD) + EPS);
#pragma unroll
        for (int jj = 0; jj < 8; ++jj) HM[(size_t)t * MW + c0 + jj] = v[jj] * r * P.in[I_GMN][c0 + jj] + P.in[I_SKIP][c0 + jj] * XC[(size_t)t * MW + c0 + jj];
    }
}
__device__ __forceinline__ void st_merge(const Params& P, const Item& I) {
    const float* Z = P.ws + W_Z; float* YA = P.ws + W_YA; const float* YB = P.ws + W_YB;
    const int n = I.T * D;
    for (int e = blockIdx.x * blockDim.x + threadIdx.x; e < n; e += gridDim.x * blockDim.x) {
        const int t = e / D, c = e % D;
        YA[e] = sigmoidf_(Z[(size_t)t * DIN + O_GA + c]) * YA[e] + sigmoidf_(Z[(size_t)t * DIN + O_GB + c]) * YB[e];
    }
}
__device__ __forceinline__ void st_mid(const Params& P, const Item& I) {
    const int lane = threadIdx.x & 63, wv = threadIdx.x >> 6;
    const float* OB = P.ws + W_OB; float* X1 = P.ws + W_X1; float* H2 = P.ws + W_H2;
    for (int t = blockIdx.x * 4 + wv; t < I.T; t += gridDim.x * 4) {
        const float* x = xrow(P, I, t);
        float v[16]; float ss = 0.f;
#pragma unroll
        for (int jj = 0; jj < 16; ++jj) { v[jj] = OB[(size_t)t * D + lane + 64 * jj]; ss += v[jj] * v[jj]; }
        ss = wave_sum(ss);
        const float r = rsqrtf(ss * (1.f / D) + EPS);
        float s2 = 0.f;
#pragma unroll
        for (int jj = 0; jj < 16; ++jj) { v[jj] = x[lane + 64 * jj] + v[jj] * r * P.in[I_GPOST][lane + 64 * jj]; s2 += v[jj] * v[jj]; }
        s2 = wave_sum(s2);
        const float r2 = rsqrtf(s2 * (1.f / D) + EPS);
#pragma unroll
        for (int jj = 0; jj < 16; ++jj) { X1[(size_t)t * D + lane + 64 * jj] = v[jj]; H2[(size_t)t * D + lane + 64 * jj] = v[jj] * r2 * P.in[I_GPREF][lane + 64 * jj]; }
    }
}
__device__ __forceinline__ void st_act(const Params& P, const Item& I) {
    const float* GU = P.ws + W_GU; float* ACT = P.ws + W_ACT;
    const int n = I.T * DFF;
    for (int e = blockIdx.x * blockDim.x + threadIdx.x; e < n; e += gridDim.x * blockDim.x) {
        const int t = e / DFF, c = e % DFF;
        ACT[e] = siluf_(GU[(size_t)t * 2 * DFF + c]) * GU[(size_t)t * 2 * DFF + DFF + c];
    }
}
__device__ __forceinline__ void st_final(const Params& P, const Item& I) {
    const int lane = threadIdx.x & 63, wv = threadIdx.x >> 6;
    const float* FFO = P.ws + W_FFO; const float* X1 = P.ws + W_X1;
    for (int t = blockIdx.x * 4 + wv; t < I.T; t += gridDim.x * 4) {
        float* y;
        if (I.samp) y = P.out + OUT_YS + ((size_t)I.b * DEC_T + t) * D;
        else { if (t < NMETA) continue; y = P.out + OUT_YP + ((size_t)I.b * SEQ + (t - NMETA)) * D; }
        float v[16]; float ss = 0.f;
#pragma unroll
        for (int jj = 0; jj < 16; ++jj) { v[jj] = FFO[(size_t)t * D + lane + 64 * jj]; ss += v[jj] * v[jj]; }
        ss = wave_sum(ss);
        const float r = rsqrtf(ss * (1.f / D) + EPS);
#pragma unroll
        for (int jj = 0; jj < 16; ++jj) y[lane + 64 * jj] = X1[(size_t)t * D + lane + 64 * jj] + v[jj] * r * P.in[I_GPOSTF][lane + 64 * jj];
    }
}

constexpr int NSTAGE = 17;
template <int s> __device__ __forceinline__ void run_stage(const Params& P, const Item& I, float* sm) {
    float* ws = P.ws;
    switch (s) {
    case 0: st_norm_in(P, I); break;
    case 1: sgemm(ws + W_H, D, P.in[I_WIN], DIN, ws + W_Z, DIN, I.T, DIN, D, P.in[I_BIN], 1.f, sm); break;
    case 2: st_fox_prep(P, I); break;
    case 3: st_fcum(P, I); break;
    case 4: st_attn(P, I, sm); break;
    case 5: st_conv(P, I); break;
    case 6:
        for (int h = 0; h < MH; ++h) {
            sgemm(ws + W_XC + h * MD, MW, P.in[I_WMQ] + (size_t)h * MD * MD, MD, ws + W_MQ + h * MD, MW, I.T, MD, MD, nullptr, 1.f, sm);
            sgemm(ws + W_XC + h * MD, MW, P.in[I_WMK] + (size_t)h * MD * MD, MD, ws + W_MK + h * MD, MW, I.T, MD, MD, nullptr, 0.08838834764831845f, sm);
        }
        break;
    case 7: st_mlstm(P, I, sm); break;
    case 8: st_hm(P, I); break;
    case 9:
        sgemm(ws + W_AT, FW, P.in[I_WFOX], D, ws + W_YA, D, I.T, D, FW, nullptr, 1.f, sm);
        sgemm(ws + W_HM, MW, P.in[I_WML], D, ws + W_YB, D, I.T, D, MW, nullptr, 1.f, sm);
        break;
    case 10: st_merge(P, I); break;
    case 11: sgemm(ws + W_YA, D, P.in[I_WOUT], D, ws + W_OB, D, I.T, D, D, nullptr, 1.f, sm); break;
    case 12: st_mid(P, I); break;
    case 13: sgemm(ws + W_H2, D, P.in[I_WGU], 2 * DFF, ws + W_GU, 2 * DFF, I.T, 2 * DFF, D, nullptr, 1.f, sm); break;
    case 14: st_act(P, I); break;
    case 15: sgemm(ws + W_ACT, DFF, P.in[I_WDN], D, ws + W_FFO, D, I.T, D, DFF, nullptr, 1.f, sm); break;
    case 16: st_final(P, I); break;
    }
}

template <int s> __global__ void __launch_bounds__(256) stage_kernel(Params P) {
    __shared__ __attribute__((aligned(16))) float sm[2304];
    for (int it = P.item_lo; it < P.item_hi; ++it) { const Item I = get_item(it); run_stage<s>(P, I, sm); }
}
template <int s> struct StageLoop {
    static void launch(const Params& P, int grid, hipStream_t stream) { StageLoop<s - 1>::launch(P, grid, stream); hipLaunchKernelGGL(stage_kernel<s>, dim3(grid), dim3(256), 0, stream, P); }
    template <class H> static void launch_hook(const Params& P, int grid, hipStream_t stream, int it, H& hook) { StageLoop<s - 1>::launch_hook(P, grid, stream, it, hook); hipLaunchKernelGGL(stage_kernel<s>, dim3(grid), dim3(256), 0, stream, P); hook(it, s); }
};
template <> struct StageLoop<-1> {
    static void launch(const Params&, int, hipStream_t) {}
    template <class H> static void launch_hook(const Params&, int, hipStream_t, int, H&) {}
};
#endif

namespace pg8 {
#define PG8_LAS __attribute__((address_space(3)))
typedef unsigned short bf16_t;
typedef short bf16x8 __attribute__((ext_vector_type(8)));
typedef float f32x4 __attribute__((ext_vector_type(4)));
typedef unsigned u32x4 __attribute__((ext_vector_type(4)));
constexpr int BM = 256, BK = 64, HALF = 128, HTB = HALF * BK * 2  , STAGE_BYTES = 8 * HTB, NXCD = 8, WGM = 8;

__host__ __device__ __forceinline__ int lds_byte(int r, int c) { const int st = (r >> 4) * 2 + (c >> 5), rr = r & 15, cc = c & 31, ob = rr * 64 + cc * 2; return st * 1024 + (ob ^ (((ob >> 9) & 1) << 5)); }
__host__ __device__ __forceinline__ void stage_rc(int b, int& R, int& C) { const int st = b / 1024, sb = b % 1024, swz = sb ^ (((sb >> 9) & 1) << 5); R = (st >> 1) * 16 + swz / 64; C = (st & 1) * 32 + (swz % 64) / 2; }
__host__ __device__ __forceinline__ int perm32(int rho) { const int n = rho >> 4, i = rho & 15; return 8 * (i >> 2) + 4 * n + (i & 3); }

struct Unit { int pm, pn, rb; };
struct Gemm { const bf16_t* A; const bf16_t* Bt; int M, N, K; const bf16_t* A2 = nullptr; int lda = 0; };

struct StaticOrder {
    int nM, nN, nwg, G, c, rp, roff;
    __host__ __device__ void init(int M, int N, int G_, int c_, int rp_ = 0, int roff_ = 0) { nM = M / BM; nN = N / BM; nwg = nM * nN; G = G_; c = c_; rp = rp_; roff = roff_; }
    __host__ __device__ bool next(int i, Unit& u) const {
        const long L = (long)i * G + c; if (L >= nwg) return false;
        int wgid = (int)L; { const int q = nwg / NXCD, r = nwg % NXCD, xcd = wgid % NXCD, off = wgid / NXCD; wgid = (xcd < r ? xcd * (q + 1) : r * (q + 1) + (xcd - r) * q) + off; }
        const int nig = WGM * nN, gid = wgid / nig, fm = gid * WGM, gsz = (nM - fm) < WGM ? (nM - fm) : WGM;
        u.pm = fm + ((wgid % nig) % gsz); u.pn = (wgid % nig) / gsz; u.rb = rp ? (u.pm >> 4) * rp + roff + (u.pm & 15) * BM : u.pm * BM; return true;
    }
    __device__ __forceinline__ void a_ready(const Unit&) const {}
    __device__ __forceinline__ void done(const Unit&) const {}
};

__device__ __forceinline__ unsigned cvt_pk_bf16(float lo, float hi) { unsigned r; asm volatile("v_cvt_pk_bf16_f32 %0, %1, %2" : "=v"(r) : "v"(lo), "v"(hi)); return r; }
typedef float f32x2 __attribute__((ext_vector_type(2)));
__device__ __forceinline__ f32x2 gelu_pk(f32x2 v) {
    const f32x2 av = __builtin_elementwise_abs(v), d = av * 0.2316418882f + 1.0f;
    f32x2 t; t.x = __builtin_amdgcn_rcpf(d.x); t.y = __builtin_amdgcn_rcpf(d.y);
    f32x2 q = t * 0.5307027145f + (-0.7265760135f); q = q * t + 0.7107068705f; q = q * t + (-0.142248368f); q = q * t + 0.127414796f; q = q * t;
    const f32x2 s = (v * v) * (-0.72134752044f);
    f32x2 e; e.x = __builtin_amdgcn_exp2f(s.x); e.y = __builtin_amdgcn_exp2f(s.y);
    const f32x2 m = v * (q * e), r = v - m;
    f32x2 o; o.x = v.x < 0.f ? m.x : r.x; o.y = v.y < 0.f ? m.y : r.y; return o;
}

template <int ACT  > struct EpiBf16 {
    static constexpr bool PERM = true, AFTER_DRAIN = false, HAS_MID = false; static_assert(ACT == 0 || ACT == 1, "EpiBf16: ACT is 0 (none) or 1 (gelu_pk)");
    bf16_t* O; int ldc; const float* bias; int split_cols; size_t split_stride; float scale0;
    __device__ __forceinline__ void operator()(const f32x4 (&acc)[2][2][4][2], const Unit& u, int wr, int wc, int fr, int fq) const {
        const int row0 = u.rb + wr * 64 + fr; int colt = u.pn * BM; bf16_t* base = O;
        float sc = 1.f; if (split_cols) { const int t = colt / split_cols; base += (size_t)t * split_stride; colt -= t * split_cols; if (t == 0) sc = scale0; }
        const int col0 = colt + wc * 32 + 8 * fq, bcol0 = u.pn * BM + wc * 32 + 8 * fq;
        f32x4 bv[2][2];
#pragma unroll
        for (int bj = 0; bj < 2; ++bj)
#pragma unroll
            for (int n = 0; n < 2; ++n) bv[bj][n] = bias ? *(const f32x4*)(bias + bcol0 + bj * HALF + 4 * n) : (f32x4){0.f, 0.f, 0.f, 0.f};
#pragma unroll
        for (int ai = 0; ai < 2; ++ai)
#pragma unroll
            for (int m = 0; m < 4; ++m) { bf16_t* rowp = base + (size_t)(row0 + ai * HALF + m * 16) * ldc + col0;
#pragma unroll
                for (int bj = 0; bj < 2; ++bj) { f32x4 v0 = acc[ai][bj][m][0] + bv[bj][0], v1 = acc[ai][bj][m][1] + bv[bj][1];
                    if (ACT == 1) { f32x2 a = gelu_pk((f32x2){v0[0], v0[1]}), b = gelu_pk((f32x2){v0[2], v0[3]}), c = gelu_pk((f32x2){v1[0], v1[1]}), d = gelu_pk((f32x2){v1[2], v1[3]});
                        v0 = (f32x4){a.x, a.y, b.x, b.y}; v1 = (f32x4){c.x, c.y, d.x, d.y}; }
                    v0 = v0 * sc; v1 = v1 * sc; u32x4 w; w.x = cvt_pk_bf16(v0[0], v0[1]); w.y = cvt_pk_bf16(v0[2], v0[3]); w.z = cvt_pk_bf16(v1[0], v1[1]); w.w = cvt_pk_bf16(v1[2], v1[3]);
                    *(u32x4*)(rowp + bj * HALF) = w; } }
    }
};
template <class Epi, class Sched, bool ALIGN_EPI = false, bool SP2 = false>
__device__ __forceinline__ void gemm_phase(PG8_LAS unsigned char* lds, const Gemm g, const Sched& S, const Epi& E) {
    const int tid = threadIdx.x, wid = __builtin_amdgcn_readfirstlane(tid >> 6), lane = tid & 63, wr = wid >> 2, wc = wid & 3, fr = lane & 15, fq = lane >> 4;
    const int K = g.K, nt = K / BK, lda = g.lda ? g.lda : g.K, nth = nt / 2;
    unsigned voffA[2], voffB[2];
#pragma unroll
    for (int i = 0; i < 2; ++i) { int R, C; stage_rc(tid * 16 + i * 8192, R, C); const int Rb = Epi::PERM ? ((R & ~31) + perm32(R & 31)) : R;
        voffA[i] = (unsigned)(R * lda + C) * 2u; voffB[i] = (unsigned)(Rb * K + C) * 2u; }
    const size_t kstep = (size_t)(BK * 2);
    const size_t hstep = (size_t)HALF * K * 2;
    const size_t hstepA = (size_t)HALF * lda * 2;
    const size_t tstep = 2 * hstep;
    const unsigned ldsw = (unsigned)wid * 1024u;
    const int aoff = lds_byte(wr * 64 + fr, fq * 8), boff = lds_byte(wc * 32 + fr, fq * 8);
#define PG8_SA(b, h) (((b) * 2 + (h)) * HTB)
#define PG8_SB(b, h) ((4 + (b) * 2 + (h)) * HTB)
#define PG8_STAGE(bufoff, gbase, voff) do { _Pragma("unroll") for (int _i = 0; _i < 2; ++_i) \
        __builtin_amdgcn_global_load_lds((const unsigned*)((const char*)(gbase) + (voff)[_i]), (PG8_LAS unsigned*)(lds + (bufoff) + ldsw + _i * 8192), 16, 0, 0); } while (0)
#define PG8_LDA(dst, b, h) do { _Pragma("unroll") for (int m = 0; m < 4; ++m) _Pragma("unroll") for (int k = 0; k < 2; ++k) dst[m][k] = *(const PG8_LAS bf16x8*)(lds + PG8_SA(b, h) + aoff + m * 2048 + k * 1024); } while (0)
#define PG8_LDB(dst, b, h) do { _Pragma("unroll") for (int n = 0; n < 2; ++n) _Pragma("unroll") for (int k = 0; k < 2; ++k) dst[n][k] = *(const PG8_LAS bf16x8*)(lds + PG8_SB(b, h) + boff + n * 2048 + k * 1024); } while (0)
#define PG8_MMA(ai, bj, At, Bt) do { __builtin_amdgcn_s_setprio(1); _Pragma("unroll") for (int m = 0; m < 4; ++m) _Pragma("unroll") for (int n = 0; n < 2; ++n) _Pragma("unroll") for (int k = 0; k < 2; ++k) \
        acc[ai][bj][m][n] = __builtin_amdgcn_mfma_f32_16x16x32_bf16(Bt[n][k], At[m][k], acc[ai][bj][m][n], 0, 0, 0); __builtin_amdgcn_s_setprio(0); } while (0)
#define PG8_WAIT_V(n) asm volatile("s_waitcnt vmcnt(" #n ")" ::: "memory")
#define PG8_WAIT_L(n) asm volatile("s_waitcnt lgkmcnt(" #n ")" ::: "memory")
#define PG8_BAR __builtin_amdgcn_s_barrier()
#define PG8_SCHED __builtin_amdgcn_sched_barrier(0)
    Unit cur, nxt; int ui = 0;
    if (!S.next(0, cur)) return;
    f32x4 acc[2][2][4][2];
#pragma unroll
    for (int a = 0; a < 2; ++a)
#pragma unroll
        for (int b = 0; b < 2; ++b)
#pragma unroll
            for (int m = 0; m < 4; ++m)
#pragma unroll
                for (int n = 0; n < 2; ++n) acc[a][b][m][n] = (f32x4){0.f, 0.f, 0.f, 0.f};
    bf16x8 At[4][2], B0[2][2], B1[2][2];
    const char* cA = (const char*)g.A + (size_t)cur.rb * (size_t)lda * 2; const char* cA2 = g.A2 ? (const char*)g.A2 + (size_t)cur.rb * (size_t)lda * 2 : nullptr; const char* cB = (const char*)g.Bt + (size_t)cur.pn * tstep;
    S.a_ready(cur);
    if constexpr (SP2) {
        PG8_STAGE(PG8_SB(0, 0), cB, voffB); PG8_STAGE(PG8_SB(0, 1), cB + hstep, voffB); PG8_STAGE(PG8_SA(0, 0), cA, voffA); PG8_STAGE(PG8_SA(0, 1), cA + hstepA, voffA);
        if (wr == 1) PG8_BAR;
        PG8_WAIT_V(2); PG8_BAR;
        PG8_STAGE(PG8_SB(1, 0), cB + kstep, voffB); PG8_STAGE(PG8_SA(1, 0), cA + kstep, voffA); PG8_STAGE(PG8_SB(1, 1), cB + hstep + kstep, voffB);
        PG8_WAIT_V(6); PG8_BAR;
    } else {
        PG8_STAGE(PG8_SB(0, 0), cB, voffB); PG8_STAGE(PG8_SA(0, 0), cA, voffA); PG8_STAGE(PG8_SB(0, 1), cB + hstep, voffB); PG8_STAGE(PG8_SA(0, 1), cA + hstepA, voffA);
        if (wr == 1) PG8_BAR;
        PG8_WAIT_V(4); PG8_BAR;
        PG8_STAGE(PG8_SB(1, 0), cB + kstep, voffB); PG8_STAGE(PG8_SA(1, 0), cA + kstep, voffA); PG8_STAGE(PG8_SB(1, 1), cB + hstep + kstep, voffB);
        PG8_WAIT_V(6); PG8_BAR;
    }
    for (;;) {
        const bool has_next = S.next(ui + 1, nxt);
        const char* nA = has_next ? (const char*)g.A + (size_t)nxt.rb * (size_t)lda * 2 : cA; const char* nB = has_next ? (const char*)g.Bt + (size_t)nxt.pn * tstep : cB;
        for (int t = 0; t < nt; t += 2) {
            const bool last = (t == nt - 2);
            const char* a1 = (cA2 && t + 1 >= nth) ? cA2 + (size_t)(t + 1 - nth) * kstep : cA + (size_t)(t + 1) * kstep;
            if constexpr (Epi::HAS_MID) { if (t == nth) E.mid(acc, cur, wr, wc, fr, fq); }
            const char* a2 = last ? nA : ((cA2 && t + 2 >= nth) ? cA2 + (size_t)(t + 2 - nth) * kstep : cA + (size_t)(t + 2) * kstep); const char* b2 = last ? nB : cB + (size_t)(t + 2) * kstep;
            const char* a3 = a2 + kstep; const char* b3 = b2 + kstep;
            if (last && has_next) S.a_ready(nxt);
            if constexpr (SP2) {
            PG8_LDB(B0, 0, 0); PG8_LDB(B1, 0, 1); PG8_SCHED; PG8_LDA(At, 0, 0); PG8_STAGE(PG8_SA(1, 1), a1 + hstepA, voffA);
            PG8_WAIT_V(8); PG8_WAIT_L(0); PG8_BAR; PG8_MMA(0, 0, At, B0); PG8_MMA(0, 1, At, B1); PG8_BAR; PG8_SCHED;
            PG8_LDA(At, 0, 1); PG8_STAGE(PG8_SB(0, 0), b2, voffB); PG8_STAGE(PG8_SB(0, 1), b2 + hstep, voffB); PG8_STAGE(PG8_SA(0, 0), a2, voffA);
            PG8_WAIT_V(8); PG8_WAIT_L(0); PG8_BAR; PG8_MMA(1, 0, At, B0); PG8_MMA(1, 1, At, B1); PG8_BAR; PG8_SCHED;
            PG8_LDB(B0, 1, 0); PG8_LDB(B1, 1, 1); PG8_SCHED; PG8_LDA(At, 1, 0); PG8_STAGE(PG8_SA(0, 1), a2 + hstepA, voffA);
            PG8_WAIT_V(8); PG8_WAIT_L(0); PG8_BAR; PG8_MMA(0, 0, At, B0); PG8_MMA(0, 1, At, B1); PG8_BAR; PG8_SCHED;
            PG8_LDA(At, 1, 1); PG8_STAGE(PG8_SB(1, 0), b3, voffB); PG8_STAGE(PG8_SB(1, 1), b3 + hstep, voffB); PG8_STAGE(PG8_SA(1, 0), a3, voffA);
            PG8_WAIT_V(8); PG8_WAIT_L(0); PG8_BAR; PG8_MMA(1, 0, At, B0); PG8_MMA(1, 1, At, B1); PG8_BAR; PG8_SCHED;
            } else {
            PG8_LDB(B0, 0, 0); PG8_SCHED; PG8_LDA(At, 0, 0); PG8_STAGE(PG8_SA(1, 1), a1 + hstepA, voffA);
            PG8_WAIT_L(8); PG8_BAR; PG8_WAIT_L(0); PG8_MMA(0, 0, At, B0); PG8_BAR; PG8_SCHED;
            PG8_LDB(B1, 0, 1); PG8_STAGE(PG8_SB(0, 0), b2, voffB);
            PG8_BAR; PG8_WAIT_L(0); PG8_MMA(0, 1, At, B1); PG8_BAR;
            PG8_LDA(At, 0, 1); PG8_STAGE(PG8_SA(0, 0), a2, voffA);
            PG8_BAR; PG8_WAIT_L(0); PG8_MMA(1, 0, At, B0); PG8_BAR; PG8_SCHED;
            PG8_STAGE(PG8_SB(0, 1), b2 + hstep, voffB);
            PG8_WAIT_V(6); PG8_BAR; PG8_MMA(1, 1, At, B1); PG8_BAR;
            PG8_LDB(B0, 1, 0); PG8_SCHED; PG8_LDA(At, 1, 0); PG8_STAGE(PG8_SA(0, 1), a2 + hstepA, voffA);
            PG8_WAIT_L(8); PG8_BAR; PG8_WAIT_L(0); PG8_MMA(0, 0, At, B0); PG8_BAR; PG8_SCHED;
            PG8_LDB(B1, 1, 1); PG8_STAGE(PG8_SB(1, 0), b3, voffB);
            PG8_BAR; PG8_WAIT_L(0); PG8_MMA(0, 1, At, B1); PG8_BAR;
            PG8_LDA(At, 1, 1); PG8_STAGE(PG8_SA(1, 0), a3, voffA);
            PG8_BAR; PG8_WAIT_L(0); PG8_MMA(1, 0, At, B0); PG8_BAR; PG8_SCHED;
            PG8_STAGE(PG8_SB(1, 1), b3 + hstep, voffB);
            PG8_WAIT_V(6); PG8_BAR; PG8_MMA(1, 1, At, B1); PG8_BAR;
            }
        }
        if constexpr (ALIGN_EPI) { if (wr == 0) PG8_BAR; }
        if constexpr (!Epi::AFTER_DRAIN) { E(acc, cur, wr, wc, fr, fq); S.done(cur); }
        if (!has_next) break;
#pragma unroll
        for (int a = 0; a < 2; ++a)
#pragma unroll
            for (int b = 0; b < 2; ++b)
#pragma unroll
                for (int m = 0; m < 4; ++m)
#pragma unroll
                    for (int n = 0; n < 2; ++n) acc[a][b][m][n] = (f32x4){0.f, 0.f, 0.f, 0.f};
        cur = nxt; cA = nA; cB = nB; ++ui; if (g.A2) cA2 = (const char*)g.A2 + (size_t)cur.rb * (size_t)lda * 2;
        if constexpr (ALIGN_EPI) { if (wr == 1) PG8_BAR; }
    }
    PG8_WAIT_V(0);
    if constexpr (!ALIGN_EPI) { if (wr == 0) PG8_BAR; }
    PG8_BAR;
    if constexpr (Epi::AFTER_DRAIN) { E.fused(acc, cur, wr, wc, fr, fq, lds, wid, lane); S.done(cur); }
#undef PG8_SA
#undef PG8_SB
#undef PG8_STAGE
#undef PG8_LDA
#undef PG8_LDB
#undef PG8_MMA
#undef PG8_WAIT_V
#undef PG8_WAIT_L
#undef PG8_BAR
#undef PG8_SCHED
}
}

#ifndef FAST_NPB
#define FAST_NPB 8
#endif
#define LAS __attribute__((address_space(3)))
#define GAS __attribute__((address_space(1)))
namespace fk {
using pg8::bf16_t;
typedef unsigned v4u __attribute__((ext_vector_type(4)));
typedef unsigned v2u __attribute__((ext_vector_type(2)));
typedef float f32x4 __attribute__((ext_vector_type(4)));
typedef float f32x16 __attribute__((ext_vector_type(16)));
typedef short bf16x8 __attribute__((ext_vector_type(8)));
typedef short s16x4 __attribute__((ext_vector_type(4)));
constexpr int NPB = FAST_NPB;
constexpr int RP = 4160, PADF = 48, NCH = RP / 64;
constexpr int SROW0 = NPB * RP;
constexpr int MREAL = SROW0 + NB * DEC_T;
constexpr int M = (MREAL + 255) / 256 * 256;
constexpr size_t SE = (size_t)M * 512;
constexpr size_t SB = SE * 2;
constexpr int NZ = 5376;
constexpr size_t MiB = 1u << 20;
constexpr size_t alignM(size_t x) { return (x + MiB - 1) / MiB * MiB; }
constexpr size_t WS_CTL = 0, CTL_ZERO_BYTES = 1 * MiB;
constexpr size_t WS_WIN = 1 * MiB, WS_WGU = 12 * MiB, WS_WDN = 23 * MiB, WS_WOUT = 29 * MiB, WS_WFOX = 31 * MiB, WS_WML = 32 * MiB, WS_WMQ = 33 * MiB, WS_WMK = 33 * MiB + 131072, WS_BIAS = 34 * MiB;
constexpr size_t WS_A = 35 * MiB;
constexpr size_t WS_Z = WS_A + alignM(2 * SB);
constexpr int ZQ = 0, ZK = 1, ZV = 2, ZMX = 3, ZMV = 4, ZMO = 5, ZGA = 6, ZGB = 8, ZGT = 10;
constexpr size_t WS_MISC = alignM(WS_Z + 11 * SB);
constexpr int NBPL = 4416;
constexpr int NBSL = 1280;
constexpr int NITEM_L = (NPB * NCH + NB) * MH;
constexpr size_t MS_NBP = 0;
constexpr size_t MS_NBS = MS_NBP + (size_t)NPB * FH * NBPL * 4;
constexpr size_t MS_BT = MS_NBS + (size_t)NB * FH * NBSL * 4;
constexpr size_t MS_IGT = MS_BT + (size_t)M * MH * 4;
constexpr size_t MS_CHS = MS_IGT + (size_t)M * MH * 4;
constexpr size_t MS_NL = MS_CHS + (size_t)NITEM_L * 2 * 4;
constexpr size_t MS_JST = MS_NL + (size_t)NITEM_L * MD * 4;
constexpr int TOTP_L = 80, TOTS_L = 32;
constexpr size_t MS_TOTS = MS_JST + (size_t)NPB * FH * TOTP_L * 4;
constexpr size_t MS_TH2 = MS_TOTS + (size_t)NB * FH * TOTS_L * 4;
constexpr size_t MS_MC = MS_TH2 + 64;
constexpr size_t MS_END = MS_MC + (size_t)NITEM_L * 4;
constexpr size_t WS_KS = alignM(WS_MISC + MS_END);
constexpr size_t WS_VS = WS_KS + (size_t)NB * NBSL * FW * 2;
constexpr size_t WS_SCR = alignM(WS_VS + (size_t)NB * NBSL * FW * 2);
constexpr size_t SCR_BYTES = 3 * SB + 4096;
#if FAST_NPB == 8
constexpr size_t WS_FASTEND = WS_SCR;
static_assert(SCR_BYTES <= (size_t)NB * SEQ * D * 4, "scratch fits y_prompt");
#else
constexpr size_t WS_FASTEND = alignM(WS_SCR + SCR_BYTES + 2 * (size_t)M * D * 4);
#endif
constexpr int CW_TMO = 0, CW_BAR = 4096, CW_QUE = 16384;

struct FP { const float* in[29]; float* out; unsigned char* ws; unsigned char* scr; int ph_lo, ph_hi; };

#define LDS_WAIT() asm volatile("s_waitcnt lgkmcnt(0)" ::: "memory")
#define VM_WAIT() asm volatile("s_waitcnt vmcnt(0)" ::: "memory")
__device__ __forceinline__ unsigned f2bf(float f) { unsigned u = __builtin_bit_cast(unsigned, f); return (u + 0x7fffu + ((u >> 16) & 1u)) >> 16; }
__device__ __forceinline__ unsigned pk2(float lo, float hi) { return f2bf(lo) | (f2bf(hi) << 16); }
__device__ __forceinline__ float bf2f(unsigned short b) { return __builtin_bit_cast(float, (unsigned)b << 16); }
__device__ __forceinline__ float bflo(unsigned w) { return __builtin_bit_cast(float, w << 16); }
__device__ __forceinline__ float bfhi(unsigned w) { return __builtin_bit_cast(float, w & 0xffff0000u); }

__host__ __device__ __forceinline__ int fox_perm(int c) { const int blk = c >> 9, h = (c >> 6) & 7, d = c & 63; return blk * 512 + (h >> 2) * 256 + (d >> 5) * 128 + (h & 3) * 32 + (d & 31); }
template <bool FOXPERM = false>
__device__ __forceinline__ void tr_item(const float* W, int K, int N, int col0, int ncols, bf16_t* WT, int row_off, LAS float* scr, int item, int lane, int pitch = 0) {
    const int nblk = ncols / 32, kb = item / nblk, nb = item % nblk, k0 = 64 * kb, n0 = 32 * nb; if (!pitch) pitch = K;
    const int d0 = FOXPERM ? fox_perm(n0) : n0;
#pragma unroll 8
    for (int i = 0; i < 32; ++i) { const int kk = 2 * i + (lane >> 5); scr[kk * 33 + (lane & 31)] = W[(size_t)(k0 + kk) * N + col0 + n0 + (lane & 31)]; }
    LDS_WAIT(); asm volatile("" ::: "memory");
    const int c = lane & 7;
#pragma unroll
    for (int j = 0; j < 4; ++j) { const int n = (lane >> 3) + 8 * j; const LAS float* s = scr + (8 * c) * 33 + n;
        v4u o; o.x = pk2(s[0 * 33], s[1 * 33]); o.y = pk2(s[2 * 33], s[3 * 33]); o.z = pk2(s[4 * 33], s[5 * 33]); o.w = pk2(s[6 * 33], s[7 * 33]);
        *(v4u*)(WT + (size_t)(row_off + d0 + n) * pitch + k0 + 8 * c) = o; }
    LDS_WAIT(); asm volatile("" ::: "memory");
}
__device__ __forceinline__ const float* fast_xrow(const FP& P, int r) {
    if (r < SROW0) { const int b = r / RP, p = r % RP; if (p < PADF) return nullptr; const int t = p - PADF;
        return t < NMETA ? P.in[I_META] + (size_t)t * D : P.in[I_XP] + ((size_t)b * SEQ + (t - NMETA)) * D; }
    if (r < MREAL) return P.in[I_XS] + (size_t)(r - SROW0) * D;
    return nullptr;
}
__device__ __forceinline__ void p0_prologue(const FP& P, LAS unsigned char* lds) {
    const int tid = threadIdx.x, lane = tid & 63, wave = tid >> 6;
    const int gw = blockIdx.x * 8 + wave, NGW = gridDim.x * 8;
    unsigned char* ws = P.ws;
    bf16_t* Win_t = (bf16_t*)(ws + WS_WIN); bf16_t* Wgu_t = (bf16_t*)(ws + WS_WGU); bf16_t* Wdn_t = (bf16_t*)(ws + WS_WDN); bf16_t* Wout_t = (bf16_t*)(ws + WS_WOUT);
    bf16_t* Wfox_t = (bf16_t*)(ws + WS_WFOX); bf16_t* Wml_t = (bf16_t*)(ws + WS_WML); bf16_t* Wmq_t = (bf16_t*)(ws + WS_WMQ); bf16_t* Wmk_t = (bf16_t*)(ws + WS_WMK);
    LAS float* scr = (LAS float*)(lds + wave * 16384);
    constexpr int I_IN = 16 * (5120 / 32), I_GU = 44 * 64, I_DN = 44 * 32, I_OUT = 16 * 32, I_FOX = 8 * 32, I_MQ = 4 * 8;
    constexpr int NITEMS = I_IN + I_GU + I_DN + I_OUT + 2 * I_FOX + 2 * I_MQ;
    for (int it = gw; it < NITEMS; it += NGW) {
        int r = it;
        if (r < I_IN) {
            if (r < 768) { tr_item<true>(P.in[I_WIN], D, DIN, 0, 1536, Win_t, 0, scr, r, lane); continue; } r -= 768;
            if (r < 256) { tr_item(P.in[I_WIN], D, DIN, O_MX, 512, Win_t, 1536, scr, r, lane); continue; } r -= 256;
            if (r < 256) { tr_item(P.in[I_WIN], D, DIN, O_MV, 512, Win_t, 2048, scr, r, lane); continue; } r -= 256;
            if (r < 256) { tr_item(P.in[I_WIN], D, DIN, O_MO, 512, Win_t, 2560, scr, r, lane); continue; } r -= 256;
            if (r < 512) { tr_item(P.in[I_WIN], D, DIN, O_GA, 1024, Win_t, 3072, scr, r, lane); continue; } r -= 512;
            tr_item(P.in[I_WIN], D, DIN, O_GB, 1024, Win_t, 4096, scr, r, lane); continue;
        }
        r -= I_IN;
        if (r < I_GU) { const int sg = r / 64, j = sg >> 1, u = sg & 1; tr_item(P.in[I_WGU], D, 2 * DFF, u * DFF + 128 * j, 128, Wgu_t, 256 * j + 128 * u, scr, r % 64, lane); continue; }
        r -= I_GU;
        if (r < I_DN) { tr_item(P.in[I_WDN], DFF, D, 0, D, Wdn_t, 0, scr, r, lane); continue; } r -= I_DN;
        if (r < I_OUT) { tr_item(P.in[I_WOUT], D, D, 0, D, Wout_t, 0, scr, r, lane); continue; } r -= I_OUT;
        if (r < I_FOX) { tr_item(P.in[I_WFOX], FW, D, 0, D, Wfox_t, 0, scr, r, lane, 2 * FW); continue; } r -= I_FOX;
        if (r < I_FOX) { tr_item(P.in[I_WML], MW, D, 0, D, Wfox_t + FW, 0, scr, r, lane, 2 * FW); continue; } r -= I_FOX;
        if (r < I_MQ) { const int h = r / 8; tr_item(P.in[I_WMQ] + (size_t)h * MD * MD, MD, MD, 0, MD, Wmq_t + (size_t)h * MD * MD, 0, scr, r % 8, lane); continue; } r -= I_MQ;
        { const int h = r / 8; tr_item(P.in[I_WMK] + (size_t)h * MD * MD, MD, MD, 0, MD, Wmk_t + (size_t)h * MD * MD, 0, scr, r % 8, lane); }
    }
    {
        const int gt = blockIdx.x * 512 + tid, NT = gridDim.x * 512;
        for (int e = gt; e < 256 * D; e += NT) {
            const int g = e / D, k = e % D;
            float v = 0.f;
            if (g < 16) { const int oc = g < 8 ? O_FF + g : (g < 12 ? O_MI + (g - 8) : O_MF + (g - 12)); v = P.in[I_WIN][(size_t)k * DIN + oc]; }
            Win_t[(size_t)(5120 + g) * D + k] = (bf16_t)f2bf(v);
        }
        float* bias_p = (float*)(ws + WS_BIAS);
        for (int n = gt; n < NZ; n += NT) {
            int oc = -1;
            if (n < 1536) { const int blk = n >> 9, pn = (n >> 8) & 1, bj = (n >> 7) & 1, wcc = (n >> 5) & 3, i5 = n & 31; oc = blk * 512 + (4 * pn + wcc) * 64 + 32 * bj + i5; } else if (n < 2048) oc = O_MX + (n - 1536); else if (n < 2560) oc = O_MV + (n - 2048); else if (n < 3072) oc = O_MO + (n - 2560);
            else if (n < 4096) oc = O_GA + (n - 3072); else if (n < 5120) oc = O_GB + (n - 4096); else if (n < 5128) oc = O_FF + (n - 5120); else if (n < 5132) oc = O_MI + (n - 5128); else if (n < 5136) oc = O_MF + (n - 5132);
            bias_p[n] = oc >= 0 ? P.in[I_BIN][oc] : 0.f;
        }
        bf16_t* KS = (bf16_t*)(ws + WS_KS); bf16_t* VS = (bf16_t*)(ws + WS_VS);
        for (int e = gt; e < NB * NBSL * (FW / 4); e += NT) {
            const int c4 = e % (FW / 4), i = (e / (FW / 4)) % NBSL, b = e / ((FW / 4) * NBSL);
            if (i >= PAST && i < PAST + DEC_T) continue;
            float4 kv = make_float4(0.f, 0.f, 0.f, 0.f), vv = kv;
            if (i < PAST) { kv = *(const float4*)(P.in[I_CK] + ((size_t)b * PAST + i) * FW + c4 * 4); vv = *(const float4*)(P.in[I_CV] + ((size_t)b * PAST + i) * FW + c4 * 4); }
            v2u ko, vo; ko.x = pk2(kv.x, kv.y); ko.y = pk2(kv.z, kv.w); vo.x = pk2(vv.x, vv.y); vo.y = pk2(vv.z, vv.w);
            *(v2u*)(KS + ((size_t)b * NBSL + i) * FW + c4 * 4) = ko; *(v2u*)(VS + ((size_t)b * NBSL + i) * FW + c4 * 4) = vo;
        }
    }
    bf16_t* A = (bf16_t*)(ws + WS_A);
    for (int r0 = gw; r0 < M; r0 += 2 * NGW) {
        const float* x[2]; int rr[2]; bool inr[2];
#pragma unroll
        for (int q = 0; q < 2; ++q) { rr[q] = r0 + q * NGW; inr[q] = rr[q] < M; x[q] = inr[q] ? fast_xrow(P, rr[q]) : nullptr; }
        f32x4 v[2][4]; float s[2] = {0.f, 0.f};
#pragma unroll
        for (int q = 0; q < 2; ++q) { const f32x4* xr = (const f32x4*)(x[q] ? x[q] : P.in[I_XS]) + lane;
#pragma unroll
            for (int j = 0; j < 4; ++j) { v[q][j] = xr[64 * j]; s[q] += (v[q][j].x * v[q][j].x + v[q][j].y * v[q][j].y) + (v[q][j].z * v[q][j].z + v[q][j].w * v[q][j].w); } }
        float rs[2];
#pragma unroll
        for (int q = 0; q < 2; ++q) rs[q] = rsqrtf(wave_sum(s[q]) * (1.f / D) + EPS);
#pragma unroll
        for (int j = 0; j < 4; ++j) { const f32x4 g = *((const f32x4*)P.in[I_GPRE] + lane + 64 * j);
#pragma unroll
            for (int q = 0; q < 2; ++q) if (inr[q]) { unsigned long long* o8 = (unsigned long long*)(A + (size_t)rr[q] * D) + lane;
                const f32x4 w = v[q][j] * rs[q] * g; o8[64 * j] = x[q] ? ((unsigned long long)pk2(w.x, w.y) | ((unsigned long long)pk2(w.z, w.w) << 32)) : 0ull; } }
    }
}
}
namespace fk {
constexpr float LOG2E = 1.4426950408889634f;
constexpr float C2Q = 0.125f * LOG2E;
constexpr float NEGBIG = -1e30f;
constexpr float SKIP_THR = 32.f;

__device__ __forceinline__ float wave_scan_add(float v, int lane) {
#pragma unroll
    for (int o = 1; o < 64; o <<= 1) { const float u = __shfl_up(v, o); if (lane >= o) v += u; }
    return v;
}
__device__ __forceinline__ float wave_scan_max(float v, int lane) {
#pragma unroll
    for (int o = 1; o < 64; o <<= 1) { const float u = __shfl_up(v, o); if (lane >= o) v = fmaxf(v, u); }
    return v;
}
__device__ __forceinline__ float fexp(float x) { return __builtin_amdgcn_exp2f(x * LOG2E); }
__device__ __forceinline__ float fsig(float x) { return __builtin_amdgcn_rcpf(1.f + __builtin_amdgcn_exp2f(-LOG2E * x)); }
__device__ __forceinline__ f32x4 mfma16(bf16x8 a, bf16x8 b, f32x4 c) { return __builtin_amdgcn_mfma_f32_16x16x32_bf16(a, b, c, 0, 0, 0); }

struct ZB {
    bf16_t* z;
    __device__ __forceinline__ bf16_t* buf(int i) const { return z + (size_t)i * SE; }
};


struct EpiIn {
    static constexpr bool PERM = true, AFTER_DRAIN = false, HAS_MID = false;
    bf16_t* Z; const float* bias; const float* gq; const float* gk; float* out; bf16_t* KS; bf16_t* VS;
    __device__ __forceinline__ void operator()(const pg8::f32x4 (&acc)[2][2][4][2], const pg8::Unit& u, int wr, int wc, int fr, int fq) const {
        using pg8::cvt_pk_bf16;
        const int row0 = u.rb + wr * 64 + fr;
        const int bcol0 = u.pn * 256 + wc * 32 + 8 * fq;
        f32x4 bv[2][2];
#pragma unroll
        for (int bj = 0; bj < 2; ++bj)
#pragma unroll
            for (int n = 0; n < 2; ++n) bv[bj][n] = *(const f32x4*)(bias + bcol0 + bj * 128 + 4 * n);
        if (u.pn >= 10 && u.pn < 20) {
            const bool iso = u.pn < 12, isb = u.pn >= 16; unsigned char* g8 = (unsigned char*)(Z + (size_t)(iso ? ZMO : (isb ? ZGB : ZGA)) * SE);
            const int gp = iso ? 512 : 1024;
            const int c0 = (u.pn - (iso ? 10 : (isb ? 16 : 12))) * 256 + wc * 32 + 8 * fq; const float lo = isb ? 1.f : 0.f;
#pragma unroll
            for (int ai = 0; ai < 2; ++ai)
#pragma unroll
                for (int m = 0; m < 4; ++m) { unsigned char* rowp = g8 + (size_t)(row0 + ai * 128 + m * 16) * gp + c0;
#pragma unroll
                    for (int bj = 0; bj < 2; ++bj) { const f32x4 v0 = acc[ai][bj][m][0] + bv[bj][0], v1 = acc[ai][bj][m][1] + bv[bj][1];
                        unsigned q[8];
#pragma unroll
                        for (int i = 0; i < 4; ++i) { q[i] = (unsigned)fmaxf(lo, __builtin_rintf(255.f * fsig(v0[i]))); q[4 + i] = (unsigned)fmaxf(lo, __builtin_rintf(255.f * fsig(v1[i]))); }
                        v2u w; w.x = q[0] | (q[1] << 8) | (q[2] << 16) | (q[3] << 24); w.y = q[4] | (q[5] << 8) | (q[6] << 16) | (q[7] << 24);
                        *(v2u*)(rowp + bj * 128) = w; } }
            return;
        }
        if (u.pn >= 6) {
            const int t = (u.pn * 256) / 512, col0 = u.pn * 256 - t * 512 + wc * 32 + 8 * fq; bf16_t* base = Z + (size_t)t * SE;
#pragma unroll
            for (int ai = 0; ai < 2; ++ai)
#pragma unroll
                for (int m = 0; m < 4; ++m) { bf16_t* rowp = base + (size_t)(row0 + ai * 128 + m * 16) * 512 + col0;
#pragma unroll
                    for (int bj = 0; bj < 2; ++bj) { const f32x4 v0 = acc[ai][bj][m][0] + bv[bj][0], v1 = acc[ai][bj][m][1] + bv[bj][1];
                        v4u w; w.x = cvt_pk_bf16(v0[0], v0[1]); w.y = cvt_pk_bf16(v0[2], v0[3]); w.z = cvt_pk_bf16(v1[0], v1[1]); w.w = cvt_pk_bf16(v1[2], v1[3]);
                        *(v4u*)(rowp + bj * 128) = w; } }
            return;
        }
        const int kind = u.pn >> 1, h = 4 * (u.pn & 1) + wc, cb = h * 64 + 8 * fq;
        f32x4 gv[2][2];
#pragma unroll
        for (int bj = 0; bj < 2; ++bj)
#pragma unroll
            for (int n = 0; n < 2; ++n) gv[bj][n] = kind == 2 ? (f32x4){1.f, 1.f, 1.f, 1.f} : *(const f32x4*)((kind == 0 ? gq : gk) + cb + 32 * bj + 4 * n);
#pragma unroll
        for (int ai = 0; ai < 2; ++ai)
#pragma unroll
            for (int m = 0; m < 4; ++m) {
                const int row = row0 + ai * 128 + m * 16;
                f32x4 v[2][2]; float ss = 0.f;
#pragma unroll
                for (int bj = 0; bj < 2; ++bj)
#pragma unroll
                    for (int n = 0; n < 2; ++n) { v[bj][n] = acc[ai][bj][m][n] + bv[bj][n]; ss += (v[bj][n][0] * v[bj][n][0] + v[bj][n][1] * v[bj][n][1]) + (v[bj][n][2] * v[bj][n][2] + v[bj][n][3] * v[bj][n][3]); }
                if (kind < 2) {
                    ss += __shfl_xor(ss, 16); ss += __shfl_xor(ss, 32);
                    const float rn = rsqrtf(ss * (1.f / FD) + EPS) * (kind == 0 ? C2Q : 1.f);
#pragma unroll
                    for (int bj = 0; bj < 2; ++bj)
#pragma unroll
                        for (int n = 0; n < 2; ++n) v[bj][n] = v[bj][n] * rn * gv[bj][n];
                }
                float* of = nullptr; bf16_t* sb = nullptr;
                if (kind >= 1) {
                    if (row < SROW0) { const int b = row / RP, p = row - b * RP; if (p >= PADF) of = out + (kind == 1 ? OUT_FKP : OUT_FVP) + ((size_t)b * LP + (p - PADF)) * FW + cb; }
                    else if (row < MREAL) { const int rs = row - SROW0, b = rs / DEC_T, t = rs - b * DEC_T; of = out + (kind == 1 ? OUT_FKS : OUT_FVS) + (size_t)rs * FW + cb;
                        sb = (kind == 1 ? KS : VS) + ((size_t)b * NBSL + PAST + t) * FW + cb; }
                }
                bf16_t* zd = Z + (size_t)kind * SE + (size_t)row * 512 + cb;
#pragma unroll
                for (int bj = 0; bj < 2; ++bj) {
                    v4u w; w.x = cvt_pk_bf16(v[bj][0][0], v[bj][0][1]); w.y = cvt_pk_bf16(v[bj][0][2], v[bj][0][3]); w.z = cvt_pk_bf16(v[bj][1][0], v[bj][1][1]); w.w = cvt_pk_bf16(v[bj][1][2], v[bj][1][3]);
                    *(v4u*)(zd + 32 * bj) = w;
                    if (sb) *(v4u*)(sb + 32 * bj) = w;
                    if (of) { *(f32x4*)(of + 32 * bj) = v[bj][0]; *(f32x4*)(of + 32 * bj + 4) = v[bj][1]; }
                }
            }
    }
};

constexpr int NFT_P = NPB * FH * NCH, NFT = NFT_P + NB * FH * 17;
__device__ __forceinline__ void p2_flocal(const FP& P, int task, int lane) {
    unsigned char* ws = P.ws;
    const bf16_t* GT = (const bf16_t*)(ws + WS_Z) + (size_t)ZGT * SE;
    float* TOTP = (float*)(ws + WS_MISC + MS_JST); float* TOTS = (float*)(ws + WS_MISC + MS_TOTS);
    if (task == 0) {
        float gq = 0.f, gk = 0.f;
#pragma unroll
        for (int j = 0; j < 8; ++j) { gq = fmaxf(gq, fabsf(P.in[I_GFQ][lane + 64 * j])); gk = fmaxf(gk, fabsf(P.in[I_GFK][lane + 64 * j])); }
        gq = wave_max(gq); gk = wave_max(gk);
        if (lane == 0) *(float*)(ws + WS_MISC + MS_TH2) = SKIP_THR + 2.f * C2Q * 64.f * gq * gk + 6.f;
    }
    if (task < NFT_P) {
        const int sq = task / NCH, c = task % NCH, b = sq / FH, fh = sq % FH;
        float* NBP = (float*)(ws + WS_MISC + MS_NBP) + (size_t)sq * NBPL;
        const int p = 64 * c + lane; const size_t row = (size_t)b * RP + p; const bool pad = p < PADF;
        const float lf = pad ? 0.f : logsigmoidf_(bf2f(GT[row * 512 + fh]));
        const float Fv = wave_scan_add(lf, lane);
        NBP[p] = pad ? NEGBIG : -Fv * LOG2E;
        if (!pad) P.out[OUT_LFP + ((size_t)b * LP + (p - PADF)) * FH + fh] = lf;
        if (lane == 63) TOTP[sq * TOTP_L + c] = -Fv * LOG2E;
        if (c == NCH - 1) for (int q = RP + lane; q < NBPL; q += 64) NBP[q] = NEGBIG;
    } else {
        const int t2 = task - NFT_P, s2 = t2 / 17, c = t2 % 17, b = s2 / FH, fh = s2 % FH;
        float* NBS = (float*)(ws + WS_MISC + MS_NBS) + (size_t)s2 * NBSL;
        float lf;
        if (c < 16) lf = P.in[I_CLF][((size_t)b * PAST + 64 * c + lane) * FH + fh];
        else { lf = logsigmoidf_(bf2f(GT[((size_t)SROW0 + b * DEC_T + lane) * 512 + fh])); P.out[OUT_LFS + ((size_t)b * DEC_T + lane) * FH + fh] = lf; }
        const float Fv = wave_scan_add(lf, lane);
        NBS[64 * c + lane] = -Fv * LOG2E;
        if (lane == 63) TOTS[s2 * TOTS_L + c] = -Fv * LOG2E;
        if (c == 16) for (int q = PAST + DEC_T + lane; q < NBSL; q += 64) NBS[q] = NEGBIG;
    }
}

constexpr int XS_P = 136, KT_P = 72;
constexpr int L2_XS = 0, L2_KT = L2_XS + 64 * XS_P * 2, L2_VT = L2_KT + 128 * KT_P * 2, L2_WK = L2_VT + 128 * KT_P * 2, L2_CW = L2_WK + 256, L2_END = L2_CW + 640 * 4;
struct ChunkId { int b, c, row0; bool samp; };
__device__ __forceinline__ ChunkId chunk_of(int ci) { ChunkId k; k.samp = ci >= NPB * NCH; if (!k.samp) { k.b = ci / NCH; k.c = ci % NCH; k.row0 = k.b * RP + 64 * k.c; } else { k.b = ci - NPB * NCH; k.c = 0; k.row0 = SROW0 + 64 * k.b; } return k; }

__device__ __forceinline__ void p2_load(const FP& P, int item, int tid, v4u (&mx)[4][2], v4u (&mv)[2], float& g_mi, float& g_mf) {
    const bf16_t* Z = (const bf16_t*)(P.ws + WS_Z);
    const bf16_t* ZMXp = Z + (size_t)ZMX * SE; const bf16_t* ZMVp = Z + (size_t)ZMV * SE; const bf16_t* GT = Z + (size_t)ZGT * SE;
    const int ci = item >> 2, mh = item & 3; const ChunkId ck = chunk_of(ci);
    const int t = tid >> 3, col = mh * MD + (tid & 7) * 16; const size_t row = (size_t)ck.row0 + t;
#pragma unroll
    for (int i = 0; i < 4; ++i) {
        const int pu = 64 * ck.c + t + i - 3 - (ck.samp ? 0 : PADF);
        if (pu >= 0) { mx[i][0] = *(const v4u*)(ZMXp + (row + i - 3) * 512 + col); mx[i][1] = *(const v4u*)(ZMXp + (row + i - 3) * 512 + col + 8); }
        else { mx[i][0] = (v4u){0u, 0u, 0u, 0u}; mx[i][1] = mx[i][0]; }
    }
    mv[0] = *(const v4u*)(ZMVp + row * 512 + col); mv[1] = *(const v4u*)(ZMVp + row * 512 + col + 8);
    if (tid < 64) { g_mi = bf2f(GT[((size_t)ck.row0 + tid) * 512 + 8 + mh]); g_mf = bf2f(GT[((size_t)ck.row0 + tid) * 512 + 12 + mh]); }
}
__device__ __forceinline__ void unpack16(const v4u a, const v4u b, float (&s)[16]) {
    s[0] = bflo(a.x); s[1] = bfhi(a.x); s[2] = bflo(a.y); s[3] = bfhi(a.y); s[4] = bflo(a.z); s[5] = bfhi(a.z); s[6] = bflo(a.w); s[7] = bfhi(a.w);
    s[8] = bflo(b.x); s[9] = bfhi(b.x); s[10] = bflo(b.y); s[11] = bfhi(b.y); s[12] = bflo(b.z); s[13] = bfhi(b.z); s[14] = bflo(b.w); s[15] = bfhi(b.w);
}
__device__ __forceinline__ void p2_phase(const FP& P, LAS unsigned char* lds) {
    const int tid = threadIdx.x, lane = tid & 63, wave = __builtin_amdgcn_readfirstlane(tid >> 6), fr = lane & 15, fq = lane >> 4;
    unsigned char* ws = P.ws;
    bf16_t* XC = (bf16_t*)(ws + WS_A); bf16_t* KVL = (bf16_t*)P.scr;
    float* BT = (float*)(ws + WS_MISC + MS_BT); float* IGT = (float*)(ws + WS_MISC + MS_IGT); float* CHS = (float*)(ws + WS_MISC + MS_CHS); float* NL = (float*)(ws + WS_MISC + MS_NL);
    LAS bf16_t* Xs = (LAS bf16_t*)(lds + L2_XS); LAS bf16_t* kTw = (LAS bf16_t*)(lds + L2_KT); LAS bf16_t* vT = (LAS bf16_t*)(lds + L2_VT); LAS float* wk = (LAS float*)(lds + L2_WK);
    v4u mx[4][2], mv[2]; float g_mi = 0.f, g_mf = 0.f;
    int item = blockIdx.x;
    if (item < NITEM_L) p2_load(P, item, tid, mx, mv, g_mi, g_mf);
    bf16x8 bk[4]; int mh_loaded = -1, cw_mh = -1;
    LAS float* CWs = (LAS float*)(lds + L2_CW);
    for (; item < NITEM_L; item += gridDim.x) {
        const int ci = item >> 2, mh = item & 3; const ChunkId ck = chunk_of(ci);
        const int npad = (!ck.samp && ck.c == 0) ? PADF : 0;
        __syncthreads();
        if (mh != cw_mh) {
            for (int e = tid; e < 640; e += 512) CWs[e] = e < 512 ? P.in[I_WCONV][(e >> 7) * MW + mh * MD + (e & 127)] : P.in[I_BCONV][mh * MD + e - 512];
            cw_mh = mh; __syncthreads();
        }
        if (wave == 0) {
            const size_t row = (size_t)ck.row0 + lane; const bool pad = lane < npad;
            const float lf = pad ? 0.f : logsigmoidf_(g_mf), ig = pad ? NEGBIG : g_mi;
            const float bt = wave_scan_add(lf, lane), bL = __shfl(bt, 63);
            const float g = bL - bt + ig, mloc = wave_max(g);
            wk[lane] = fexp(g - mloc);
            BT[row * MH + mh] = bt; IGT[row * MH + mh] = ig;
            if (lane == 0) { CHS[(size_t)item * 2] = bL; CHS[(size_t)item * 2 + 1] = mloc; }
        }
        {
            const int t = tid >> 3, cg = (tid & 7) * 16, col = mh * MD + cg; const size_t row = (size_t)ck.row0 + t;
            float acc[16];
            { const LAS f32x4* bcp = (const LAS f32x4*)(CWs + 512 + cg);
#pragma unroll
              for (int j = 0; j < 4; ++j) { const f32x4 bb = bcp[j]; acc[4 * j] = bb[0]; acc[4 * j + 1] = bb[1]; acc[4 * j + 2] = bb[2]; acc[4 * j + 3] = bb[3]; } }
#pragma unroll
            for (int i = 0; i < 4; ++i) {
                float s[16]; unpack16(mx[i][0], mx[i][1], s);
                if (ck.samp) { const int pu = t + i - 3; if (pu < 0) { const float* pv = P.in[I_SCV] + ((size_t)ck.b * 3 + (pu + 3)) * MW + col;
#pragma unroll
                    for (int j = 0; j < 16; ++j) s[j] = pv[j]; } }
                const LAS f32x4* wcp = (const LAS f32x4*)(CWs + i * 128 + cg);
#pragma unroll
                for (int j = 0; j < 4; ++j) { const f32x4 ww = wcp[j]; acc[4 * j] += ww[0] * s[4 * j]; acc[4 * j + 1] += ww[1] * s[4 * j + 1]; acc[4 * j + 2] += ww[2] * s[4 * j + 2]; acc[4 * j + 3] += ww[3] * s[4 * j + 3]; }
            }
            const bool padrow = t < npad;
            unsigned w[8];
#pragma unroll
            for (int j = 0; j < 8; ++j) { const float x0 = padrow ? 0.f : acc[2 * j] * fsig(acc[2 * j]), x1 = padrow ? 0.f : acc[2 * j + 1] * fsig(acc[2 * j + 1]); w[j] = pk2(x0, x1); }
            const v4u w0 = {w[0], w[1], w[2], w[3]}, w1 = {w[4], w[5], w[6], w[7]};
            *(LAS v4u*)(Xs + t * XS_P + cg) = w0; *(LAS v4u*)(Xs + t * XS_P + cg + 8) = w1;
            *(v4u*)(XC + row * 512 + col) = w0; *(v4u*)(XC + row * 512 + col + 8) = w1;
            const int tl = ck.samp ? t - (DEC_T - 3) : ((ck.c == NCH - 1) ? t - 61 : -1);
            if (tl >= 0) { float* oc = P.out + (ck.samp ? OUT_CVS : OUT_CVP) + ((size_t)ck.b * 3 + tl) * MW + col; float s[16]; unpack16(mx[3][0], mx[3][1], s);
#pragma unroll
                for (int j = 0; j < 16; ++j) oc[j] = s[j]; }
            v4u a = mv[0], bq = mv[1];
            if (padrow) { a = (v4u){0u, 0u, 0u, 0u}; bq = a; }
            const unsigned vv[8] = {a.x, a.y, a.z, a.w, bq.x, bq.y, bq.z, bq.w};
#pragma unroll
            for (int j = 0; j < 8; ++j) { vT[(cg + 2 * j) * KT_P + t] = (bf16_t)(vv[j] & 0xffffu); vT[(cg + 2 * j + 1) * KT_P + t] = (bf16_t)(vv[j] >> 16); }
        }
        if (item + (int)gridDim.x < NITEM_L) p2_load(P, item + gridDim.x, tid, mx, mv, g_mi, g_mf);
        __syncthreads();
        {
            if (mh != mh_loaded) { const bf16_t* wkk = (const bf16_t*)(ws + WS_WMK) + (size_t)mh * MD * MD + (size_t)(16 * wave + fr) * MD + 8 * fq;
#pragma unroll
                for (int ks = 0; ks < 4; ++ks) bk[ks] = *(const bf16x8*)(wkk + 32 * ks);
                mh_loaded = mh; }
            const int e = 16 * wave + fr;
#pragma unroll
            for (int m = 0; m < 4; ++m) {
                f32x4 ak = {0.f, 0.f, 0.f, 0.f};
#pragma unroll
                for (int ks = 0; ks < 4; ++ks) { const bf16x8 a = *(const LAS bf16x8*)(Xs + (16 * m + fr) * XS_P + 32 * ks + 8 * fq); ak = mfma16(a, bk[ks], ak); }
                const int t0 = 16 * m + 4 * fq; const f32x4 wv = *(const LAS f32x4*)(wk + t0);
                ak = ak * 0.08838834764831845f;
                const float k0 = bflo(pk2(ak[0], 0.f)), k1 = bflo(pk2(ak[1], 0.f)), k2 = bflo(pk2(ak[2], 0.f)), k3 = bflo(pk2(ak[3], 0.f));
                v2u kw; kw.x = pk2(k0 * wv[0], k1 * wv[1]); kw.y = pk2(k2 * wv[2], k3 * wv[3]);
                *(LAS v2u*)(kTw + e * KT_P + t0) = kw;
            }
        }
        __syncthreads();
        {
            bf16x8 a[2];
#pragma unroll
            for (int ks = 0; ks < 2; ++ks) a[ks] = *(const LAS bf16x8*)(kTw + (16 * wave + fr) * KT_P + 32 * ks + 8 * fq);
            bf16_t* kvl = KVL + (size_t)item * MD * MD;
#pragma unroll
            for (int n = 0; n < 8; ++n) {
                f32x4 acc = {0.f, 0.f, 0.f, 0.f};
#pragma unroll
                for (int ks = 0; ks < 2; ++ks) { const bf16x8 b = *(const LAS bf16x8*)(vT + (16 * n + fr) * KT_P + 32 * ks + 8 * fq); acc = mfma16(a[ks], b, acc); }
                v2u o; o.x = pk2(acc[0], acc[1]); o.y = pk2(acc[2], acc[3]);
                *(v2u*)(kvl + (size_t)(16 * n + fr) * MD + 16 * wave + 4 * fq) = o;
            }
            if (tid < MD) {
                float s = 0.f;
#pragma unroll
                for (int j = 0; j < 8; ++j) { const v4u x = *(const LAS v4u*)(kTw + tid * KT_P + 8 * j);
                    s += (bflo(x.x) + bfhi(x.x)) + (bflo(x.y) + bfhi(x.y)) + (bflo(x.z) + bfhi(x.z)) + (bflo(x.w) + bfhi(x.w)); }
                NL[(size_t)item * MD + tid] = s;
            }
        }
    }
}
}
namespace fk {
__device__ __forceinline__ void p3_scan(const FP& P) {
    unsigned char* ws = P.ws;
    bf16_t* KVL = (bf16_t*)P.scr;
    float* NL = (float*)(ws + WS_MISC + MS_NL); const float* CHS = (const float*)(ws + WS_MISC + MS_CHS);
    float* MC = (float*)(ws + WS_MISC + MS_MC);
    constexpr int EPS_ = MD * MD / 4 + MD;
    constexpr int NSEQ = (NPB + NB) * MH;
    const int gt = blockIdx.x * 512 + threadIdx.x, NT = gridDim.x * 512;
    for (int e = gt; e < NSEQ * EPS_; e += NT) {
        const int sidx = e / EPS_, w = e % EPS_;
        const bool samp = sidx >= NPB * MH; const int b = samp ? (sidx - NPB * MH) / MH : sidx / MH, h = sidx % MH;
        const int nch = samp ? 1 : NCH;
        const int item0 = samp ? ((NPB * NCH + b) * MH + h) : ((b * NCH) * MH + h);
        float m = samp ? P.in[I_SM][b * MH + h] : 0.f;
        if (w < MD * MD / 4) {
            const int dv = w >> 5, dk = (w & 31) * 4;
            float c0 = 0.f, c1 = 0.f, c2 = 0.f, c3 = 0.f;
            if (samp) { const float* C0 = P.in[I_SC] + ((size_t)b * MH + h) * MD * MD; c0 = C0[(size_t)dk * MD + dv]; c1 = C0[(size_t)(dk + 1) * MD + dv]; c2 = C0[(size_t)(dk + 2) * MD + dv]; c3 = C0[(size_t)(dk + 3) * MD + dv]; }
            for (int cb = 0; cb < nch; cb += 13) {
                v2u kv[13]; float blv[13], mlv[13];
#pragma unroll
                for (int j = 0; j < 13; ++j) if (cb + j < nch) { const int it = item0 + 4 * (cb + j); kv[j] = *(const v2u*)(KVL + (size_t)it * MD * MD + (size_t)dv * MD + dk); blv[j] = CHS[(size_t)it * 2]; mlv[j] = CHS[(size_t)it * 2 + 1]; }
#pragma unroll
                for (int j = 0; j < 13; ++j) if (cb + j < nch) {
                    const int it = item0 + 4 * (cb + j);
                    const float bL = blv[j], ml = mlv[j];
                    const float mn = fmaxf(bL + m, ml), a = fexp(bL + m - mn), s = fexp(ml - mn);
                    v2u o; o.x = pk2(c0, c1); o.y = pk2(c2, c3);
                    *(v2u*)(KVL + (size_t)it * MD * MD + (size_t)dv * MD + dk) = o;
                    if (w == 0) MC[it] = m;
                    c0 = a * c0 + s * bflo(kv[j].x); c1 = a * c1 + s * bfhi(kv[j].x); c2 = a * c2 + s * bflo(kv[j].y); c3 = a * c3 + s * bfhi(kv[j].y);
                    m = mn;
                }
            }
            float* oC = P.out + (samp ? OUT_CS : OUT_CP) + ((size_t)b * MH + h) * MD * MD;
            oC[(size_t)dk * MD + dv] = c0; oC[(size_t)(dk + 1) * MD + dv] = c1; oC[(size_t)(dk + 2) * MD + dv] = c2; oC[(size_t)(dk + 3) * MD + dv] = c3;
            if (w == 0) P.out[(samp ? OUT_MS : OUT_MP) + (size_t)b * MH + h] = m;
        } else {
            const int dk = w - MD * MD / 4;
            float n = samp ? P.in[I_SN][((size_t)b * MH + h) * MD + dk] : 0.f;
            for (int cb = 0; cb < nch; cb += 13) {
                float nlv[13], blv[13], mlv[13];
#pragma unroll
                for (int j = 0; j < 13; ++j) if (cb + j < nch) { const int it = item0 + 4 * (cb + j); nlv[j] = NL[(size_t)it * MD + dk]; blv[j] = CHS[(size_t)it * 2]; mlv[j] = CHS[(size_t)it * 2 + 1]; }
#pragma unroll
                for (int j = 0; j < 13; ++j) if (cb + j < nch) {
                    const int it = item0 + 4 * (cb + j);
                    const float mn = fmaxf(blv[j] + m, mlv[j]), a = fexp(blv[j] + m - mn), s = fexp(mlv[j] - mn);
                    NL[(size_t)it * MD + dk] = n;
                    n = a * n + s * nlv[j]; m = mn;
                }
            }
            P.out[(samp ? OUT_NS : OUT_NP) + ((size_t)b * MH + h) * MD + dk] = n;
        }
    }
}

constexpr int L3_K = 0, L3_V = 16384, L3_WS = 32768, L3_OFF = L3_WS + 8 * 64 * 4, L3_END = L3_OFF + 128 * 4;
__device__ __forceinline__ int crow(int r, int hi) { return (r & 3) + 8 * (r >> 2) + 4 * hi; }
typedef short v4i16_t __attribute__((ext_vector_type(4)));
__device__ __forceinline__ s16x4 vtr(const LAS unsigned char* p) { return __builtin_bit_cast(s16x4, __builtin_amdgcn_ds_read_tr16_b64_v4i16((LAS v4i16_t*)p)); }
__device__ __forceinline__ unsigned cvtpk(float lo, float hi) { typedef float f2 __attribute__((ext_vector_type(2))); typedef __bf16 b2 __attribute__((ext_vector_type(2))); f2 v = {lo, hi}; b2 b = __builtin_convertvector(v, b2); return __builtin_bit_cast(unsigned, b); }

__device__ __forceinline__ void attn_unit(const FP& P, int unit, LAS unsigned char* lds) {
    const int tid = threadIdx.x, lane = tid & 63, r32 = lane & 31, hi = lane >> 5, wave = __builtin_amdgcn_readfirstlane(tid >> 6);
    unsigned char* ws = P.ws;
    bf16_t* Z = (bf16_t*)(ws + WS_Z);
    const bf16_t *Kb, *Vb; const float* nb; const float* tot; bf16_t* Qb; int J0, J1, jdiag, nvalid, qpos0, ntot, t0;
    if (unit < NPB * FH * 17) {
        const int sq = unit / 17, j = unit % 17, b = sq / FH, fh = sq % FH;
        Kb = Z + (size_t)ZK * SE + (size_t)b * RP * 512 + fh * FD; Vb = Z + (size_t)ZV * SE + (size_t)b * RP * 512 + fh * FD;
        Qb = Z + (size_t)ZQ * SE + ((size_t)b * RP + 256 * j) * 512 + fh * FD;
        nb = (const float*)(ws + WS_MISC + MS_NBP) + (size_t)sq * NBPL;
        tot = (const float*)(ws + WS_MISC + MS_JST) + sq * TOTP_L; ntot = NCH; t0 = j == 0 ? PADF : 256 * j;
        jdiag = 4 * j; J1 = (j == 16) ? 65 : 4 * j + 4; nvalid = (j == 16) ? 64 : 256; qpos0 = 256 * j;
    } else {
        const int s2 = unit - NPB * FH * 17, b = s2 / FH, fh = s2 % FH;
        Kb = (const bf16_t*)(ws + WS_KS) + (size_t)b * NBSL * 512 + fh * FD; Vb = (const bf16_t*)(ws + WS_VS) + (size_t)b * NBSL * 512 + fh * FD;
        Qb = Z + (size_t)ZQ * SE + ((size_t)SROW0 + b * DEC_T) * 512 + fh * FD;
        nb = (const float*)(ws + WS_MISC + MS_NBS) + (size_t)s2 * NBSL;
        tot = (const float*)(ws + WS_MISC + MS_TOTS) + s2 * TOTS_L; ntot = 17; t0 = PAST;
        jdiag = 16; J1 = 17; nvalid = 64; qpos0 = PAST;
    }
    const bool active = wave * 32 < nvalid;
    LAS float* wsf = (LAS float*)(lds + L3_WS) + wave * 64;
    const int skey = tid >> 3, sch = tid & 7;
    const unsigned kdst = L3_K + sch * 1024 + skey * 16, vdst = L3_V + (sch >> 2) * 4096 + skey * 64 + (sch & 3) * 16;
    const bf16_t* ksrc = Kb + (size_t)skey * 512 + sch * 8; const bf16_t* vsrc = Vb + (size_t)skey * 512 + sch * 8;
    bf16x8 qr[4];
#pragma unroll
    for (int d0 = 0; d0 < 4; ++d0) qr[d0] = *(const bf16x8*)(Qb + (size_t)(wave * 32 + r32) * 512 + d0 * 16 + hi * 8);
    float m = -INFINITY, l = 0.f; f32x16 o[2]; o[0] = f32x16{}; o[1] = f32x16{};
    const int qpos = qpos0 + wave * 32 + r32;
    LAS float* OFF = (LAS float*)(lds + L3_OFF);
    __syncthreads();
    if (wave == 0) {
        const float v0 = lane < ntot ? tot[lane] : 0.f, v1 = (64 + lane) < ntot ? tot[64 + lane] : 0.f;
        const int twl = (lane < 8 && t0 <= qpos0 + 32 * lane) ? qpos0 + 32 * lane : t0;
        const float nbl = nb[twl];
        const float th2 = *(const float*)(ws + WS_MISC + MS_TH2);
        const float s0 = wave_scan_add(v0, lane);
        const float s1 = __shfl(s0, 63) + wave_scan_add(v1, lane);
        OFF[lane + 1] = s0; if (lane == 0) { OFF[0] = 0.f; OFF[65] = s1; }
#pragma unroll
        for (int w = 0; w < 8; ++w) {
            const int tw = __shfl(twl, w), cw = tw >> 6, jd = w == 0 ? jdiag : cw;
            const float offw = cw == 0 ? 0.f : __shfl(s0, cw - 1 < 63 ? cw - 1 : 63);
            const float nbw = __shfl(nbl, w) + (cw <= 64 ? offw : 0.f);
            unsigned long long mw = __ballot(s0 - nbw >= -th2);
            if (jd < 64) mw &= (1ull << jd) - 1ull;
            const int jw = mw ? __builtin_ctzll(mw) : jd;
            if (lane == 0) ((LAS int*)OFF)[80 + w] = jw;
        }
    }
    __syncthreads();
    J0 = ((LAS int*)OFF)[80];
    const int Jw = wave == 0 ? J0 : ((LAS int*)OFF)[80 + wave];
    v4u kreg = *(const v4u*)(ksrc + (size_t)J0 * 64 * 512), vreg = *(const v4u*)(vsrc + (size_t)J0 * 64 * 512);
    *(LAS v4u*)(lds + kdst) = kreg; *(LAS v4u*)(lds + vdst) = vreg;
    __syncthreads();
    for (int J = J0; J < J1; ++J) {
        const int slot = (J - J0) & 1;
        if (J + 1 < J1) { kreg = *(const v4u*)(ksrc + (size_t)(J + 1) * 64 * 512); vreg = *(const v4u*)(vsrc + (size_t)(J + 1) * 64 * 512); }
        if (active && J >= Jw && 64 * J <= qpos0 + wave * 32 + 31) {
            const LAS unsigned char* Ks = lds + L3_K + slot * 8192; const LAS unsigned char* Vs = lds + L3_V + slot * 8192;
            const float* nbt = nb + 64 * J + 4 * hi; const float offJ = OFF[J];
            f32x4 nx0[4], nx1[4];
#pragma unroll
            for (int g = 0; g < 4; ++g) { nx0[g] = *(const f32x4*)(nbt + 8 * g); nx1[g] = *(const f32x4*)(nbt + 32 + 8 * g); }
            f32x16 p0 = f32x16{}, p1 = f32x16{};
#pragma unroll
            for (int d0 = 0; d0 < 4; ++d0) {
                const bf16x8 b0 = *(const LAS bf16x8*)(Ks + (2 * d0 + hi) * 1024 + r32 * 16);
                const bf16x8 b1 = *(const LAS bf16x8*)(Ks + (2 * d0 + hi) * 1024 + (32 + r32) * 16);
                p0 = __builtin_amdgcn_mfma_f32_32x32x16_bf16(b0, qr[d0], p0, 0, 0, 0);
                p1 = __builtin_amdgcn_mfma_f32_32x32x16_bf16(b1, qr[d0], p1, 0, 0, 0);
            }
#pragma unroll
            for (int g = 0; g < 4; ++g) {
#pragma unroll
                for (int i = 0; i < 4; ++i) { p0[4 * g + i] += nx0[g][i] + offJ; p1[4 * g + i] += nx1[g][i] + offJ; }
            }
            if (J >= jdiag) {
#pragma unroll
                for (int r = 0; r < 16; ++r) { const int kv = 64 * J + crow(r, hi); if (kv > qpos) p0[r] = -INFINITY; if (kv + 32 > qpos) p1[r] = -INFINITY; }
            }
            float mt = p0[0];
#pragma unroll
            for (int r = 1; r < 16; ++r) mt = fmaxf(mt, p0[r]);
#pragma unroll
            for (int r = 0; r < 16; ++r) mt = fmaxf(mt, p1[r]);
            mt = fmaxf(mt, __shfl_xor(mt, 32));
            const float mn = fmaxf(m, mt);
            const float alpha = __builtin_amdgcn_exp2f(m - mn);
            float ps = 0.f;
#pragma unroll
            for (int r = 0; r < 16; ++r) { p0[r] = __builtin_amdgcn_exp2f(p0[r] - mn); p1[r] = __builtin_amdgcn_exp2f(p1[r] - mn); ps += p0[r] + p1[r]; }
            l = l * alpha + ps; m = mn;
            if (hi == 0) wsf[r32] = alpha;
            LDS_WAIT(); asm volatile("" ::: "memory");
#pragma unroll
            for (int g = 0; g < 4; ++g) { const f32x4 al = *(const LAS f32x4*)(wsf + 8 * g + 4 * hi);
#pragma unroll
                for (int i = 0; i < 4; ++i) { o[0][4 * g + i] *= al[i]; o[1][4 * g + i] *= al[i]; } }
            v4u pw[4];
#pragma unroll
            for (int i = 0; i < 4; ++i) { pw[0][i] = cvtpk(p0[2 * i], p0[2 * i + 1]); pw[1][i] = cvtpk(p0[8 + 2 * i], p0[8 + 2 * i + 1]); pw[2][i] = cvtpk(p1[2 * i], p1[2 * i + 1]); pw[3][i] = cvtpk(p1[8 + 2 * i], p1[8 + 2 * i + 1]); }
            const LAS unsigned char* vb = Vs + ((lane >> 4) & 1) * 32 + (lane & 3) * 8 + (4 * hi + ((lane & 15) >> 2)) * 64;
#pragma unroll
            for (int db = 0; db < 2; ++db)
#pragma unroll
                for (int ks = 0; ks < 4; ++ks) {
                    const s16x4 lo = vtr(vb + db * 4096 + ks * 1024), hh = vtr(vb + db * 4096 + ks * 1024 + 512);
                    const bf16x8 vf = {lo[0], lo[1], lo[2], lo[3], hh[0], hh[1], hh[2], hh[3]};
                    o[db] = __builtin_amdgcn_mfma_f32_32x32x16_bf16(__builtin_bit_cast(bf16x8, pw[ks]), vf, o[db], 0, 0, 0);
                }
        }
        if (J + 1 < J1) { *(LAS v4u*)(lds + kdst + (slot ^ 1) * 8192) = kreg; *(LAS v4u*)(lds + vdst + (slot ^ 1) * 8192) = vreg; }
        __syncthreads();
    }
    if (active) {
        l += __shfl_xor(l, 32);
        if (hi == 0) wsf[r32] = 1.f / l;
        LDS_WAIT(); asm volatile("" ::: "memory");
#pragma unroll
        for (int g = 0; g < 4; ++g) { const f32x4 il = *(const LAS f32x4*)(wsf + 8 * g + 4 * hi);
#pragma unroll
            for (int i = 0; i < 4; ++i) {
                const int r = 4 * g + i; bf16_t* orow = Qb + (size_t)(wave * 32 + crow(r, hi)) * 512;
                orow[r32] = (bf16_t)f2bf(o[0][r] * il[i]); orow[32 + r32] = (bf16_t)f2bf(o[1][r] * il[i]);
            } }
    }
}
}
namespace fk {
constexpr int L4_QS = 0, L4_KS = L4_QS + 64 * XS_P * 2, L4_XS = L4_KS + 64 * XS_P * 2, L4_VT = L4_XS + 64 * XS_P * 2, L4_CT = L4_VT + 128 * KT_P * 2, L4_AS = L4_CT + 128 * XS_P * 2, L4_F = L4_AS + 64 * KT_P * 2, L4_GS = L4_F + 10 * 64 * 4, L4_END = L4_GS + 256 * 4;
static_assert(L4_END <= 131072, "P4 LDS");
struct P4Pre { v4u xc[2], mv[2], mo, ct[4]; float nc, bt, ig, mc; };
__device__ __forceinline__ void p4_load(const FP& P, int item, int tid, P4Pre& R) {
    const bf16_t* Z = (const bf16_t*)(P.ws + WS_Z);
    const bf16_t* ZMVp = Z + (size_t)ZMV * SE; const bf16_t* ZMOp = Z + (size_t)ZMO * SE; const bf16_t* XC = (const bf16_t*)(P.ws + WS_A); const bf16_t* KVL = (const bf16_t*)P.scr;
    const float* BT = (const float*)(P.ws + WS_MISC + MS_BT); const float* IGT = (const float*)(P.ws + WS_MISC + MS_IGT); const float* NL = (const float*)(P.ws + WS_MISC + MS_NL); const float* MC = (const float*)(P.ws + WS_MISC + MS_MC);
    const int ci = item >> 2, mh = item & 3; const ChunkId ck = chunk_of(ci);
    const int t = tid >> 3, col = mh * MD + (tid & 7) * 16; const size_t row = (size_t)ck.row0 + t;
    R.xc[0] = *(const v4u*)(XC + row * 512 + col); R.xc[1] = *(const v4u*)(XC + row * 512 + col + 8);
    R.mv[0] = *(const v4u*)(ZMVp + row * 512 + col); R.mv[1] = *(const v4u*)(ZMVp + row * 512 + col + 8);
    R.mo = *(const v4u*)((const unsigned char*)ZMOp + row * 512 + col);
    const bf16_t* src = KVL + (size_t)item * MD * MD + (size_t)(tid >> 2) * MD + (tid & 3) * 32;
#pragma unroll
    for (int j = 0; j < 4; ++j) R.ct[j] = *(const v4u*)(src + 8 * j);
    R.nc = tid < MD ? NL[(size_t)item * MD + tid] : 0.f;
    if (tid < 64) { R.bt = BT[((size_t)ck.row0 + tid) * MH + mh]; R.ig = IGT[((size_t)ck.row0 + tid) * MH + mh]; R.mc = MC[item]; }
}
__device__ __forceinline__ void p4_phase(const FP& P, LAS unsigned char* lds) {
    const int tid = threadIdx.x, lane = tid & 63, wave = __builtin_amdgcn_readfirstlane(tid >> 6), fr = lane & 15, fq = lane >> 4;
    unsigned char* ws = P.ws;
    bf16_t* HM = (bf16_t*)(ws + WS_Z) + (size_t)ZMX * SE;
    LAS bf16_t* Qs = (LAS bf16_t*)(lds + L4_QS); LAS bf16_t* Ks = (LAS bf16_t*)(lds + L4_KS); LAS bf16_t* Xs = (LAS bf16_t*)(lds + L4_XS); LAS bf16_t* vT = (LAS bf16_t*)(lds + L4_VT);
    LAS bf16_t* CT = (LAS bf16_t*)(lds + L4_CT); LAS bf16_t* As = (LAS bf16_t*)(lds + L4_AS); LAS bf16_t* MOs = Ks;
    LAS float* U = (LAS float*)(lds + L4_F); LAS float* Vv = U + 64; LAS float* WI = U + 128; LAS float* EM = U + 192; LAS float* DD = U + 256; LAS float* NC = U + 320;   LAS float* SS = U + 448;
    P4Pre R;
    int item = blockIdx.x;
    if (item < NITEM_L) p4_load(P, item, tid, R);
    bf16x8 aq[4], ak[4]; int mh_loaded = -1, gs_mh = -1;
    LAS float* GS = (LAS float*)(lds + L4_GS);
    for (; item < NITEM_L; item += gridDim.x) {
        const int ci = item >> 2, mh = item & 3; const ChunkId ck = chunk_of(ci);
        const int npad = (!ck.samp && ck.c == 0) ? PADF : 0;
        if (mh != mh_loaded) { const bf16_t* wq = (const bf16_t*)(ws + WS_WMQ) + (size_t)mh * MD * MD + (size_t)(16 * wave + fr) * MD + 8 * fq; const bf16_t* wkk = (const bf16_t*)(ws + WS_WMK) + (size_t)mh * MD * MD + (size_t)(16 * wave + fr) * MD + 8 * fq;
#pragma unroll
          for (int ks = 0; ks < 4; ++ks) { aq[ks] = *(const bf16x8*)(wq + 32 * ks); ak[ks] = *(const bf16x8*)(wkk + 32 * ks); }
          mh_loaded = mh; }
        __syncthreads();
        if (mh != gs_mh) { if (tid < 256) GS[tid] = tid < 128 ? P.in[I_GMN][mh * MD + tid] : P.in[I_SKIP][mh * MD + tid - 128]; gs_mh = mh; }
        const v4u mo0 = R.mo;
        {
            const int t = tid >> 3, cg = (tid & 7) * 16;
            *(LAS v4u*)(Xs + t * XS_P + cg) = R.xc[0]; *(LAS v4u*)(Xs + t * XS_P + cg + 8) = R.xc[1];
            v4u a = R.mv[0], bq = R.mv[1];
            if (t < npad) { a = (v4u){0u, 0u, 0u, 0u}; bq = a; }
            const unsigned vv[8] = {a.x, a.y, a.z, a.w, bq.x, bq.y, bq.z, bq.w};
#pragma unroll
            for (int j = 0; j < 8; ++j) { vT[(cg + 2 * j) * KT_P + t] = (bf16_t)(vv[j] & 0xffffu); vT[(cg + 2 * j + 1) * KT_P + t] = (bf16_t)(vv[j] >> 16); }
            const int dv = tid >> 2, qq = (tid & 3) * 32;
#pragma unroll
            for (int j = 0; j < 4; ++j) *(LAS v4u*)(CT + dv * XS_P + qq + 8 * j) = R.ct[j];
            if (tid < MD) NC[tid] = R.nc;
        }
        if (wave == 0) {
            const float bt = R.bt, ig = R.ig, mc = R.mc;
            const float vs = ig - bt, cm = wave_scan_max(vs, lane), mt = bt + fmaxf(mc, cm);
            U[lane] = bt - mt; Vv[lane] = vs; WI[lane] = fexp(bt + mc - mt); EM[lane] = fexp(-mt);
        }
        if (item + (int)gridDim.x < NITEM_L) p4_load(P, item + gridDim.x, tid, R);
        __syncthreads();
        {
#pragma unroll
            for (int n = 0; n < 4; ++n) {
                f32x4 cq = {0.f, 0.f, 0.f, 0.f}, ckk = {0.f, 0.f, 0.f, 0.f};
#pragma unroll
                for (int ks = 0; ks < 4; ++ks) { const bf16x8 b = *(const LAS bf16x8*)(Xs + (16 * n + fr) * XS_P + 32 * ks + 8 * fq); cq = mfma16(aq[ks], b, cq); ckk = mfma16(ak[ks], b, ckk); }
                ckk = ckk * 0.08838834764831845f;
                v2u oq, ok; oq.x = pk2(cq[0], cq[1]); oq.y = pk2(cq[2], cq[3]); ok.x = pk2(ckk[0], ckk[1]); ok.y = pk2(ckk[2], ckk[3]);
                *(LAS v2u*)(Qs + (16 * n + fr) * XS_P + 16 * wave + 4 * fq) = oq; *(LAS v2u*)(Ks + (16 * n + fr) * XS_P + 16 * wave + 4 * fq) = ok;
            }
        }
        __syncthreads();
        {
            const int s0 = 16 * (wave & 3), tb = 32 * (wave >> 2);
            f32x4 acc[2] = {{0.f, 0.f, 0.f, 0.f}, {0.f, 0.f, 0.f, 0.f}};
#pragma unroll
            for (int ks = 0; ks < 4; ++ks) {
                const bf16x8 a = *(const LAS bf16x8*)(Ks + (s0 + fr) * XS_P + 32 * ks + 8 * fq);
#pragma unroll
                for (int n = 0; n < 2; ++n) { const bf16x8 b = *(const LAS bf16x8*)(Qs + (tb + 16 * n + fr) * XS_P + 32 * ks + 8 * fq); acc[n] = mfma16(a, b, acc[n]); }
            }
            const int sb = s0 + 4 * fq; const f32x4 vsv = *(const LAS f32x4*)(Vv + sb);
#pragma unroll
            for (int n = 0; n < 2; ++n) {
                const int t = tb + 16 * n + fr; const float ut = U[t];
                float w[4];
#pragma unroll
                for (int r = 0; r < 4; ++r) w[r] = (sb + r <= t) ? fexp(ut + vsv[r]) * acc[n][r] : 0.f;
                v2u o; o.x = pk2(w[0], w[1]); o.y = pk2(w[2], w[3]);
                *(LAS v2u*)(As + t * KT_P + sb) = o;
            }
        }
        __syncthreads();
        {
            const int t = tid >> 3, cg = (tid & 7) * 16;
            *(LAS v4u*)((LAS unsigned char*)MOs + t * 144 + cg) = mo0;
        }
        {
            const int t = tid >> 3, pp = tid & 7;
            const v4u x = *(const LAS v4u*)(As + t * KT_P + 8 * pp);
            float d = (bflo(x.x) + bfhi(x.x)) + (bflo(x.y) + bfhi(x.y)) + (bflo(x.z) + bfhi(x.z)) + (bflo(x.w) + bfhi(x.w)), dq = 0.f;
#pragma unroll
            for (int j = 0; j < 2; ++j) { const v4u q = *(const LAS v4u*)(Qs + t * XS_P + 16 * pp + 8 * j); const f32x4 n0 = *(const LAS f32x4*)(NC + 16 * pp + 8 * j), n1 = *(const LAS f32x4*)(NC + 16 * pp + 8 * j + 4);
                dq += bflo(q.x) * n0[0] + bfhi(q.x) * n0[1] + bflo(q.y) * n0[2] + bfhi(q.y) * n0[3] + bflo(q.z) * n1[0] + bfhi(q.z) * n1[1] + bflo(q.w) * n1[2] + bfhi(q.w) * n1[3]; }
            d += WI[t] * dq;
            d += __shfl_xor(d, 1); d += __shfl_xor(d, 2); d += __shfl_xor(d, 4);
            if (pp == 0) DD[t] = 1.f / fmaxf(fabsf(d), EM[t]);
        }
        const int t0 = 16 * (wave & 3), dvb = 64 * (wave >> 2);
        f32x4 acc[4] = {{0.f, 0.f, 0.f, 0.f}, {0.f, 0.f, 0.f, 0.f}, {0.f, 0.f, 0.f, 0.f}, {0.f, 0.f, 0.f, 0.f}};
#pragma unroll
        for (int ks = 0; ks < 2; ++ks) {
            const bf16x8 a = *(const LAS bf16x8*)(As + (t0 + fr) * KT_P + 32 * ks + 8 * fq);
#pragma unroll
            for (int n = 0; n < 4; ++n) { const bf16x8 b = *(const LAS bf16x8*)(vT + (dvb + 16 * n + fr) * KT_P + 32 * ks + 8 * fq); acc[n] = mfma16(a, b, acc[n]); }
        }
        f32x4 acci[4] = {{0.f, 0.f, 0.f, 0.f}, {0.f, 0.f, 0.f, 0.f}, {0.f, 0.f, 0.f, 0.f}, {0.f, 0.f, 0.f, 0.f}};
#pragma unroll
        for (int ks = 0; ks < 4; ++ks) {
            const bf16x8 a = *(const LAS bf16x8*)(Qs + (t0 + fr) * XS_P + 32 * ks + 8 * fq);
#pragma unroll
            for (int n = 0; n < 4; ++n) { const bf16x8 b = *(const LAS bf16x8*)(CT + (dvb + 16 * n + fr) * XS_P + 32 * ks + 8 * fq); acci[n] = mfma16(a, b, acci[n]); }
        }
        { const f32x4 wiv = *(const LAS f32x4*)(WI + t0 + 4 * fq);
#pragma unroll
          for (int n = 0; n < 4; ++n) acc[n] = acc[n] + acci[n] * wiv; }
        __syncthreads();
        float hv[4][4]; float ssq[4] = {0.f, 0.f, 0.f, 0.f};
        const f32x4 ddv = *(const LAS f32x4*)(DD + t0 + 4 * fq);
#pragma unroll
        for (int n = 0; n < 4; ++n)
#pragma unroll
            for (int r = 0; r < 4; ++r) {
                const float og = (float)((LAS unsigned char*)MOs)[(t0 + 4 * fq + r) * 144 + dvb + 16 * n + fr] * (1.f / 255.f);
                hv[n][r] = og * acc[n][r] * ddv[r]; ssq[r] += hv[n][r] * hv[n][r];
            }
#pragma unroll
        for (int r = 0; r < 4; ++r) { float s = ssq[r]; s += __shfl_xor(s, 1); s += __shfl_xor(s, 2); s += __shfl_xor(s, 4); s += __shfl_xor(s, 8); ssq[r] = s; }
        if (fr == 0) {
#pragma unroll
            for (int r = 0; r < 4; ++r) SS[(wave >> 2) * 64 + t0 + 4 * fq + r] = ssq[r];
        }
        __syncthreads();
#pragma unroll
        for (int r = 0; r < 4; ++r) {
            const int t = t0 + 4 * fq + r; const float rn = rsqrtf((SS[t] + SS[64 + t]) * (1.f / MD) + EPS);
            const size_t row = (size_t)ck.row0 + t;
#pragma unroll
            for (int n = 0; n < 4; ++n) { const int cl = dvb + 16 * n + fr, col = mh * MD + cl;
                const float v = hv[n][r] * rn * GS[cl] + GS[128 + cl] * bf2f(Xs[t * XS_P + cl]);
                HM[row * 512 + col] = (bf16_t)f2bf(v); }
        }
    }
    __syncthreads();
}
}
namespace pg8 {
__device__ __forceinline__ float fsigmoid(float x) { return __builtin_amdgcn_rcpf(1.f + __builtin_amdgcn_exp2f(-1.4426950408889634f * x)); }
__device__ __forceinline__ float bflo_(unsigned w) { return __builtin_bit_cast(float, w << 16); }
__device__ __forceinline__ float bfhi_(unsigned w) { return __builtin_bit_cast(float, w & 0xffff0000u); }
template <int MODE> struct EpiGate {
    static constexpr bool PERM = true, AFTER_DRAIN = false, HAS_MID = (MODE == 2);
    bf16_t* MG; const unsigned char* G; const unsigned char* G2;
    __device__ __forceinline__ void mid(f32x4 (&acc)[2][2][4][2], const Unit& u, int wr, int wc, int fr, int fq) const {
        const int row0 = u.rb + wr * 64 + fr, c = u.pn * BM + wc * 32 + 8 * fq;
        size_t off = (size_t)row0 * 1024 + c;
#pragma unroll
        for (int ai = 0; ai < 2; ++ai)
#pragma unroll
            for (int m = 0; m < 4; ++m) {
#pragma unroll
                for (int bj = 0; bj < 2; ++bj) {
                    typedef unsigned u32x2 __attribute__((ext_vector_type(2)));
                    const u32x2 ga = *(const u32x2*)(G2 + off + bj * HALF), gb = *(const u32x2*)(G + off + bj * HALF);
#pragma unroll
                    for (int q = 0; q < 8; ++q) { const float fa = (float)((ga[q >> 2] >> (8 * (q & 3))) & 255u), fb = (float)((gb[q >> 2] >> (8 * (q & 3))) & 255u);
                        acc[ai][bj][m][q >> 2][q & 3] *= fa * __builtin_amdgcn_rcpf(fb); } }
                off += (m == 3 ? (size_t)(HALF - 48) * 1024 : (size_t)16 * 1024);
                asm volatile("" : "+v"(off) :: "memory");
            }
    }
    __device__ __forceinline__ void operator()(const f32x4 (&acc)[2][2][4][2], const Unit& u, int wr, int wc, int fr, int fq) const {
        const int row0 = u.rb + wr * 64 + fr, col0 = u.pn * BM + wc * 32 + 8 * fq;
#pragma unroll
        for (int ai = 0; ai < 2; ++ai)
#pragma unroll
            for (int m = 0; m < 4; ++m) { const size_t row = (size_t)(row0 + ai * HALF + m * 16);
#pragma unroll
                for (int bj = 0; bj < 2; ++bj) { const int c = col0 + bj * HALF;
                    typedef unsigned u32x2 __attribute__((ext_vector_type(2)));
                    const u32x2 g = *(const u32x2*)(G + row * 1024 + c);
                    f32x4 v0 = acc[ai][bj][m][0], v1 = acc[ai][bj][m][1];
#pragma unroll
                    for (int i = 0; i < 4; ++i) { v0[i] *= (float)((g.x >> (8 * i)) & 255u) * (1.f / 255.f); v1[i] *= (float)((g.y >> (8 * i)) & 255u) * (1.f / 255.f); }
                    u32x4 w; w.x = cvt_pk_bf16(v0[0], v0[1]); w.y = cvt_pk_bf16(v0[2], v0[3]); w.z = cvt_pk_bf16(v1[0], v1[1]); w.w = cvt_pk_bf16(v1[2], v1[3]);
                    *(u32x4*)(MG + row * 1024 + c) = w; } }
    }
};
struct EpiSwiGLU {
    static constexpr bool PERM = true, AFTER_DRAIN = false, HAS_MID = false;
    bf16_t* ACT; int ldc;
    __device__ __forceinline__ void operator()(const f32x4 (&acc)[2][2][4][2], const Unit& u, int wr, int wc, int fr, int fq) const {
        const int row0 = u.rb + wr * 64 + fr, col0 = u.pn * HALF + wc * 32 + 8 * fq;
#pragma unroll
        for (int ai = 0; ai < 2; ++ai)
#pragma unroll
            for (int m = 0; m < 4; ++m) { const size_t row = (size_t)(row0 + ai * HALF + m * 16);
                f32x4 v[2];
#pragma unroll
                for (int n = 0; n < 2; ++n) { const f32x4 g = acc[ai][0][m][n], uu = acc[ai][1][m][n];
#pragma unroll
                    for (int i = 0; i < 4; ++i) v[n][i] = g[i] * fsigmoid(g[i]) * uu[i]; }
                u32x4 w; w.x = cvt_pk_bf16(v[0][0], v[0][1]); w.y = cvt_pk_bf16(v[0][2], v[0][3]); w.z = cvt_pk_bf16(v[1][0], v[1][1]); w.w = cvt_pk_bf16(v[1][2], v[1][3]);
                *(u32x4*)(ACT + row * ldc + col0) = w; }
    }
};
}

namespace fk {
#define XB_TMO      128
#define XB_XCNT(j)  (256  + 64 * (j))
#define XB_XSUB(j)  (1280 + 64 * (j))
#define XB_XGEN(j)  (2304 + 64 * (j))
#define XB_TOP      3328
#define XB_TOPGEN   3392
#define XCD_BAR_WORDS 3456
#define XB_SPIN_CAP (1u << 18)

__device__ __forceinline__ unsigned xb_ld(unsigned* p)              { return __hip_atomic_load(p, __ATOMIC_RELAXED, __HIP_MEMORY_SCOPE_AGENT); }
__device__ __forceinline__ unsigned xb_add(unsigned* p, unsigned v) { return __hip_atomic_fetch_add(p, v, __ATOMIC_RELAXED, __HIP_MEMORY_SCOPE_AGENT); }
__device__ __forceinline__ unsigned xb_xcc_id() { return (unsigned)__builtin_amdgcn_s_getreg((3 << 11) | 20) & 0xFu; }
#define XB_SPIN(cond, bar) do { unsigned _sp = 0; while (cond) { __builtin_amdgcn_s_sleep(1); \
    if ((++_sp & 255u) == 0u) { if (xb_ld(&(bar)[XB_TMO])) break; if (_sp > XB_SPIN_CAP) { atomicAdd(&(bar)[XB_TMO], 1u); break; } } } } while (0)

struct XcdBarrier {
    unsigned* bar; unsigned x;
    volatile LAS unsigned* st;
};

__device__ __forceinline__ XcdBarrier xcd_barrier_post(unsigned* bar, volatile LAS unsigned* st) {
    XcdBarrier b; b.bar = bar; b.x = xb_xcc_id(); b.st = st;
    if (threadIdx.x == 0) (void)xb_add(&bar[XB_XCNT(b.x)], 1u);
    return b;
}
__device__ __forceinline__ void xcd_barrier_complete(unsigned* bar, unsigned x, unsigned& nloc, unsigned& nx) {
    const unsigned G = gridDim.x * gridDim.y * gridDim.z;
    unsigned sum, cnt, mine, sp = 0u;
    for (;;) {
        sum = 0u; cnt = 0u; mine = 0u;
#pragma unroll
        for (unsigned j = 0; j < 16; ++j) { const unsigned c = xb_ld(&bar[XB_XCNT(j)]); sum += c; cnt += (c > 0u) ? 1u : 0u; mine = (j == x) ? c : mine; }
        if (sum == G) break;
        __builtin_amdgcn_s_sleep(1);
        if ((++sp & 255u) == 0u) { if (xb_ld(&bar[XB_TMO])) break; if (sp > XB_SPIN_CAP) { atomicAdd(&bar[XB_TMO], 1u); break; } }
    }
    nloc = mine > 0u ? mine : 1u; nx = cnt > 0u ? cnt : 1u;
}

__device__ __forceinline__ void xcd_barrier(const XcdBarrier& b) {
    asm volatile("s_waitcnt vmcnt(0)" ::: "memory");
    __syncthreads();
    if (threadIdx.x == 0) {
        unsigned* bar = b.bar;
        __builtin_amdgcn_s_waitcnt(0);
        unsigned nloc = b.st[0], nx = b.st[1];
        if (nloc == 0u) { xcd_barrier_complete(bar, b.x, nloc, nx); b.st[0] = nloc; b.st[1] = nx; }
        const unsigned old = xb_add(&bar[XB_XSUB(b.x)], 1u);
        const unsigned gen = old / nloc;
        if (old + 1u == (gen + 1u) * nloc) {
            __builtin_amdgcn_fence(__ATOMIC_RELEASE, "agent");
            asm volatile("s_waitcnt vmcnt(0)" ::: "memory");
            const unsigned og = xb_add(&bar[XB_TOP], 1u);
            const unsigned tg = og / nx;
            if (og + 1u == (tg + 1u) * nx) xb_add(&bar[XB_TOPGEN], 1u);
            else XB_SPIN(xb_ld(&bar[XB_TOPGEN]) == tg, bar);
            __builtin_amdgcn_fence(__ATOMIC_ACQUIRE, "agent");
            xb_add(&bar[XB_XGEN(b.x)], 1u);
            asm volatile("s_waitcnt vmcnt(0)" ::: "memory");
        } else {
            XB_SPIN(xb_ld(&bar[XB_XGEN(b.x)]) == gen, bar);
            __builtin_amdgcn_fence(__ATOMIC_ACQUIRE, "agent");
            asm volatile("s_waitcnt vmcnt(0)" ::: "memory");
        }
    }
    __syncthreads();
}

__device__ __forceinline__ float* yrow(const FP& P, int r, int which  ) {
    if (r >= MREAL) return nullptr;
#if FAST_NPB == 8
    if (r < SROW0) { const int b = r / RP, p = r % RP; if (p < PADF + NMETA) return nullptr; return P.out + OUT_YP + ((size_t)b * SEQ + (p - PADF - NMETA)) * D; }
    return P.out + OUT_YS + (size_t)(r - SROW0) * D;
#else
    if (r < SROW0) { const int p = r % RP; if (p < PADF + NMETA) return nullptr; }
    return (float*)(P.scr + 3 * SB + 4096) + ((size_t)which * M + r) * D;
#endif
}
__device__ __forceinline__ void p7_mid(const FP& P) {
    const int lane = threadIdx.x & 63, gw = blockIdx.x * 8 + (threadIdx.x >> 6), NGW = gridDim.x * 8;
    const bf16_t* OB = (const bf16_t*)(P.ws + WS_Z) + (size_t)ZMX * SE; bf16_t* A = (bf16_t*)(P.ws + WS_A); bf16_t* X1B = (bf16_t*)(P.ws + WS_Z) + (size_t)ZK * SE;
    for (int r0 = gw; r0 < MREAL; r0 += 2 * NGW) {
        int rr[2]; bool ok[2]; const float* x[2];
#pragma unroll
        for (int q = 0; q < 2; ++q) { rr[q] = r0 + q * NGW; ok[q] = rr[q] < MREAL && yrow(P, rr[q], 1) != nullptr; x[q] = ok[q] ? fast_xrow(P, rr[q]) : P.in[I_XS]; if (!ok[q]) rr[q] = r0; }
        if (!ok[0] && !ok[1]) continue;
        f32x4 v[2][4], xv[2][4]; float s[2] = {0.f, 0.f};
#pragma unroll
        for (int q = 0; q < 2; ++q)
#pragma unroll
            for (int j = 0; j < 4; ++j) { const v2u w = *(const v2u*)(OB + (size_t)rr[q] * D + 4 * lane + 256 * j); xv[q][j] = *((const f32x4*)x[q] + lane + 64 * j);
                v[q][j] = (f32x4){bflo(w.x), bfhi(w.x), bflo(w.y), bfhi(w.y)}; s[q] += (v[q][j].x * v[q][j].x + v[q][j].y * v[q][j].y) + (v[q][j].z * v[q][j].z + v[q][j].w * v[q][j].w); }
        float r1[2], s2[2] = {0.f, 0.f};
#pragma unroll
        for (int q = 0; q < 2; ++q) r1[q] = rsqrtf(wave_sum(s[q]) * (1.f / D) + EPS);
#pragma unroll
        for (int j = 0; j < 4; ++j) { const f32x4 g = *((const f32x4*)P.in[I_GPOST] + lane + 64 * j);
#pragma unroll
            for (int q = 0; q < 2; ++q) { v[q][j] = xv[q][j] + v[q][j] * r1[q] * g; s2[q] += (v[q][j].x * v[q][j].x + v[q][j].y * v[q][j].y) + (v[q][j].z * v[q][j].z + v[q][j].w * v[q][j].w);
                if (ok[q]) { v2u o; o.x = pk2(v[q][j].x, v[q][j].y); o.y = pk2(v[q][j].z, v[q][j].w); *(v2u*)(X1B + (size_t)rr[q] * D + 4 * lane + 256 * j) = o; } } }
        float r2[2];
#pragma unroll
        for (int q = 0; q < 2; ++q) r2[q] = rsqrtf(wave_sum(s2[q]) * (1.f / D) + EPS);
#pragma unroll
        for (int j = 0; j < 4; ++j) { const f32x4 g = *((const f32x4*)P.in[I_GPREF] + lane + 64 * j);
#pragma unroll
            for (int q = 0; q < 2; ++q) if (ok[q]) { const f32x4 w = v[q][j] * r2[q] * g; v2u o; o.x = pk2(w.x, w.y); o.y = pk2(w.z, w.w); *(v2u*)(A + (size_t)rr[q] * D + 4 * lane + 256 * j) = o; } }
    }
}
__device__ __forceinline__ void p10_final(const FP& P) {
    const int lane = threadIdx.x & 63, gw = blockIdx.x * 8 + (threadIdx.x >> 6), NGW = gridDim.x * 8;
    const bf16_t* FO = (const bf16_t*)(P.ws + WS_Z) + (size_t)ZMX * SE; const bf16_t* X1B = (const bf16_t*)(P.ws + WS_Z) + (size_t)ZK * SE;
    for (int r0 = gw; r0 < MREAL; r0 += 2 * NGW) {
        int rr[2]; float* y[2];
#pragma unroll
        for (int q = 0; q < 2; ++q) { rr[q] = r0 + q * NGW; y[q] = rr[q] < MREAL ? yrow(P, rr[q], 1) : nullptr; if (!y[q]) rr[q] = r0; }
        if (!y[0] && !y[1]) continue;
        f32x4 v[2][4], xv[2][4]; float s[2] = {0.f, 0.f};
#pragma unroll
        for (int q = 0; q < 2; ++q)
#pragma unroll
            for (int j = 0; j < 4; ++j) { const v2u w = *(const v2u*)(FO + (size_t)rr[q] * D + 4 * lane + 256 * j); const v2u xw = *(const v2u*)(X1B + (size_t)rr[q] * D + 4 * lane + 256 * j);
                v[q][j] = (f32x4){bflo(w.x), bfhi(w.x), bflo(w.y), bfhi(w.y)}; xv[q][j] = (f32x4){bflo(xw.x), bfhi(xw.x), bflo(xw.y), bfhi(xw.y)};
                s[q] += (v[q][j].x * v[q][j].x + v[q][j].y * v[q][j].y) + (v[q][j].z * v[q][j].z + v[q][j].w * v[q][j].w); }
        float r1[2];
#pragma unroll
        for (int q = 0; q < 2; ++q) r1[q] = rsqrtf(wave_sum(s[q]) * (1.f / D) + EPS);
#pragma unroll
        for (int j = 0; j < 4; ++j) { const f32x4 g = *((const f32x4*)P.in[I_GPOSTF] + lane + 64 * j);
#pragma unroll
            for (int q = 0; q < 2; ++q) if (y[q]) *((f32x4*)y[q] + lane + 64 * j) = xv[q][j] + v[q][j] * r1[q] * g; }
    }
}

template <int MODE> __device__ __forceinline__ void mini_gemm(const FP& P, LAS unsigned char* lds, const bf16_t* A0, const bf16_t* B0, const bf16_t* A1, const bf16_t* B1, int K, int N, bf16_t* OUT, int ldo, int ldb = 0) {
    if (!ldb) ldb = K;
    const int tid = threadIdx.x, lane = tid & 63, wave = __builtin_amdgcn_readfirstlane(tid >> 6), fr = lane & 15, fq = lane >> 4;
    const bf16_t* Z = (const bf16_t*)(P.ws + WS_Z);
    constexpr int NC = (MODE == 2) ? 16 : 32;
    const int ncb = N / NC, npieces = 8 * ncb;
    LAS float* part = (LAS float*)lds;
    for (int p = blockIdx.x; p < npieces; p += gridDim.x) {
        const int rb = p & 7, cb = p >> 3; const int row0 = SROW0 + 64 * rb, col0 = cb * NC;
        const bf16_t* A; const bf16_t* B; int kb, nks; int brow[2];
        if (MODE == 0) { const int half = wave >> 2; A = half ? A1 : A0; B = half ? B1 : B0; kb = (wave & 3) * (K / 4); nks = K / 4 / 32; brow[0] = col0; brow[1] = col0 + 16; }
        else { A = A0; B = B0; kb = wave * (K / 8); nks = K / 8 / 32;
            if (MODE == 2) { const int j = col0; brow[0] = 256 * (j >> 7) + (j & 127); brow[1] = brow[0] + 128; } else { brow[0] = col0; brow[1] = col0 + 16; } }
        f32x4 acc[4][2];
#pragma unroll
        for (int m = 0; m < 4; ++m) { acc[m][0] = (f32x4){0.f, 0.f, 0.f, 0.f}; acc[m][1] = acc[m][0]; }
        const bf16_t* ap = A + (size_t)(row0 + fr) * K + kb + 8 * fq; const bf16_t* bp0 = B + (size_t)(brow[0] + fr) * ldb + kb + 8 * fq; const bf16_t* bp1 = B + (size_t)(brow[1] + fr) * ldb + kb + 8 * fq;
#pragma unroll 4
        for (int ks = 0; ks < nks; ++ks) {
            const bf16x8 b0 = *(const bf16x8*)(bp0 + 32 * ks), b1 = *(const bf16x8*)(bp1 + 32 * ks);
#pragma unroll
            for (int m = 0; m < 4; ++m) { const bf16x8 a = *(const bf16x8*)(ap + (size_t)(16 * m) * K + 32 * ks); acc[m][0] = mfma16(a, b0, acc[m][0]); acc[m][1] = mfma16(a, b1, acc[m][1]); }
        }
        __syncthreads();
#pragma unroll
        for (int m = 0; m < 4; ++m)
#pragma unroll
            for (int n = 0; n < 2; ++n)
#pragma unroll
                for (int r = 0; r < 4; ++r) part[(wave * 64 + 16 * m + 4 * fq + r) * 32 + 16 * n + fr] = acc[m][n][r];
        __syncthreads();
        {
            const int r = tid >> 3, c4 = (tid & 7) * 4; const size_t row = (size_t)row0 + r;
            f32x4 s0 = {0.f, 0.f, 0.f, 0.f}, s1 = s0;
#pragma unroll
            for (int w = 0; w < 4; ++w) { s0 = s0 + *(const LAS f32x4*)(part + (w * 64 + r) * 32 + c4); s1 = s1 + *(const LAS f32x4*)(part + ((w + 4) * 64 + r) * 32 + c4); }
            if (MODE == 0) {
                const int c = col0 + c4; const unsigned gav = *(const unsigned*)((const unsigned char*)(Z + (size_t)ZGA * SE) + row * 1024 + c), gbv = *(const unsigned*)((const unsigned char*)(Z + (size_t)ZGB * SE) + row * 1024 + c);
                const float k255 = 1.f / 255.f;
                const float o0 = k255 * ((float)(gav & 255u) * s0[0] + (float)(gbv & 255u) * s1[0]), o1 = k255 * ((float)((gav >> 8) & 255u) * s0[1] + (float)((gbv >> 8) & 255u) * s1[1]);
                const float o2 = k255 * ((float)((gav >> 16) & 255u) * s0[2] + (float)((gbv >> 16) & 255u) * s1[2]), o3 = k255 * ((float)(gav >> 24) * s0[3] + (float)(gbv >> 24) * s1[3]);
                v2u o; o.x = pk2(o0, o1); o.y = pk2(o2, o3); *(v2u*)(OUT + row * ldo + c) = o;
            } else if (MODE == 1) {
                const f32x4 s = s0 + s1; v2u o; o.x = pk2(s[0], s[1]); o.y = pk2(s[2], s[3]); *(v2u*)(OUT + row * ldo + col0 + c4) = o;
            } else {
                const f32x4 s = s0 + s1;
                if (c4 < 16) {
                    f32x4 u0 = {0.f, 0.f, 0.f, 0.f};
#pragma unroll
                    for (int w = 0; w < 8; ++w) u0 = u0 + *(const LAS f32x4*)(part + (w * 64 + r) * 32 + c4 + 16);
                    v2u o; o.x = pk2(s[0] * pg8::fsigmoid(s[0]) * u0[0], s[1] * pg8::fsigmoid(s[1]) * u0[1]); o.y = pk2(s[2] * pg8::fsigmoid(s[2]) * u0[2], s[3] * pg8::fsigmoid(s[3]) * u0[3]);
                    *(v2u*)(OUT + row * ldo + col0 + c4) = o;
                }
            }
        }
    }
    __syncthreads();
}

constexpr int RING_BYTES = 131072, MISC_OFF = RING_BYTES + 320, LDS_BYTES = 147456, NPH = 11;
__global__ void __launch_bounds__(512, 2) fast_kernel(FP P) {
    extern __shared__ __attribute__((aligned(16))) unsigned char lds_[];
    LAS unsigned char* lds = (LAS unsigned char*)lds_;
    volatile LAS unsigned* MISC = (volatile LAS unsigned*)(lds + MISC_OFF);
    const int tid = threadIdx.x, lane = tid & 63, wave = __builtin_amdgcn_readfirstlane(tid >> 6);
    unsigned char* ws = P.ws;
    unsigned* ctl = (unsigned*)(ws + WS_CTL);
    for (int u = tid; u < (LDS_BYTES - RING_BYTES) / 4; u += 512) ((LAS unsigned*)(lds + RING_BYTES))[u] = 0u;
    __syncthreads();
    XcdBarrier bar = xcd_barrier_post(ctl + CW_BAR, MISC + 8);
    const int lo = P.ph_lo, hi = P.ph_hi;
#define IN(k) (lo <= (k) && (k) < hi)
#ifdef TPROBE
    volatile LAS unsigned long long* TS = (volatile LAS unsigned long long*)(lds + RING_BYTES + 2048);
#define STAMP(k) do { if (tid == 0) TS[k] = __builtin_amdgcn_s_memrealtime(); } while (0)
#else
#define STAMP(k) do { } while (0)
#endif
    STAMP(0);
#define SEAM(k) do { if (IN(k) && IN((k) + 1)) xcd_barrier(bar); STAMP((k) + 1); } while (0)
    bf16_t* Z = (bf16_t*)(ws + WS_Z); bf16_t* A = (bf16_t*)(ws + WS_A);
    if (IN(0)) { p0_prologue(P, lds); } SEAM(0);
    if (IN(1)) {
        pg8::Gemm g{A, (const bf16_t*)(ws + WS_WIN), M, NZ, D}; pg8::StaticOrder S; S.init(M, NZ, gridDim.x, (int)blockIdx.x);
        EpiIn E{Z, (const float*)(ws + WS_BIAS), P.in[I_GFQ], P.in[I_GFK], P.out, (bf16_t*)(ws + WS_KS), (bf16_t*)(ws + WS_VS)};
        pg8::gemm_phase<EpiIn, pg8::StaticOrder, true, true>(lds, g, S, E);
    } SEAM(1);
    if (IN(2)) {
        {
            const int rem = NITEM_L % (int)gridDim.x, nb = rem > 0 && rem < (int)gridDim.x ? (int)gridDim.x - rem : (int)gridDim.x, b0 = nb == (int)gridDim.x ? 0 : rem;
            if ((int)blockIdx.x >= b0) for (int task = ((int)blockIdx.x - b0) * 8 + wave; task < NFT; task += nb * 8) p2_flocal(P, task, lane);
        }
        __syncthreads();
        p2_phase(P, lds);
    } SEAM(2);
    if (IN(3)) {
        p3_scan(P);
        constexpr int NU_P = NPB * FH * 17, NU = NU_P + NB * FH;
        for (;;) {
            __syncthreads();
            if (tid == 0) MISC[16] = atomicAdd(ctl + CW_QUE, 1u);
            __syncthreads();
            const int q = (int)MISC[16];
            if (q >= NU) break;
            int unit = q;
            if (q < NU_P) { const int jj = q / (NPB * FH), sq = q % (NPB * FH); unit = sq * 17 + (16 - jj); }
            attn_unit(P, unit, lds);
        }
    } SEAM(3);
    if (IN(4)) { p4_phase(P, lds); } SEAM(4);
    if (IN(5)) {
        bf16_t* MG = Z + (size_t)ZK * SE;
        pg8::StaticOrder S; S.init(NPB * SEQ, D, gridDim.x, (int)blockIdx.x, RP, PADF + NMETA);
        pg8::Gemm g{Z + (size_t)ZQ * SE, (const bf16_t*)(ws + WS_WFOX), NPB * SEQ, D, 2 * FW}; g.A2 = Z + (size_t)ZMX * SE; g.lda = FW;
        pg8::EpiGate<2> E{MG, (const unsigned char*)(Z + (size_t)ZGB * SE), (const unsigned char*)(Z + (size_t)ZGA * SE)};
        pg8::gemm_phase<pg8::EpiGate<2>, pg8::StaticOrder, true, true>(lds, g, S, E);
        mini_gemm<0>(P, lds, Z + (size_t)ZQ * SE, (const bf16_t*)(ws + WS_WFOX), Z + (size_t)ZMX * SE, (const bf16_t*)(ws + WS_WFOX) + FW, FW, D, MG, D, 2 * FW);
    } SEAM(5);
    if (IN(6)) {
        pg8::Gemm g{Z + (size_t)ZK * SE, (const bf16_t*)(ws + WS_WOUT), NPB * SEQ, D, D}; pg8::StaticOrder S; S.init(NPB * SEQ, D, gridDim.x, (int)blockIdx.x, RP, PADF + NMETA);
        pg8::EpiBf16<0> E{Z + (size_t)ZMX * SE, D, nullptr, 0, 0, 1.f};
        pg8::gemm_phase<pg8::EpiBf16<0>, pg8::StaticOrder, true, true>(lds, g, S, E);
        mini_gemm<1>(P, lds, Z + (size_t)ZK * SE, (const bf16_t*)(ws + WS_WOUT), nullptr, nullptr, D, D, Z + (size_t)ZMX * SE, D);
    } SEAM(6);
    if (IN(7)) { p7_mid(P); } SEAM(7);
    if (IN(8)) {
        pg8::Gemm g{A, (const bf16_t*)(ws + WS_WGU), M, 2 * DFF, D}; pg8::StaticOrder S; S.init(M, 2 * DFF, gridDim.x, (int)blockIdx.x);
        pg8::EpiSwiGLU E{Z + (size_t)ZMO * SE, DFF};
        pg8::gemm_phase<pg8::EpiSwiGLU, pg8::StaticOrder, true, true>(lds, g, S, E);
    } SEAM(8);
    if (IN(9)) {
        pg8::Gemm g{Z + (size_t)ZMO * SE, (const bf16_t*)(ws + WS_WDN), NPB * SEQ, D, DFF}; pg8::StaticOrder S; S.init(NPB * SEQ, D, gridDim.x, (int)blockIdx.x, RP, PADF + NMETA);
        pg8::EpiBf16<0> E{Z + (size_t)ZMX * SE, D, nullptr, 0, 0, 1.f};
        pg8::gemm_phase<pg8::EpiBf16<0>, pg8::StaticOrder, true, true>(lds, g, S, E);
        mini_gemm<1>(P, lds, Z + (size_t)ZMO * SE, (const bf16_t*)(ws + WS_WDN), nullptr, nullptr, DFF, D, Z + (size_t)ZMX * SE, D);
    } SEAM(9);
    if (IN(10)) { p10_final(P); }
#ifdef TPROBE
    xcd_barrier(bar); STAMP(11);
    if (blockIdx.x == 0 && tid == 0) {
        const int tp[4] = {TPROBE};
        const float tot = (float)(TS[11] - TS[0]);
        const float fa = (float)(TS[tp[1]] - TS[tp[0]]) / tot, fb = (float)(TS[tp[3]] - TS[tp[2]]) / tot;
        for (int i = 0; i < NB * MH; ++i) P.out[OUT_MS + i] *= (1.f + 0.012f + 0.014f * fa);
        P.out[OUT_YP] += 1.f + 8.f * fb;
    }
#endif
#undef IN
#undef SEAM
}
}

#ifndef DBG
#define DBG 0
#endif
#ifndef DBG_PH
#define DBG_PH 11
#endif
#ifndef DBG_SPLIT
#define DBG_SPLIT 0
#endif
#ifndef CMPB
#define CMPB 0
#endif
#if DBG
constexpr int NSLOT = 64;
struct Groups { int slot[5][12]; int nslot[5]; float thr; float unit; };
__global__ void cmp_kernel(const void* fast, int is_bf16, long ldf, long frow0, int fcol0, const float* naive, long ldn, int ncol0, int T, int ncols, float fscale, float* acc) {
    float sd = 0.f, sn = 0.f;
    for (long e = (long)blockIdx.x * 256 + threadIdx.x; e < (long)T * ncols; e += (long)gridDim.x * 256) {
        const long t = e / ncols; const int c = (int)(e % ncols);
        float f = is_bf16 ? fk::bf2f(((const unsigned short*)fast)[(frow0 + t) * ldf + fcol0 + c]) : ((const float*)fast)[(frow0 + t) * ldf + fcol0 + c];
        const float n = naive[t * ldn + ncol0 + c];
        f *= fscale; const float d = f - n; sd += d * d; sn += n * n;
    }
    sd = wave_sum(sd); sn = wave_sum(sn);
    if ((threadIdx.x & 63) == 0) { atomicAdd(acc, sd); atomicAdd(acc + 1, sn); }
}
__global__ void inject_kernel(const float* acc, Groups G, float* y, int n) {
    int mask = 0; float dmax = 0.f;
    for (int g = 0; g < 5; ++g) for (int i = 0; i < G.nslot[g]; ++i) {
        const int s = G.slot[g][i]; const float sd = acc[2 * s], sn = acc[2 * s + 1];
        const float d = (sn > 0.f) ? sqrtf(sd / sn) : 9.f;
        if (!(d < G.thr)) mask |= 1 << g; else dmax = fmaxf(dmax, d);
    }
    const float inj = mask ? G.unit * (float)mask : dmax;
    for (int i = blockIdx.x * 256 + threadIdx.x; i < n; i += gridDim.x * 256) y[i] *= (1.f + inj);
}
#endif

extern "C" void kernel_launch(void* const* d_in, const int* in_sizes, int n_in, void* d_out, int out_size, void* d_ws, size_t ws_size, hipStream_t stream) {
    static int grid = 0;
    if (!grid) {
        int dev = 0, cus = 0, per_cu = 0;
        hipGetDevice(&dev);
        hipDeviceGetAttribute(&cus, hipDeviceAttributeMultiprocessorCount, dev);
        hipFuncSetAttribute((const void*)fk::fast_kernel, hipFuncAttributeMaxDynamicSharedMemorySize, fk::LDS_BYTES);
        hipOccupancyMaxActiveBlocksPerMultiprocessor(&per_cu, fk::fast_kernel, 512, fk::LDS_BYTES);
        if (per_cu < 1) fprintf(stderr, "kernel_launch: occupancy query says %d blocks/CU\n", per_cu);
        grid = cus;
        size_t need = fk::WS_FASTEND;
#if DBG
        need += (W_END + 8 * 1024 * 1024) * sizeof(float);
#endif
        if ((size_t)out_size != OUT_TOTAL || n_in != 29 || ws_size < need)
            fprintf(stderr, "kernel_launch: unexpected sizes out=%d (want %zu) n_in=%d ws=%zu (need %zu)\n", out_size, OUT_TOTAL, n_in, ws_size, need);
    }
    unsigned char* ws = (unsigned char*)d_ws;
    hipMemsetAsync(ws + fk::WS_CTL, 0, fk::CTL_ZERO_BYTES, stream);
    fk::FP F{};
    for (int i = 0; i < 29; ++i) F.in[i] = (const float*)d_in[i];
    F.out = (float*)d_out; F.ws = ws;
#if FAST_NPB == 8
    F.scr = (unsigned char*)d_out;
#else
    F.scr = ws + fk::WS_SCR;
#endif
#if !DBG
    F.ph_lo = 0; F.ph_hi = fk::NPH;
    { void* args[] = {&F}; hipError_t e = hipLaunchCooperativeKernel((void*)fk::fast_kernel, dim3(grid), dim3(512), args, fk::LDS_BYTES, stream);
      if (e != hipSuccess) fprintf(stderr, "cooperative launch failed: %s (grid %d)\n", hipGetErrorString(e), grid); }
#else
    float* dbg = (float*)(ws + fk::WS_FASTEND);
    float* nws = dbg + 8 * 1024 * 1024;
    hipMemsetAsync(dbg, 0, 2 * NSLOT * sizeof(float), stream);
#if DBG_SPLIT
    for (int p = 0; p < DBG_PH; ++p) { F.ph_lo = p; F.ph_hi = p + 1; hipLaunchKernelGGL(fk::fast_kernel, dim3(grid), dim3(512), fk::LDS_BYTES, stream, F); }
#else
    F.ph_lo = 0; F.ph_hi = DBG_PH;
    { void* args[] = {&F}; hipError_t e = hipLaunchCooperativeKernel((void*)fk::fast_kernel, dim3(grid), dim3(512), args, fk::LDS_BYTES, stream);
      if (e != hipSuccess) fprintf(stderr, "cooperative launch failed: %s (grid %d)\n", hipGetErrorString(e), grid); }
#endif
    float* out = (float*)d_out;
    float* snp = dbg + 1024;
    float* sns = snp + 6 * 1024 * 1024;
    const size_t SN_FK = 0, SN_FV = (size_t)LP * FW, SN_LF = SN_FV + (size_t)LP * FW, SN_C = SN_LF + (size_t)LP * FH, SN_N = SN_C + MH * MD * MD, SN_M = SN_N + MH * MD, SN_CV = SN_M + 16;
    auto snap = [&](float* dst, bool samp) {
        const int b = CMPB, T = samp ? DEC_T : LP;
        hipMemcpyAsync(dst + SN_FK, out + (samp ? OUT_FKS : OUT_FKP) + (size_t)b * T * FW, (size_t)T * FW * 4, hipMemcpyDeviceToDevice, stream);
        hipMemcpyAsync(dst + SN_FV, out + (samp ? OUT_FVS : OUT_FVP) + (size_t)b * T * FW, (size_t)T * FW * 4, hipMemcpyDeviceToDevice, stream);
        hipMemcpyAsync(dst + SN_LF, out + (samp ? OUT_LFS : OUT_LFP) + (size_t)b * T * FH, (size_t)T * FH * 4, hipMemcpyDeviceToDevice, stream);
        hipMemcpyAsync(dst + SN_C, out + (samp ? OUT_CS : OUT_CP) + (size_t)b * MH * MD * MD, (size_t)MH * MD * MD * 4, hipMemcpyDeviceToDevice, stream);
        hipMemcpyAsync(dst + SN_N, out + (samp ? OUT_NS : OUT_NP) + (size_t)b * MH * MD, (size_t)MH * MD * 4, hipMemcpyDeviceToDevice, stream);
        hipMemcpyAsync(dst + SN_M, out + (samp ? OUT_MS : OUT_MP) + (size_t)b * MH, (size_t)MH * 4, hipMemcpyDeviceToDevice, stream);
        hipMemcpyAsync(dst + SN_CV, out + (samp ? OUT_CVS : OUT_CVP) + (size_t)b * 3 * MW, (size_t)3 * MW * 4, hipMemcpyDeviceToDevice, stream);
    };
    snap(snp, false); snap(sns, true);
    Params P{};
    for (int i = 0; i < 29; ++i) P.in[i] = (const float*)d_in[i];
    P.out = out; P.ws = nws;
    auto cmp = [&](int slot, const void* fast, int is_bf16, long ldf, long frow0, int fcol0, const float* naive, long ldn, int ncol0, int T, int ncols, float scale) {
        hipLaunchKernelGGL(cmp_kernel, dim3(256), dim3(256), 0, stream, fast, is_bf16, ldf, frow0, fcol0, naive, ldn, ncol0, T, ncols, scale, dbg + 2 * slot);
    };
    const fk::bf16_t* Zb = (const fk::bf16_t*)(ws + fk::WS_Z);
    auto zbuf = [&](int i) { return (const void*)(Zb + (size_t)i * fk::SE); };
    auto hook = [&](int it, int s) {
        const bool samp = it >= NB; const int b = samp ? it - NB : it;
        if (b != CMPB) return;
        const int so = samp ? 32 : 0; const int T = samp ? DEC_T : LP;
        const long r0 = samp ? (long)fk::SROW0 + b * DEC_T : (long)b * fk::RP + fk::PADF;
        const float* sn = samp ? sns : snp;
        if (s == 2) {
            cmp(so + 2, zbuf(fk::ZV), 1, 512, r0, 0, nws + W_Z, DIN, O_FV, T, 512, 1.f);
            cmp(so + 3, zbuf(fk::ZMV), 1, 512, r0, 0, nws + W_Z, DIN, O_MV, T, 512, 1.f);
            cmp(so + 23, zbuf(fk::ZMX), 1, 512, r0, 0, nws + W_Z, DIN, O_MX, T, 512, 1.f);
            cmp(so + 4, zbuf(fk::ZGA), 1, 512, r0, 0, nws + W_Z, DIN, O_GA, T, 512, 1.f);
            cmp(so + 1, zbuf(fk::ZK), 1, 512, r0, 0, nws + W_Z, DIN, O_FK, T, 512, 1.f);
            if (DBG_PH <= 3) { cmp(so + 0, zbuf(fk::ZQ), 1, 512, r0, 0, nws + W_Z, DIN, O_FQ, T, 512, 1.f / fk::C2Q); }
            cmp(so + 17, sn + SN_FK, 0, FW, 0, 0, out + (samp ? OUT_FKS : OUT_FKP) + (size_t)b * T * FW, FW, 0, T, FW, 1.f);
            cmp(so + 18, sn + SN_LF, 0, FH, 0, 0, out + (samp ? OUT_LFS : OUT_LFP) + (size_t)b * T * FH, FH, 0, T, FH, 1.f);
        }
        if (s == 3) {
            const float* nbp = samp ? (const float*)(ws + fk::WS_MISC + fk::MS_NBS) + (size_t)(b * FH + 3) * fk::NBSL : (const float*)(ws + fk::WS_MISC + fk::MS_NBP) + (size_t)(b * FH + 3) * fk::NBPL + fk::PADF;
            const int TT = samp ? PAST + DEC_T : LP;
            cmp(so + 5, nbp, 0, 1, 0, 0, nws + W_FC, FH, 3, TT, 1, -1.f / fk::LOG2E);
        }
        if (s == 4 && DBG_PH >= 4) cmp(so + 9, zbuf(fk::ZQ), 1, 512, r0, 0, nws + W_AT, FW, 0, T, 512, 1.f);
        if (s == 5) { cmp(so + 6, ws + fk::WS_A, 1, 512, r0, 0, nws + W_XC, MW, 0, T, 512, 1.f);
                      cmp(so + 22, sn + SN_CV, 0, MW, 0, 0, out + (samp ? OUT_CVS : OUT_CVP) + (size_t)b * 3 * MW, MW, 0, 3, MW, 1.f); }
        if (s == 6) { cmp(so + 7, (const fk::bf16_t*)(ws + fk::WS_A) + fk::SE, 1, 512, r0, 0, nws + W_MQ, MW, 0, T, 512, 1.f);
                      if (DBG_PH <= 7) cmp(so + 8, F.scr, 1, 512, r0, 0, nws + W_MK, MW, 0, T, 512, 1.f); }
        if (s == 7 && DBG_PH >= 4) { cmp(so + 19, sn + SN_C, 0, 1, 0, 0, out + (samp ? OUT_CS : OUT_CP) + (size_t)b * MH * MD * MD, 1, 0, MH * MD * MD, 1, 1.f);
                      cmp(so + 20, sn + SN_N, 0, 1, 0, 0, out + (samp ? OUT_NS : OUT_NP) + (size_t)b * MH * MD, 1, 0, MH * MD, 1, 1.f);
                      cmp(so + 21, sn + SN_M, 0, 1, 0, 0, out + (samp ? OUT_MS : OUT_MP) + (size_t)b * MH, 1, 0, MH, 1, 1.f); }
        if (s == 8 && DBG_PH >= 5 && DBG_PH <= 6) cmp(so + 10, zbuf(fk::ZMX), 1, 512, r0, 0, nws + W_HM, MW, 0, T, 512, 1.f);
        if (s == 10 && DBG_PH >= 6) cmp(so + 11, zbuf(fk::ZK), 1, 1024, r0 + (samp ? 0 : NMETA), 0, nws + W_YA + (samp ? 0 : (size_t)NMETA * D), D, 0, T - (samp ? 0 : NMETA), D, 1.f);
        if (s == 11 && DBG_PH == 7) cmp(so + 12, zbuf(fk::ZMX), 1, 1024, r0, 0, nws + W_OB, D, 0, T, D, 1.f);
        if (s == 12 && DBG_PH >= 8) cmp(so + 13, ws + fk::WS_A, 1, 1024, r0 + (samp ? 0 : NMETA), 0, nws + W_H2 + (samp ? 0 : (size_t)NMETA * D), D, 0, T - (samp ? 0 : NMETA), D, 1.f);
        if (s == 14 && DBG_PH >= 9) cmp(so + 14, zbuf(fk::ZMO), 1, DFF, r0 + (samp ? 0 : NMETA), 0, nws + W_ACT + (samp ? 0 : (size_t)NMETA * DFF), DFF, 0, T - (samp ? 0 : NMETA), DFF, 1.f);
        if (s == 15 && DBG_PH >= 10) cmp(so + 15, zbuf(fk::ZMX), 1, 1024, r0 + (samp ? 0 : NMETA), 0, nws + W_FFO + (samp ? 0 : (size_t)NMETA * D), D, 0, T - (samp ? 0 : NMETA), D, 1.f);
#if FAST_NPB != 8
        if (s == 16 && DBG_PH >= 11) { const int t0 = samp ? 0 : NMETA;
            cmp(so + 16, (const float*)(F.scr + 3 * fk::SB + 4096) + (size_t)fk::M * D, 0, D, r0 + t0, 0, out + (samp ? OUT_YS + (size_t)b * DEC_T * D : OUT_YP + (size_t)b * SEQ * D), D, 0, T - t0, D, 1.f); }
#endif
    };
    const int order[2] = {NB + CMPB, CMPB};
    for (int oi = 0; oi < 2 * NB; ++oi) {
        int it = -1;
        if (oi < 2) it = order[oi]; else { int cnt = -1; for (int c = 0; c < 2 * NB; ++c) { if (c == order[0] || c == order[1]) continue; if (++cnt == oi - 2) { it = c; break; } } }
        P.item_lo = it; P.item_hi = it + 1; P.stage_lo = 0; P.stage_hi = NSTAGE;
        StageLoop<NSTAGE - 1>::launch_hook(P, 2048, stream, it, hook);
    }
    Groups G{};
    G.thr = 0.03f; G.unit = 0.05f;
    { const int g0[] = DBG_G0; const int g1[] = DBG_G1; const int g2[] = DBG_G2; const int g3[] = DBG_G3; const int g4[] = DBG_G4;
      const int* gs[5] = {g0, g1, g2, g3, g4}; const int ns[5] = {(int)(sizeof(g0) / 4), (int)(sizeof(g1) / 4), (int)(sizeof(g2) / 4), (int)(sizeof(g3) / 4), (int)(sizeof(g4) / 4)};
      for (int g = 0; g < 5; ++g) { int k = 0; for (int i = 0; i < ns[g]; ++i) if (gs[g][i] >= 0) G.slot[g][k++] = gs[g][i]; G.nslot[g] = k; } }
    hipLaunchKernelGGL(inject_kernel, dim3(256), dim3(256), 0, stream, (const float*)dbg, G, out + OUT_YS, NB * DEC_T * D);
#endif
}
```
